# Optimizing an MI355X kernel written in HIP

```python
import math
import jax, jax.numpy as jnp
from jax import lax
import numpy as np

D_MODEL = 1024
BATCH = 2
SEQ = 8192
DEPTH = 2

CHUNK = 64
Q_BLOCK = 128
N_META = 16
DIFF_HEADS = 4
DIFF_QK_DIM = 64
DIFF_V_DIM = 2 * DIFF_QK_DIM
FOX_HEADS = 4
FOX_HEAD_DIM = 64
FOX_FORGET_BIAS = 2.0
GDN_HEADS = 4
GDN_HEAD_DIM = 64
CONV_K = 4
N_EXPERTS = 32
TOP_K = 4
D_EXPERT = D_MODEL
MOE_BLOCK = 128
SWIGLU_LIMIT = 7.0
SWIGLU_ALPHA = 1.702
DEEPNORM_ALPHA = (2 * DEPTH) ** 0.25
DEEPNORM_BETA = (8 * DEPTH) ** -0.25
MASK_VALUE = -1e30

DIFF_QK_WIDTH = DIFF_HEADS * 2 * DIFF_QK_DIM
DIFF_V_WIDTH = DIFF_HEADS * DIFF_V_DIM
FOX_WIDTH = FOX_HEADS * FOX_HEAD_DIM
GDN_WIDTH = GDN_HEADS * GDN_HEAD_DIM
GDN_CONV_CH = 3 * GDN_WIDTH
MIX_WIDTH = DIFF_V_WIDTH + FOX_WIDTH + GDN_WIDTH
IN_PROJ_SIZES = (DIFF_QK_WIDTH, DIFF_QK_WIDTH, DIFF_V_WIDTH, FOX_WIDTH, FOX_WIDTH, FOX_WIDTH, FOX_HEADS,
                 GDN_CONV_CH, GDN_HEADS, GDN_HEADS, GDN_WIDTH)
N_PROJ = 3340

kernel_name = 'hybrid_diff_fox_gdn_moe_deepnorm'


def _split_points():
    return [int(s) for s in np.cumsum(IN_PROJ_SIZES)[:-1]]


def _in_proj_column_scale():
    scale = np.ones((N_PROJ,), np.float32)
    offs = np.concatenate([[0], np.cumsum(IN_PROJ_SIZES)])
    for seg in (2, 5):
        scale[offs[seg]:offs[seg + 1]] = DEEPNORM_BETA
    scale[offs[7] + 2 * GDN_WIDTH:offs[8]] = DEEPNORM_BETA
    return scale


def _diff_lambda_init(layer):
    return 0.8 - 0.6 * math.exp(-0.3 * layer)


def _layer_norm(x, g, b, eps=1e-5):
    xf = x.astype(jnp.float32)
    mu = jnp.mean(xf, -1, keepdims=True)
    var = jnp.mean(jnp.square(xf - mu), -1, keepdims=True)
    return ((xf - mu) * lax.rsqrt(var + eps) * g + b).astype(x.dtype)


def _rms_norm(x, g, eps):
    xf = x.astype(jnp.float32)
    return (xf * lax.rsqrt(jnp.mean(jnp.square(xf), -1, keepdims=True) + eps) * g).astype(x.dtype)


def _l2_normalize(x, eps=1e-6):
    return x * lax.rsqrt(jnp.sum(jnp.square(x), -1, keepdims=True) + eps)


def _sweep_query_blocks(block_fn, seq_len):
    out = lax.map(block_fn, jnp.arange(seq_len // Q_BLOCK))
    nb, b, h, qb, dv = out.shape
    return out.transpose(1, 2, 0, 3, 4).reshape(b, h, nb * qb, dv)


def _differential_attention(q, k, v, lam_vecs, subln_g, lambda_init, key_valid):
    b, l, _ = q.shape
    q = q.reshape(b, l, DIFF_HEADS, 2, DIFF_QK_DIM).transpose(3, 0, 2, 1, 4)
    k = k.reshape(b, l, DIFF_HEADS, 2, DIFF_QK_DIM).transpose(3, 0, 2, 1, 4)
    v = v.reshape(b, l, DIFF_HEADS, DIFF_V_DIM).transpose(0, 2, 1, 3)
    lv = lam_vecs.astype(jnp.float32)
    lam = jnp.exp(jnp.sum(lv[0] * lv[1])) - jnp.exp(jnp.sum(lv[2] * lv[3])) + lambda_init
    key_chunk = jnp.arange(l) // CHUNK
    scale = DIFF_QK_DIM ** -0.5

    def block(i):
        qi = lax.dynamic_slice_in_dim(q, i * Q_BLOCK, Q_BLOCK, axis=3)
        q_chunk = (i * Q_BLOCK + jnp.arange(Q_BLOCK)) // CHUNK
        visible = (key_chunk[None, :] <= q_chunk[:, None]) & key_valid[None, :]
        s = jnp.einsum('mbhqd,mbhkd->mbhqk', qi, k).astype(jnp.float32) * scale
        p = jax.nn.softmax(jnp.where(visible, s, MASK_VALUE), axis=-1)
        p = p[0] - lam * p[1]
        return jnp.einsum('bhqk,bhkd->bhqd', p.astype(v.dtype), v)

    o = _sweep_query_blocks(block, l)
    o = _rms_norm(o, subln_g, 1e-5) * (1.0 - lambda_init)
    return o.transpose(0, 2, 1, 3).reshape(b, l, DIFF_V_WIDTH)


def _forgetting_attention(q, k, v, f_logit, f_bias, key_valid):
    b, l, _ = q.shape

    def heads(t):
        return t.reshape(b, l, FOX_HEADS, FOX_HEAD_DIM).transpose(0, 2, 1, 3)

    q, k, v = heads(q), heads(k), heads(v)
    log_f = jax.nn.log_sigmoid((f_logit + f_bias).astype(jnp.float32))
    cum = jnp.cumsum(log_f, axis=1).transpose(0, 2, 1)
    key_pos = jnp.arange(l)
    scale = FOX_HEAD_DIM ** -0.5

    def block(i):
        start = i * Q_BLOCK
        qi = lax.dynamic_slice_in_dim(q, start, Q_BLOCK, axis=2)
        ci = lax.dynamic_slice_in_dim(cum, start, Q_BLOCK, axis=2)
        q_pos = start + jnp.arange(Q_BLOCK)
        visible = (key_pos[None, :] <= q_pos[:, None]) & key_valid[None, :]
        s = (jnp.einsum('bhqd,bhkd->bhqk', qi, k).astype(jnp.float32) * scale
             + ci[..., :, None] - cum[..., None, :])
        p = jax.nn.softmax(jnp.where(visible, s, MASK_VALUE), axis=-1)
        return jnp.einsum('bhqk,bhkd->bhqd', p.astype(v.dtype), v)

    o = _sweep_query_blocks(block, l)
    return o.transpose(0, 2, 1, 3).reshape(b, l, FOX_WIDTH)


def _causal_depthwise_conv(x, w):
    return lax.conv_general_dilated(x, w[:, None, :], window_strides=(1,), padding=[(CONV_K - 1, 0)],
                                    dimension_numbers=('NWC', 'WIO', 'NWC'),
                                    feature_group_count=x.shape[-1])


def _unit_lower_solve(a, rhs):
    return lax.linalg.triangular_solve(a, rhs, left_side=True, lower=True, unit_diagonal=True)


def _chunk_gated_delta_rule(q, k, v, beta, g):
    b, l, h, dk = q.shape
    dv = v.shape[-1]
    n = l // CHUNK

    def chunks(t):
        return t.reshape(b, n, CHUNK, h, -1).transpose(0, 3, 1, 2, 4)

    q, k, v = chunks(q), chunks(k), chunks(v)
    beta = beta.reshape(b, n, CHUNK, h).transpose(0, 3, 1, 2)
    gc = jnp.cumsum(g.reshape(b, n, CHUNK, h).transpose(0, 3, 1, 2), axis=-1)
    causal = jnp.tril(jnp.ones((CHUNK, CHUNK), bool))
    strict = jnp.tril(jnp.ones((CHUNK, CHUNK), bool), -1)
    decay = jnp.exp(jnp.where(causal, gc[..., :, None] - gc[..., None, :], -jnp.inf))
    a = jnp.where(strict, jnp.einsum('bhncd,bhnsd->bhncs', k, k) * beta[..., :, None] * decay, 0.0)
    a = a + jnp.eye(CHUNK, dtype=a.dtype)
    u_base = _unit_lower_solve(a, v * beta[..., None])
    w_dec = _unit_lower_solve(a, k * (beta * jnp.exp(gc))[..., None])
    qk = jnp.einsum('bhncd,bhnsd->bhncs', q, k) * decay
    q_dec = q * jnp.exp(gc)[..., None]
    k_dec = k * jnp.exp(gc[..., -1:] - gc)[..., None]
    chunk_decay = jnp.exp(gc[..., -1])

    def step(state, xs):
        u_n, w_n, qk_n, qd_n, kd_n, cd_n = xs
        v_new = u_n - jnp.einsum('bhcd,bhdv->bhcv', w_n, state)
        o_n = jnp.einsum('bhcd,bhdv->bhcv', qd_n, state) + jnp.einsum('bhcs,bhsv->bhcv', qk_n, v_new)
        state = state * cd_n[..., None, None] + jnp.einsum('bhcd,bhcv->bhdv', kd_n, v_new)
        return state, o_n

    xs = tuple(jnp.moveaxis(t, 2, 0) for t in (u_base, w_dec, qk, q_dec, k_dec, chunk_decay))
    state0 = jnp.zeros((b, h, dk, dv), jnp.float32)
    _, o = lax.scan(step, state0, xs)
    return o.transpose(1, 0, 3, 2, 4).reshape(b, l, h, dv)


def _gated_deltanet(qkv, b_logit, a_logit, z, conv_w, a_log, dt_bias, norm_g):
    b, l, _ = qkv.shape
    qkv = jax.nn.silu(_causal_depthwise_conv(qkv, conv_w))
    q, k, v = jnp.split(qkv.astype(jnp.float32), 3, axis=-1)

    def heads(t):
        return t.reshape(b, l, GDN_HEADS, GDN_HEAD_DIM)

    q = _l2_normalize(heads(q)) * GDN_HEAD_DIM ** -0.5
    k = _l2_normalize(heads(k))
    beta = jax.nn.sigmoid(b_logit.astype(jnp.float32))
    g = -jnp.exp(a_log.astype(jnp.float32)) * jax.nn.softplus(a_logit.astype(jnp.float32) + dt_bias)
    o = _chunk_gated_delta_rule(q, k, heads(v), beta, g).astype(z.dtype)
    o = _rms_norm(o, norm_g, 1e-6) * jax.nn.silu(heads(z))
    return o.reshape(b, l, GDN_WIDTH)


def _hybrid_mixer(h, w_in, diff_lambda, diff_subln_g, fox_forget_b, gdn_conv_w, gdn_a_log, gdn_dt_bias,
                  gdn_norm_g, w_out, lambda_init, key_valid):
    proj = h @ w_in
    dq, dk, dv, fq, fk, fv, ff, gqkv, gb, ga, gz = jnp.split(proj, _split_points(), axis=-1)
    y_diff = _differential_attention(dq, dk, dv, diff_lambda, diff_subln_g, lambda_init, key_valid)
    y_fox = _forgetting_attention(fq, fk, fv, ff, fox_forget_b, key_valid)
    y_gdn = _gated_deltanet(gqkv, gb, ga, gz, gdn_conv_w, gdn_a_log, gdn_dt_bias, gdn_norm_g)
    return jnp.concatenate([y_diff, y_fox, y_gdn], axis=-1) @ w_out


def _moe_ffn(h, router_w, router_b, w1, b1, w2, b2):
    b, l, d = h.shape
    xt = h.reshape(-1, d)
    t = xt.shape[0]
    logits = (xt @ router_w + router_b).astype(jnp.float32)
    top_val, top_idx = lax.top_k(logits, TOP_K)
    gate = jax.nn.softmax(top_val, axis=-1)
    e_flat = top_idx.reshape(-1)
    tok_flat = jnp.arange(t * TOP_K) // TOP_K
    order = jnp.argsort(e_flat)
    e_sorted = e_flat[order]
    counts = jnp.bincount(e_flat, length=N_EXPERTS)
    padded = (counts + MOE_BLOCK - 1) // MOE_BLOCK * MOE_BLOCK
    pad_end = jnp.cumsum(padded)
    pad_start = pad_end - padded
    start = jnp.cumsum(counts) - counts
    dest = pad_start[e_sorted] + jnp.arange(t * TOP_K) - start[e_sorted]
    n_slots = -(-(t * TOP_K + N_EXPERTS * (MOE_BLOCK - 1)) // MOE_BLOCK) * MOE_BLOCK
    n_blocks = n_slots // MOE_BLOCK
    slot_tok = jnp.full((n_slots,), t, jnp.int32).at[dest].set(tok_flat[order])
    slot_gate = jnp.zeros((n_slots,), jnp.float32).at[dest].set(gate.reshape(-1)[order])
    block_expert = jnp.minimum(jnp.searchsorted(pad_end, jnp.arange(n_blocks) * MOE_BLOCK, side='right'),
                               N_EXPERTS - 1)
    x_pad = jnp.concatenate([xt, jnp.zeros((1, d), xt.dtype)], axis=0)
    xs = x_pad[slot_tok].reshape(n_blocks, MOE_BLOCK, d)

    def expert_block(args):
        xb, e = args
        hid = xb @ w1[e] + b1[e]
        glu, lin = jnp.split(hid, 2, axis=-1)
        glu = jnp.minimum(glu, SWIGLU_LIMIT)
        lin = jnp.clip(lin, -SWIGLU_LIMIT, SWIGLU_LIMIT)
        act = glu * jax.nn.sigmoid(SWIGLU_ALPHA * glu) * (lin + 1.0)
        return act @ w2[e] + b2[e]

    ys = lax.map(expert_block, (xs, block_expert)).reshape(n_slots, d)
    out = jnp.zeros((t + 1, d), ys.dtype).at[slot_tok].add(ys * slot_gate[:, None].astype(ys.dtype))
    return out[:t].reshape(b, l, d)


def setup_inputs(seed: int = 0) -> dict:
    key = jax.random.key(seed)
    ks = jax.random.split(key, 23)
    f32 = jnp.float32

    def normal(k, shape, scale):
        return jax.random.normal(k, shape, f32) * scale

    x = normal(ks[0], (BATCH, SEQ, D_MODEL), 1.0)
    meta_tokens = normal(ks[1], (N_META, D_MODEL), 1.0)
    ln_in_g = 1.0 + normal(ks[2], (D_MODEL,), 0.02)
    ln_in_b = normal(ks[3], (D_MODEL,), 0.02)
    w_in = normal(ks[4], (DEPTH, D_MODEL, N_PROJ), D_MODEL ** -0.5) * jnp.asarray(_in_proj_column_scale())
    diff_lambda = normal(ks[5], (DEPTH, 4, DIFF_QK_DIM), 0.1)
    diff_subln_g = 1.0 + normal(ks[6], (DEPTH, DIFF_V_DIM), 0.02)
    fox_forget_b = FOX_FORGET_BIAS + normal(ks[7], (DEPTH, FOX_HEADS), 0.1)
    gdn_conv_w = normal(ks[8], (DEPTH, CONV_K, GDN_CONV_CH), CONV_K ** -0.5)
    gdn_a_log = jnp.log(jax.random.uniform(ks[9], (DEPTH, GDN_HEADS), f32, 1.0, 16.0))
    dt = jnp.exp(jax.random.uniform(ks[10], (DEPTH, GDN_HEADS), f32, math.log(1e-3), math.log(0.1)))
    gdn_dt_bias = dt + jnp.log(-jnp.expm1(-dt))
    gdn_norm_g = 1.0 + normal(ks[11], (DEPTH, GDN_HEAD_DIM), 0.02)
    w_out = normal(ks[12], (DEPTH, MIX_WIDTH, D_MODEL), MIX_WIDTH ** -0.5 * DEEPNORM_BETA)
    ln1_g = 1.0 + normal(ks[13], (DEPTH, D_MODEL), 0.02)
    ln1_b = normal(ks[14], (DEPTH, D_MODEL), 0.02)
    router_w = normal(ks[15], (DEPTH, D_MODEL, N_EXPERTS), D_MODEL ** -0.5)
    router_b = normal(ks[16], (DEPTH, N_EXPERTS), 0.01)
    expert_w1 = normal(ks[17], (DEPTH, N_EXPERTS, D_MODEL, 2 * D_EXPERT), D_MODEL ** -0.5 * DEEPNORM_BETA)
    expert_b1 = normal(ks[18], (DEPTH, N_EXPERTS, 2 * D_EXPERT), 0.02)
    expert_w2 = normal(ks[19], (DEPTH, N_EXPERTS, D_EXPERT, D_MODEL), D_EXPERT ** -0.5 * DEEPNORM_BETA)
    expert_b2 = normal(ks[20], (DEPTH, N_EXPERTS, D_MODEL), 0.02)
    ln2_g = 1.0 + normal(ks[21], (DEPTH, D_MODEL), 0.02)
    ln2_b = normal(ks[22], (DEPTH, D_MODEL), 0.02)
    return {'x': x, 'meta_tokens': meta_tokens, 'ln_in_g': ln_in_g, 'ln_in_b': ln_in_b, 'w_in': w_in,
            'diff_lambda': diff_lambda, 'diff_subln_g': diff_subln_g, 'fox_forget_b': fox_forget_b,
            'gdn_conv_w': gdn_conv_w, 'gdn_a_log': gdn_a_log, 'gdn_dt_bias': gdn_dt_bias,
            'gdn_norm_g': gdn_norm_g, 'w_out': w_out, 'ln1_g': ln1_g, 'ln1_b': ln1_b,
            'router_w': router_w, 'router_b': router_b, 'expert_w1': expert_w1, 'expert_b1': expert_b1,
            'expert_w2': expert_w2, 'expert_b2': expert_b2, 'ln2_g': ln2_g, 'ln2_b': ln2_b}


def reference(x, meta_tokens, ln_in_g, ln_in_b, w_in, diff_lambda, diff_subln_g, fox_forget_b, gdn_conv_w,
              gdn_a_log, gdn_dt_bias, gdn_norm_g, w_out, ln1_g, ln1_b, router_w, router_b, expert_w1,
              expert_b1, expert_w2, expert_b2, ln2_g, ln2_b):
    b, s, d = x.shape
    n_lead = (-(s + N_META)) % Q_BLOCK
    l = n_lead + N_META + s
    stream = jnp.concatenate([jnp.zeros((b, n_lead, d), x.dtype),
                              jnp.broadcast_to(meta_tokens.astype(x.dtype)[None], (b, N_META, d)),
                              x], axis=1)
    stream = _layer_norm(stream, ln_in_g, ln_in_b)
    key_valid = jnp.arange(l) >= n_lead
    in_mask = key_valid[None, :, None].astype(x.dtype)
    for layer in range(DEPTH):
        mix = _hybrid_mixer(stream * in_mask, w_in[layer], diff_lambda[layer], diff_subln_g[layer],
                            fox_forget_b[layer], gdn_conv_w[layer], gdn_a_log[layer], gdn_dt_bias[layer],
                            gdn_norm_g[layer], w_out[layer], _diff_lambda_init(layer), key_valid)
        stream = _layer_norm(DEEPNORM_ALPHA * stream + mix, ln1_g[layer], ln1_b[layer])
        ffn = _moe_ffn(stream, router_w[layer], router_b[layer], expert_w1[layer], expert_b1[layer],
                       expert_w2[layer], expert_b2[layer])
        stream = _layer_norm(DEEPNORM_ALPHA * stream + ffn, ln2_g[layer], ln2_b[layer])
    return stream[:, n_lead + N_META:]
```

```cpp
#include <hip/hip_runtime.h>
#include <cstdio>
#include <cstdint>
#include <cmath>

constexpr int NB = 2, SEQ = 8192, DM = 1024, NLEAD = 112, NMETA = 16, LL = 8320;
constexpr int LP = 8320, MP = NB * LP;
constexpr int NPROJ = 3340;
constexpr int C_DQ = 0, C_DK = 512, C_DV = 1024, C_FQ = 1536, C_FK = 1792, C_FV = 2048, C_FF = 2304, C_GQKV = 2308, C_GB = 3076, C_GA = 3080, C_GZ = 3084;
constexpr int NE = 32, TOPK = 4, DE = 1024;
constexpr float DN_ALPHA = 1.4142135623730951f;
constexpr int NSLOT = TOPK * MP;

#define WAVE_RED(OP) \
    v = OP(v, __int_as_float(__builtin_amdgcn_update_dpp(0, __float_as_int(v), 0xB1, 0xf, 0xf, true)));     \
    v = OP(v, __int_as_float(__builtin_amdgcn_update_dpp(0, __float_as_int(v), 0x4E, 0xf, 0xf, true)));     \
    v = OP(v, __int_as_float(__builtin_amdgcn_update_dpp(0, __float_as_int(v), 0x141, 0xf, 0xf, true)));    \
    v = OP(v, __int_as_float(__builtin_amdgcn_update_dpp(0, __float_as_int(v), 0x140, 0xf, 0xf, true)));    \
    v = OP(v, __int_as_float(__builtin_amdgcn_ds_swizzle(__float_as_int(v), 0x401F)));                      \
    { auto rr = __builtin_amdgcn_permlane32_swap(__float_as_uint(v), __float_as_uint(v), false, false); v = OP(__uint_as_float(rr[0]), __uint_as_float(rr[1])); }
__device__ __forceinline__ float wave_sum(float v) {
#define OPADD(a, b) ((a) + (b))
    WAVE_RED(OPADD)
#undef OPADD
    return v;
}
__device__ __forceinline__ float wave_max(float v) {
    WAVE_RED(fmaxf)
    return v;
}
__device__ __forceinline__ float shfl_up_l(float v, int o, int lane) { const float u = __int_as_float(__builtin_amdgcn_ds_bpermute(((lane - o) & 63) << 2, __float_as_int(v))); return u; }
__device__ __forceinline__ int shfl_up_li(int v, int o, int lane) { return __builtin_amdgcn_ds_bpermute(((lane - o) & 63) << 2, v); }
__device__ __forceinline__ float shfl_idx(float v, int idx) { return __int_as_float(__builtin_amdgcn_ds_bpermute(idx << 2, __float_as_int(v))); }
__device__ __forceinline__ bool row_valid(int t) { return t >= NLEAD && t < LL; }

__global__ __launch_bounds__(256) void k_ln_in(const float* __restrict__ x, const float* __restrict__ meta, const float* __restrict__ g, const float* __restrict__ bta, float* __restrict__ stream) {
    const int w = (blockIdx.x * 256 + threadIdx.x) >> 6, lane = threadIdx.x & 63;
    if (w >= NB * LL) return;
    const int b = w / LL, t = w % LL;
    const float* src = nullptr;
    if (t >= NLEAD + NMETA) src = x + ((size_t)b * SEQ + (t - NLEAD - NMETA)) * DM;
    else if (t >= NLEAD) src = meta + (size_t)(t - NLEAD) * DM;
    float4 v[4]; float s = 0.f;
#pragma unroll
    for (int j = 0; j < 4; ++j) { v[j] = src ? ((const float4*)src)[lane + 64 * j] : make_float4(0.f, 0.f, 0.f, 0.f); s += (v[j].x + v[j].y) + (v[j].z + v[j].w); }
    const float mean = wave_sum(s) * (1.f / DM); float q = 0.f;
#pragma unroll
    for (int j = 0; j < 4; ++j) { v[j].x -= mean; v[j].y -= mean; v[j].z -= mean; v[j].w -= mean; q += (v[j].x * v[j].x + v[j].y * v[j].y) + (v[j].z * v[j].z + v[j].w * v[j].w); }
    const float rstd = rsqrtf(wave_sum(q) * (1.f / DM) + 1e-5f);
    float4* o = (float4*)(stream + ((size_t)b * LP + t) * DM);
#pragma unroll
    for (int j = 0; j < 4; ++j) { const float4 gg = ((const float4*)g)[lane + 64 * j], bb = ((const float4*)bta)[lane + 64 * j];
        o[lane + 64 * j] = make_float4(v[j].x * rstd * gg.x + bb.x, v[j].y * rstd * gg.y + bb.y, v[j].z * rstd * gg.z + bb.z, v[j].w * rstd * gg.w + bb.w); }
}

struct NG {
    const float* A; int lda; const int* arow;
    const float* B; int ldb; size_t strideB;
    float* C; int ldc; int M, N, K;
    const int* Mdev; const int* offs;
    const float* bias; int strideBias;
};
template <int MODE> __global__ __launch_bounds__(256) void k_ngemm(NG p) {
    __shared__ float As[16][68]; __shared__ float Bs[16][64]; __shared__ float Bs2[MODE == 1 ? 16 : 1][64];
    const int z = blockIdx.z; const int M = p.Mdev ? p.Mdev[z] : p.M;
    const int m0 = blockIdx.y * 64, n0 = blockIdx.x * 64; if (m0 >= M) return;
    const int rowbase = p.offs ? p.offs[z] : 0;
    const float* B = p.B + (size_t)z * p.strideB;
    const int tid = threadIdx.x, lr = tid >> 2, lk = (tid & 3) * 4;
    const float* ap = nullptr;
    { const int r = m0 + lr; if (r < M) { int idx; if (MODE == 1) idx = p.arow[rowbase + r]; else if (MODE == 2) idx = rowbase + r; else idx = p.arow ? p.arow[r] : r; if (idx >= 0) ap = p.A + (size_t)idx * p.lda; } }
    const int bk = tid >> 4, bn = (tid & 15) * 4; const bool bok = (n0 + bn) < p.N;
    const int tx = tid & 15, ty = tid >> 4;
    float acc[4][4], acc2[4][4];
#pragma unroll
    for (int i = 0; i < 4; ++i)
#pragma unroll
        for (int j = 0; j < 4; ++j) { acc[i][j] = 0.f; acc2[i][j] = 0.f; }
    float4 av = ap ? *(const float4*)(ap + lk) : make_float4(0.f, 0.f, 0.f, 0.f);
    float4 bv = bok ? *(const float4*)(B + (size_t)bk * p.ldb + n0 + bn) : make_float4(0.f, 0.f, 0.f, 0.f);
    float4 bv2 = make_float4(0.f, 0.f, 0.f, 0.f);
    if (MODE == 1) bv2 = *(const float4*)(B + (size_t)bk * p.ldb + DE + n0 + bn);
    for (int k0 = 0; k0 < p.K; k0 += 16) {
        __syncthreads();
        As[lk + 0][lr] = av.x; As[lk + 1][lr] = av.y; As[lk + 2][lr] = av.z; As[lk + 3][lr] = av.w;
        *(float4*)&Bs[bk][bn] = bv; if (MODE == 1) *(float4*)&Bs2[bk][bn] = bv2;
        __syncthreads();
        if (k0 + 16 < p.K) {
            av = ap ? *(const float4*)(ap + k0 + 16 + lk) : make_float4(0.f, 0.f, 0.f, 0.f);
            bv = bok ? *(const float4*)(B + (size_t)(k0 + 16 + bk) * p.ldb + n0 + bn) : make_float4(0.f, 0.f, 0.f, 0.f);
            if (MODE == 1) bv2 = *(const float4*)(B + (size_t)(k0 + 16 + bk) * p.ldb + DE + n0 + bn);
        }
#pragma unroll
        for (int kk = 0; kk < 16; ++kk) {
            const float4 a = *(const float4*)&As[kk][ty * 4]; const float4 b = *(const float4*)&Bs[kk][tx * 4];
            const float aa[4] = {a.x, a.y, a.z, a.w}, bb[4] = {b.x, b.y, b.z, b.w};
#pragma unroll
            for (int i = 0; i < 4; ++i)
#pragma unroll
                for (int j = 0; j < 4; ++j) acc[i][j] += aa[i] * bb[j];
            if (MODE == 1) { const float4 b2 = *(const float4*)&Bs2[kk][tx * 4]; const float b2b[4] = {b2.x, b2.y, b2.z, b2.w};
#pragma unroll
                for (int i = 0; i < 4; ++i)
#pragma unroll
                    for (int j = 0; j < 4; ++j) acc2[i][j] += aa[i] * b2b[j]; }
        }
    }
#pragma unroll
    for (int i = 0; i < 4; ++i) { const int r = m0 + ty * 4 + i; if (r >= M) continue;
#pragma unroll
        for (int j = 0; j < 4; ++j) { const int n = n0 + tx * 4 + j; if (n >= p.N) continue;
            if (MODE == 0) p.C[(size_t)r * p.ldc + n] = acc[i][j];
            else if (MODE == 1) { const float* bs = p.bias + (size_t)z * p.strideBias; float glu = acc[i][j] + bs[n], lin = acc2[i][j] + bs[DE + n];
                glu = fminf(glu, 7.f); lin = fminf(fmaxf(lin, -7.f), 7.f); const float sg = 1.f / (1.f + expf(-1.702f * glu));
                p.C[(size_t)(rowbase + r) * p.ldc + n] = glu * sg * (lin + 1.f); }
            else { const float* bs = p.bias + (size_t)z * p.strideBias; p.C[(size_t)(rowbase + r) * p.ldc + n] = acc[i][j] + bs[n]; } }
    }
}

__global__ void k_rowmask(int* rm) { const int r = blockIdx.x * 256 + threadIdx.x; if (r < MP) rm[r] = row_valid(r % LP) ? r : -1; }

__global__ __launch_bounds__(64) void k_fox_cum(const float* __restrict__ proj, const float* __restrict__ fbias, float* __restrict__ cum) {
    const int b = blockIdx.x >> 2, h = blockIdx.x & 3, lane = threadIdx.x; double base = 0.0; const float fb = fbias[h];
    for (int t0 = 0; t0 < LL; t0 += 64) { const int t = t0 + lane; const float z = proj[((size_t)b * LP + t) * NPROJ + C_FF + h] + fb;
        float ls = fminf(z, 0.f) - log1pf(expf(-fabsf(z)));
#pragma unroll
        for (int o = 1; o < 64; o <<= 1) { const float u = __shfl_up(ls, o); if (lane >= o) ls += u; }
        cum[((size_t)b * 4 + h) * LP + t] = (float)(base + (double)ls); base += (double)__shfl(ls, 63); }
}

__global__ __launch_bounds__(64) void k_nattn(const float* __restrict__ proj, const float* __restrict__ cum, float* __restrict__ tmpA, float* __restrict__ mixcat) {
    __shared__ float Ks[64][64]; __shared__ float Vs[64][64];
    const int c = blockIdx.x, job = blockIdx.y, b = blockIdx.z, lane = threadIdx.x;
    int qcol, kcol, vcol, mode; float* out; int old; const float* cm = nullptr;
    if (job < 16) { const int h = job >> 2, s = (job >> 1) & 1, half = job & 1; qcol = C_DQ + h * 128 + s * 64; kcol = C_DK + h * 128 + s * 64; vcol = C_DV + h * 128 + half * 64; mode = 0;
        out = tmpA + (size_t)job * MP * 64; old = 64; }
    else { const int h = job - 16; qcol = C_FQ + h * 64; kcol = C_FK + h * 64; vcol = C_FV + h * 64; mode = 1; out = mixcat + 512 + h * 64; old = DM; cm = cum + ((size_t)b * 4 + h) * LP; }
    const int t = c * 64 + lane; const size_t row = (size_t)b * LP + t;
    float q[64], o[64];
#pragma unroll
    for (int d = 0; d < 64; d += 4) { const float4 v = *(const float4*)(proj + row * NPROJ + qcol + d); q[d] = v.x * 0.125f; q[d + 1] = v.y * 0.125f; q[d + 2] = v.z * 0.125f; q[d + 3] = v.w * 0.125f; }
#pragma unroll
    for (int d = 0; d < 64; ++d) o[d] = 0.f;
    float m = -1e30f, l = 0.f; const float cq = cm ? cm[t] : 0.f;
    for (int j = 1; j <= c; ++j) {
        __syncthreads();
        for (int it = 0; it < 16; ++it) { const int rr = it * 4 + (lane >> 4), cc = (lane & 15) * 4; const size_t kr = ((size_t)b * LP + j * 64 + rr) * NPROJ;
            *(float4*)&Ks[rr][cc] = *(const float4*)(proj + kr + kcol + cc); *(float4*)&Vs[rr][cc] = *(const float4*)(proj + kr + vcol + cc); }
        __syncthreads();
        for (int kk = 0; kk < 64; ++kk) { const int kt = j * 64 + kk; if (kt < NLEAD) continue; if (mode == 1 && kt > t) continue;
            float s = 0.f;
#pragma unroll
            for (int d = 0; d < 64; d += 4) { const float4 kv = *(const float4*)&Ks[kk][d]; s += q[d] * kv.x + q[d + 1] * kv.y + q[d + 2] * kv.z + q[d + 3] * kv.w; }
            if (mode == 1) s += cq - cm[kt];
            if (s > m) { const float corr = expf(m - s); l *= corr;
#pragma unroll
                for (int d = 0; d < 64; ++d) o[d] *= corr;
                m = s; }
            const float pp = expf(s - m); l += pp;
#pragma unroll
            for (int d = 0; d < 64; d += 4) { const float4 vv = *(const float4*)&Vs[kk][d]; o[d] += pp * vv.x; o[d + 1] += pp * vv.y; o[d + 2] += pp * vv.z; o[d + 3] += pp * vv.w; }
        }
    }
    const float inv = (l > 0.f && t >= NLEAD) ? 1.f / l : 0.f;
#pragma unroll
    for (int d = 0; d < 64; d += 4) *(float4*)(out + row * old + d) = make_float4(o[d] * inv, o[d + 1] * inv, o[d + 2] * inv, o[d + 3] * inv);
}

__global__ __launch_bounds__(256) void k_diff_combine(const float* __restrict__ tmpA, const float* __restrict__ lamv, const float* __restrict__ subg, float lam_init, float* __restrict__ mixcat) {
    const int w = (blockIdx.x * 256 + threadIdx.x) >> 6, lane = threadIdx.x & 63; if (w >= MP * 4) return;
    const int row = w >> 2, h = w & 3; const int t = row % LP;
    float d01 = lamv[lane] * lamv[64 + lane], d23 = lamv[128 + lane] * lamv[192 + lane];
    const float lam = expf(wave_sum(d01)) - expf(wave_sum(d23)) + lam_init;
    float o0 = 0.f, o1 = 0.f;
    if (t < LL) {
        const float a1lo = tmpA[((size_t)(h * 4 + 0) * MP + row) * 64 + lane], a1hi = tmpA[((size_t)(h * 4 + 1) * MP + row) * 64 + lane];
        const float a2lo = tmpA[((size_t)(h * 4 + 2) * MP + row) * 64 + lane], a2hi = tmpA[((size_t)(h * 4 + 3) * MP + row) * 64 + lane];
        o0 = a1lo - lam * a2lo; o1 = a1hi - lam * a2hi;
    }
    const float ms = wave_sum(o0 * o0 + o1 * o1) * (1.f / 128.f); const float r = rsqrtf(ms + 1e-5f) * (1.f - lam_init);
    mixcat[(size_t)row * DM + h * 128 + lane] = o0 * r * subg[lane]; mixcat[(size_t)row * DM + h * 128 + 64 + lane] = o1 * r * subg[64 + lane];
}

__global__ __launch_bounds__(256) void k_gdn_prep(const float* __restrict__ proj, const float* __restrict__ convw, const float* __restrict__ a_log, const float* __restrict__ dt_bias,
                                                  float* __restrict__ gq, float* __restrict__ gk, float* __restrict__ gv, float* __restrict__ gbeta, float* __restrict__ gg) {
    const int row = blockIdx.x, b = row / LP, t = row % LP, tid = threadIdx.x, h = tid >> 6;
    float val[3];
#pragma unroll
    for (int part = 0; part < 3; ++part) { const int ch = part * 256 + tid; float a = 0.f;
#pragma unroll
        for (int i = 0; i < 4; ++i) { const int tt = t - 3 + i; if (tt >= 0 && tt < LL) a += convw[i * 768 + ch] * proj[((size_t)b * LP + tt) * NPROJ + C_GQKV + ch]; }
        val[part] = a / (1.f + expf(-a)); }
    const float qn = rsqrtf(wave_sum(val[0] * val[0]) + 1e-6f) * 0.125f, kn = rsqrtf(wave_sum(val[1] * val[1]) + 1e-6f);
    gq[(size_t)row * 256 + tid] = val[0] * qn; gk[(size_t)row * 256 + tid] = val[1] * kn; gv[(size_t)row * 256 + tid] = val[2];
    if ((tid & 63) == 0) { const float bl = proj[(size_t)row * NPROJ + C_GB + h], al = proj[(size_t)row * NPROJ + C_GA + h] + dt_bias[h];
        const float sp = fmaxf(al, 0.f) + log1pf(expf(-fabsf(al)));
        gbeta[(size_t)row * 4 + h] = 1.f / (1.f + expf(-bl)); gg[(size_t)row * 4 + h] = -expf(a_log[h]) * sp; }
}
__global__ __launch_bounds__(64) void k_gdn_seq(const float* __restrict__ gq, const float* __restrict__ gk, const float* __restrict__ gv, const float* __restrict__ gbeta, const float* __restrict__ gg,
                                                const float* __restrict__ proj, const float* __restrict__ normg, float* __restrict__ mixcat) {
    __shared__ float Kt[64][64]; __shared__ float Qt[64][64]; __shared__ float Vt[64][64]; __shared__ float bg[64][2];
    const int b = blockIdx.x >> 2, h = blockIdx.x & 3, j = threadIdx.x;
    float S[64];
#pragma unroll
    for (int i = 0; i < 64; ++i) S[i] = 0.f;
    const float ng = normg[j];
    for (int c = 1; c < LL / 64; ++c) {
        __syncthreads();
        for (int it = 0; it < 16; ++it) { const int rr = it * 4 + (j >> 4), cc = (j & 15) * 4; const size_t r = (size_t)b * LP + c * 64 + rr;
            *(float4*)&Kt[rr][cc] = *(const float4*)(gk + r * 256 + h * 64 + cc); *(float4*)&Qt[rr][cc] = *(const float4*)(gq + r * 256 + h * 64 + cc); *(float4*)&Vt[rr][cc] = *(const float4*)(gv + r * 256 + h * 64 + cc); }
        { const size_t r = (size_t)b * LP + c * 64 + j; bg[j][0] = gbeta[r * 4 + h]; bg[j][1] = expf(gg[r * 4 + h]); }
        __syncthreads();
        for (int tt = 0; tt < 64; ++tt) { const size_t r = (size_t)b * LP + c * 64 + tt;
            const float vj = Vt[tt][j];
            const float beta = bg[tt][0], dec = bg[tt][1]; float rr = 0.f;
#pragma unroll
            for (int i = 0; i < 64; i += 4) { const float4 kv = *(const float4*)&Kt[tt][i]; S[i] *= dec; S[i + 1] *= dec; S[i + 2] *= dec; S[i + 3] *= dec;
                rr += S[i] * kv.x + S[i + 1] * kv.y + S[i + 2] * kv.z + S[i + 3] * kv.w; }
            const float coef = beta * (vj - rr); float oj = 0.f;
#pragma unroll
            for (int i = 0; i < 64; i += 4) { const float4 kv = *(const float4*)&Kt[tt][i]; const float4 qv = *(const float4*)&Qt[tt][i];
                S[i] += coef * kv.x; S[i + 1] += coef * kv.y; S[i + 2] += coef * kv.z; S[i + 3] += coef * kv.w;
                oj += S[i] * qv.x + S[i + 1] * qv.y + S[i + 2] * qv.z + S[i + 3] * qv.w; }
            const float ms = wave_sum(oj * oj) * (1.f / 64.f);
            mixcat[r * DM + 768 + h * 64 + j] = oj * rsqrtf(ms + 1e-6f) * ng;
        }
    }
}
__global__ __launch_bounds__(256) void k_gdn_gate(const float* __restrict__ proj, float* __restrict__ mixcat) {
    const int row = blockIdx.x, c = threadIdx.x; const int t = row % LP; if (t < 64 || t >= LL) return;
    const float z = proj[(size_t)row * NPROJ + C_GZ + c]; mixcat[(size_t)row * DM + 768 + c] *= z / (1.f + expf(-z));
}
__global__ __launch_bounds__(256) void k_zero_pad_rows(float* __restrict__ buf) {
    const int w = (blockIdx.x * 256 + threadIdx.x) >> 6, lane = threadIdx.x & 63; if (w >= MP) return; const int t = w % LP; if (t >= 64 && t < LL) return;
    float4* o = (float4*)(buf + (size_t)w * DM);
#pragma unroll
    for (int j = 0; j < 4; ++j) o[lane + 64 * j] = make_float4(0.f, 0.f, 0.f, 0.f);
}

__global__ __launch_bounds__(256) void k_ln1_route(const float* __restrict__ stream, const float* __restrict__ mix, const float* __restrict__ g, const float* __restrict__ bta,
                                                   const float* __restrict__ rw, const float* __restrict__ rb, float* __restrict__ x1, int* __restrict__ topidx, float* __restrict__ gate, int* __restrict__ pos, int* __restrict__ cnt) {
    __shared__ float xs[4][DM];
    const int wv = threadIdx.x >> 6, row = blockIdx.x * 4 + wv, lane = threadIdx.x & 63; if (row >= MP) return; const int t = row % LP;
    float4* o = (float4*)(x1 + (size_t)row * DM);
    if (!row_valid(t)) {
#pragma unroll
        for (int j = 0; j < 4; ++j) o[lane + 64 * j] = make_float4(0.f, 0.f, 0.f, 0.f);
        return; }
    float4 v[4]; float s = 0.f;
#pragma unroll
    for (int j = 0; j < 4; ++j) { const float4 a = ((const float4*)(stream + (size_t)row * DM))[lane + 64 * j], m = ((const float4*)(mix + (size_t)row * DM))[lane + 64 * j];
        v[j] = make_float4(DN_ALPHA * a.x + m.x, DN_ALPHA * a.y + m.y, DN_ALPHA * a.z + m.z, DN_ALPHA * a.w + m.w); s += (v[j].x + v[j].y) + (v[j].z + v[j].w); }
    const float mean = wave_sum(s) * (1.f / DM); float q = 0.f;
#pragma unroll
    for (int j = 0; j < 4; ++j) { v[j].x -= mean; v[j].y -= mean; v[j].z -= mean; v[j].w -= mean; q += (v[j].x * v[j].x + v[j].y * v[j].y) + (v[j].z * v[j].z + v[j].w * v[j].w); }
    const float rstd = rsqrtf(wave_sum(q) * (1.f / DM) + 1e-5f);
#pragma unroll
    for (int j = 0; j < 4; ++j) { const float4 gg = ((const float4*)g)[lane + 64 * j], bb = ((const float4*)bta)[lane + 64 * j];
        const float4 r = make_float4(v[j].x * rstd * gg.x + bb.x, v[j].y * rstd * gg.y + bb.y, v[j].z * rstd * gg.z + bb.z, v[j].w * rstd * gg.w + bb.w);
        o[lane + 64 * j] = r; *(float4*)&xs[wv][(lane + 64 * j) * 4] = r; }
    asm volatile("s_waitcnt lgkmcnt(0)" ::: "memory");
    const int e = lane & 31, half = lane >> 5; float acc = 0.f;
    for (int k = half * 512; k < half * 512 + 512; ++k) acc += xs[wv][k] * rw[(size_t)k * NE + e];
    acc += __shfl_xor(acc, 32); acc += rb[e];
    float val = acc; float tv[4]; int ti[4];
#pragma unroll
    for (int k = 0; k < 4; ++k) { const float mx = wave_max(val); const unsigned long long bal = __ballot(val == mx); const int win = (int)(__ffsll((long long)(bal & 0xffffffffull)) - 1);
        tv[k] = mx; ti[k] = win; if (e == win) val = -INFINITY; }
    const float e0 = 1.f, e1 = expf(tv[1] - tv[0]), e2 = expf(tv[2] - tv[0]), e3 = expf(tv[3] - tv[0]); const float inv = 1.f / (e0 + e1 + e2 + e3);
    if (lane < 4) { const float gt = (lane == 0 ? e0 : lane == 1 ? e1 : lane == 2 ? e2 : e3) * inv; const int ex = lane == 0 ? ti[0] : lane == 1 ? ti[1] : lane == 2 ? ti[2] : ti[3];
        topidx[(size_t)row * 4 + lane] = ex; gate[(size_t)row * 4 + lane] = gt; pos[(size_t)row * 4 + lane] = atomicAdd(&cnt[ex], 1); }
}
__global__ void k_offsets(const int* __restrict__ cnt, int* __restrict__ offs) { if (threadIdx.x == 0) { int a = 0; for (int e = 0; e < NE; ++e) { offs[e] = a; a += cnt[e]; } offs[NE] = a; } }
__global__ void k_fill_slots(const int* __restrict__ topidx, const int* __restrict__ pos, const int* __restrict__ offs, int* __restrict__ slot_tok, int* __restrict__ tokslot) {
    const int i = blockIdx.x * 256 + threadIdx.x; if (i >= MP * 4) return; const int row = i >> 2; if (!row_valid(row % LP)) return;
    const int s = offs[topidx[i]] + pos[i]; slot_tok[s] = row; tokslot[i] = s;
}
__global__ __launch_bounds__(256) void k_combine_ln2(const float* __restrict__ x1, const float* __restrict__ y, const int* __restrict__ tokslot, const float* __restrict__ gate,
                                                     const float* __restrict__ g, const float* __restrict__ bta, float* __restrict__ stream, float* __restrict__ out) {
    const int row = (blockIdx.x * 256 + threadIdx.x) >> 6, lane = threadIdx.x & 63; if (row >= MP) return; const int t = row % LP, b = row / LP;
    float4* o = (float4*)(stream + (size_t)row * DM);
    if (!row_valid(t)) {
#pragma unroll
        for (int j = 0; j < 4; ++j) o[lane + 64 * j] = make_float4(0.f, 0.f, 0.f, 0.f);
        return; }
    float4 v[4];
#pragma unroll
    for (int j = 0; j < 4; ++j) { const float4 a = ((const float4*)(x1 + (size_t)row * DM))[lane + 64 * j]; v[j] = make_float4(DN_ALPHA * a.x, DN_ALPHA * a.y, DN_ALPHA * a.z, DN_ALPHA * a.w); }
    for (int k = 0; k < 4; ++k) { const int s = tokslot[(size_t)row * 4 + k]; const float gt = gate[(size_t)row * 4 + k];
#pragma unroll
        for (int j = 0; j < 4; ++j) { const float4 a = ((const float4*)(y + (size_t)s * DM))[lane + 64 * j]; v[j].x += gt * a.x; v[j].y += gt * a.y; v[j].z += gt * a.z; v[j].w += gt * a.w; } }
    float s = 0.f;
#pragma unroll
    for (int j = 0; j < 4; ++j) s += (v[j].x + v[j].y) + (v[j].z + v[j].w);
    const float mean = wave_sum(s) * (1.f / DM); float q = 0.f;
#pragma unroll
    for (int j = 0; j < 4; ++j) { v[j].x -= mean; v[j].y -= mean; v[j].z -= mean; v[j].w -= mean; q += (v[j].x * v[j].x + v[j].y * v[j].y) + (v[j].z * v[j].z + v[j].w * v[j].w); }
    const float rstd = rsqrtf(wave_sum(q) * (1.f / DM) + 1e-5f);
    float4* oo = (out && t >= NLEAD + NMETA) ? (float4*)(out + ((size_t)b * SEQ + (t - NLEAD - NMETA)) * DM) : nullptr;
#pragma unroll
    for (int j = 0; j < 4; ++j) { const float4 gg = ((const float4*)g)[lane + 64 * j], bb = ((const float4*)bta)[lane + 64 * j];
        const float4 r = make_float4(v[j].x * rstd * gg.x + bb.x, v[j].y * rstd * gg.y + bb.y, v[j].z * rstd * gg.z + bb.z, v[j].w * rstd * gg.w + bb.w);
        o[lane + 64 * j] = r; if (oo) oo[lane + 64 * j] = r; }
}

#define LAS __attribute__((address_space(3)))
#define GAS __attribute__((address_space(1)))
typedef unsigned short bf16_t;
typedef short bf16x8 __attribute__((ext_vector_type(8)));
typedef float f32x4 __attribute__((ext_vector_type(4)));
typedef float f32x2 __attribute__((ext_vector_type(2)));
typedef unsigned u32x4 __attribute__((ext_vector_type(4)));
typedef unsigned u32x2 __attribute__((ext_vector_type(2)));

constexpr int NPJ = 3328;
constexpr int P_DQ = 0, P_DK = 512, P_DV = 1024, P_FQ = 1536, P_FK = 1792, P_FV = 2048, P_GQKV = 2304, P_GZ = 3072;
constexpr float QK_C2 = 0.125f * 1.4426950408889634f;
constexpr int NWAVES = 8, NTHR = 512;
constexpr int PMAX = 320;
constexpr int FILL_ROW = NLEAD;

__device__ __forceinline__ unsigned cvt_pk_bf16(float lo, float hi) { unsigned r; asm volatile("v_cvt_pk_bf16_f32 %0, %1, %2" : "=v"(r) : "v"(lo), "v"(hi)); return r; }
typedef __bf16 bf16x2_nat __attribute__((ext_vector_type(2)));
__device__ __forceinline__ unsigned cvt_pk_bf16_m(float lo, float hi) { const f32x2 v = {lo, hi}; const bf16x2_nat b = __builtin_convertvector(v, bf16x2_nat); return __builtin_bit_cast(unsigned, b); }
__device__ __forceinline__ float bf2f(unsigned short h) { return __uint_as_float((unsigned)h << 16); }
__device__ __forceinline__ float bflo(unsigned w) { return __uint_as_float(w << 16); }
__device__ __forceinline__ float bfhi(unsigned w) { return __uint_as_float(w & 0xffff0000u); }

namespace pg8 {
constexpr int BM = 256, BK = 64, HALF = 128, HTB = HALF * BK * 2, STAGE_BYTES = 8 * HTB;
__host__ __device__ __forceinline__ int lds_byte(int r, int c) { const int st = (r >> 4) * 2 + (c >> 5), rr = r & 15, cc = c & 31, ob = rr * 64 + cc * 2; return st * 1024 + (ob ^ (((ob >> 9) & 1) << 5)); }
__host__ __device__ __forceinline__ void stage_rc(int b, int& R, int& C) { const int st = b / 1024, sb = b % 1024, swz = sb ^ (((sb >> 9) & 1) << 5); R = (st >> 1) * 16 + swz / 64; C = (st & 1) * 32 + (swz % 64) / 2; }
__host__ __device__ __forceinline__ int perm32(int rho) { const int n = rho >> 4, i = rho & 15; return 8 * (i >> 2) + 4 * n + (i & 3); }

struct Unit { int pm, pn, e; };
struct Gemm { const bf16_t* A; const bf16_t* Bt; int K; size_t bstride_e; };

struct DenseOrder {
    int nM, nN, nwg, G, c;
    __device__ void init(int nM_, int nN_, int G_, int c_) { nM = nM_; nN = nN_; nwg = nM * nN; G = G_; c = c_; }
    __device__ bool next(int i, Unit& u) const {
        const long L = (long)i * G + c; if (L >= nwg) return false;
        int wgid = (int)L; { const int q = nwg / 8, r = nwg % 8, xcd = wgid % 8, off = wgid / 8; wgid = (xcd < r ? xcd * (q + 1) : r * (q + 1) + (xcd - r) * q) + off; }
        const int nig = 8 * nN, gid = wgid / nig, fm = gid * 8, gsz = (nM - fm) < 8 ? (nM - fm) : 8;
        u.pm = fm + ((wgid % nig) % gsz); u.pn = (wgid % nig) / gsz; u.e = 0; return true;
    }
    __device__ void rows(const Unit&, const int*& list, int& nvalid) const { list = nullptr; nvalid = 0; }
};
struct ExpertOrder {
    const volatile LAS int* tab;
    const int* cnt; const int* etok; int nN, G, c;
    __device__ bool next(int i, Unit& u) const {
        const int L = i * G + c; const int P = __builtin_amdgcn_readfirstlane(tab[0]); if (L >= P * nN) return false;
        u.pm = L / nN; u.pn = L % nN; u.e = __builtin_amdgcn_readfirstlane(tab[40 + u.pm]); return true;
    }
    __device__ void rows(const Unit& u, const int*& list, int& nvalid) const {
        const int lt = u.pm - __builtin_amdgcn_readfirstlane(tab[1 + u.e]); list = etok + (size_t)u.e * MP + lt * 256; int nv = __builtin_amdgcn_readfirstlane(cnt[u.e * 32]) - lt * 256; nvalid = nv > 256 ? 256 : nv;
    }
};

struct EpiStoreBf16 {
    static constexpr bool PERM = true;
    bf16_t* O; int ldc; const float* bias; int bias_stride;
    struct Pre { f32x4 bv[2][2]; };
    __device__ __forceinline__ void prefetch(Pre& pre, const Unit& u, int wc, int fq) const {
        const int col0 = u.pn * BM + wc * 32 + 8 * fq;
#pragma unroll
        for (int bj = 0; bj < 2; ++bj)
#pragma unroll
            for (int n = 0; n < 2; ++n) pre.bv[bj][n] = bias ? *(const f32x4*)(bias + (size_t)u.e * bias_stride + col0 + bj * HALF + 4 * n) : (f32x4){0.f, 0.f, 0.f, 0.f};
    }
    __device__ __forceinline__ void operator()(const f32x4 (&acc)[2][2][4][2], const Unit& u, int wr, int wc, int fr, int fq, const Pre& pre) const {
        const int row0 = u.pm * BM + wr * 64 + fr, col0 = u.pn * BM + wc * 32 + 8 * fq;
        f32x4 bv[2][2];
#pragma unroll
        for (int bj = 0; bj < 2; ++bj)
#pragma unroll
            for (int n = 0; n < 2; ++n) bv[bj][n] = pre.bv[bj][n];
#pragma unroll
        for (int ai = 0; ai < 2; ++ai)
#pragma unroll
            for (int m = 0; m < 4; ++m) { bf16_t* rowp = O + (size_t)(row0 + ai * HALF + m * 16) * ldc + col0;
#pragma unroll
                for (int bj = 0; bj < 2; ++bj) { const f32x4 v0 = acc[ai][bj][m][0] + bv[bj][0], v1 = acc[ai][bj][m][1] + bv[bj][1];
                    u32x4 w; w.x = cvt_pk_bf16(v0[0], v0[1]); w.y = cvt_pk_bf16(v0[2], v0[3]); w.z = cvt_pk_bf16(v1[0], v1[1]); w.w = cvt_pk_bf16(v1[2], v1[3]);
                    *(u32x4*)(rowp + bj * HALF) = w; } }
    }
};
struct EpiSwiglu {
    static constexpr bool PERM = true;
    bf16_t* O; const float* bias;
    __device__ __forceinline__ static float sw(float g, float l) { g = fminf(g, 7.f); l = fminf(fmaxf(l, -7.f), 7.f); const float sg = __builtin_amdgcn_rcpf(1.f + __builtin_amdgcn_exp2f(-1.702f * 1.4426950408889634f * g)); return g * sg * (l + 1.f); }
    struct Pre { f32x4 bg[2], bl[2]; };
    __device__ __forceinline__ void prefetch(Pre& pre, const Unit& u, int wc, int fq) const {
        const int c0 = u.pn * HALF + wc * 32 + 8 * fq; const float* bs = bias + (size_t)u.e * 2048;
#pragma unroll
        for (int n = 0; n < 2; ++n) { pre.bg[n] = *(const f32x4*)(bs + c0 + 4 * n); pre.bl[n] = *(const f32x4*)(bs + 1024 + c0 + 4 * n); }
    }
    __device__ __forceinline__ void operator()(const f32x4 (&acc)[2][2][4][2], const Unit& u, int wr, int wc, int fr, int fq, const Pre& pre) const {
        const int row0 = u.pm * BM + wr * 64 + fr, c0 = u.pn * HALF + wc * 32 + 8 * fq;
        f32x4 bg[2], bl[2];
#pragma unroll
        for (int n = 0; n < 2; ++n) { bg[n] = pre.bg[n]; bl[n] = pre.bl[n]; }
#pragma unroll
        for (int ai = 0; ai < 2; ++ai)
#pragma unroll
            for (int m = 0; m < 4; ++m) { float o[8];
#pragma unroll
                for (int n = 0; n < 2; ++n) { const f32x4 g = acc[ai][0][m][n] + bg[n], l = acc[ai][1][m][n] + bl[n];
#pragma unroll
                    for (int i = 0; i < 4; ++i) o[4 * n + i] = sw(g[i], l[i]); }
                u32x4 w; w.x = cvt_pk_bf16(o[0], o[1]); w.y = cvt_pk_bf16(o[2], o[3]); w.z = cvt_pk_bf16(o[4], o[5]); w.w = cvt_pk_bf16(o[6], o[7]);
                *(u32x4*)(O + (size_t)(row0 + ai * HALF + m * 16) * 1024 + c0) = w; }
    }
};
struct EpiResid {
    static constexpr bool PERM = true;
    bf16_t* S; const bf16_t* R; int ldc; float alpha;
    struct Pre {};
    __device__ __forceinline__ void prefetch(Pre&, const Unit&, int, int) const {}
    __device__ __forceinline__ void operator()(const f32x4 (&acc)[2][2][4][2], const Unit& u, int wr, int wc, int fr, int fq, const Pre&) const {
        const int row0 = u.pm * BM + wr * 64 + fr, col0 = u.pn * BM + wc * 32 + 8 * fq;
#pragma unroll
        for (int ai = 0; ai < 2; ++ai)
#pragma unroll
            for (int m = 0; m < 4; ++m) { const size_t ro = (size_t)(row0 + ai * HALF + m * 16) * ldc + col0;
#pragma unroll
                for (int bj = 0; bj < 2; ++bj) { const u32x4 r = *(const u32x4*)(R + ro + bj * HALF);
                    const f32x4 x0 = {bflo(r.x), bfhi(r.x), bflo(r.y), bfhi(r.y)}, x1 = {bflo(r.z), bfhi(r.z), bflo(r.w), bfhi(r.w)};
                    const f32x4 v0 = x0 * alpha + acc[ai][bj][m][0], v1 = x1 * alpha + acc[ai][bj][m][1];
                    u32x4 w; w.x = cvt_pk_bf16(v0[0], v0[1]); w.y = cvt_pk_bf16(v0[2], v0[3]); w.z = cvt_pk_bf16(v1[0], v1[1]); w.w = cvt_pk_bf16(v1[2], v1[3]);
                    *(u32x4*)(S + ro + bj * HALF) = w; } }
    }
};

template <class Epi, class Sched, bool GATHER>
__device__ __forceinline__ void gemm_phase(LAS unsigned char* lds, const Gemm g, const Sched& S, const Epi& E, const int tid) {
    const int wid = __builtin_amdgcn_readfirstlane(tid >> 6), lane = tid & 63, wr = wid >> 2, wc = wid & 3, fr = lane & 15, fq = lane >> 4;
    const int K = g.K, nt = K / BK;
    int sR[2], sC[2]; unsigned voffB[2];
#pragma unroll
    for (int i = 0; i < 2; ++i) { stage_rc(tid * 16 + i * 8192, sR[i], sC[i]); const int Rb = Epi::PERM ? ((sR[i] & ~31) + perm32(sR[i] & 31)) : sR[i]; voffB[i] = (unsigned)(Rb * K + sC[i]) * 2u; }
    const size_t kstep = (size_t)(BK * 2);
    const size_t hstep = (size_t)HALF * K * 2;
    const size_t tstep = 2 * hstep;
    const unsigned ldsw = (unsigned)wid * 1024u;
    const int aoff = lds_byte(wr * 64 + fr, fq * 8), boff = lds_byte(wc * 32 + fr, fq * 8);
#define PG8_SA(b, h) (((b) * 2 + (h)) * HTB)
#define PG8_SB(b, h) ((4 + (b) * 2 + (h)) * HTB)
#define PG8_STAGE(bufoff, gbase, voff) do { _Pragma("unroll") for (int _i = 0; _i < 2; ++_i) \
        __builtin_amdgcn_global_load_lds((const unsigned*)((const char*)(gbase) + (voff)[_i]), (LAS unsigned*)(lds + (bufoff) + ldsw + _i * 8192), 16, 0, 0); } while (0)
#define PG8_LDA(dst, b, h) do { _Pragma("unroll") for (int m = 0; m < 4; ++m) _Pragma("unroll") for (int k = 0; k < 2; ++k) dst[m][k] = *(const LAS bf16x8*)(lds + PG8_SA(b, h) + aoff + m * 2048 + k * 1024); } while (0)
#define PG8_LDB(dst, b, h) do { _Pragma("unroll") for (int n = 0; n < 2; ++n) _Pragma("unroll") for (int k = 0; k < 2; ++k) dst[n][k] = *(const LAS bf16x8*)(lds + PG8_SB(b, h) + boff + n * 2048 + k * 1024); } while (0)
#define PG8_MMA(ai, bj, At, Bt) do { __builtin_amdgcn_s_setprio(1); _Pragma("unroll") for (int m = 0; m < 4; ++m) _Pragma("unroll") for (int n = 0; n < 2; ++n) _Pragma("unroll") for (int k = 0; k < 2; ++k) \
        acc[ai][bj][m][n] = __builtin_amdgcn_mfma_f32_16x16x32_bf16(Bt[n][k], At[m][k], acc[ai][bj][m][n], 0, 0, 0); __builtin_amdgcn_s_setprio(0); } while (0)
#define PG8_WAIT_V(n) asm volatile("s_waitcnt vmcnt(" #n ")" ::: "memory")
#define PG8_WAIT_L(n) asm volatile("s_waitcnt lgkmcnt(" #n ")" ::: "memory")
#define PG8_BAR __builtin_amdgcn_s_barrier()
#define PG8_SCHED __builtin_amdgcn_sched_barrier(0)
#define PG8_AOFFS(dst, u_) do { if (GATHER) { const int* _l; int _nv; S.rows(u_, _l, _nv); _Pragma("unroll") for (int _h = 0; _h < 2; ++_h) _Pragma("unroll") for (int _i = 0; _i < 2; ++_i) { \
            const int _r = sR[_i] + 128 * _h; const int _t = _r < _nv ? _l[_r] : FILL_ROW; dst[_h][_i] = (unsigned)(_t * K + sC[_i]) * 2u; } } \
        else { _Pragma("unroll") for (int _h = 0; _h < 2; ++_h) _Pragma("unroll") for (int _i = 0; _i < 2; ++_i) dst[_h][_i] = (unsigned)((sR[_i] + 128 * _h) * K + sC[_i]) * 2u; } } while (0)
#define PG8_ABASE(u_) (GATHER ? (const char*)g.A : (const char*)g.A + (size_t)(u_).pm * tstep)
#define PG8_BBASE(u_) ((const char*)g.Bt + ((size_t)(u_).e * g.bstride_e) * 2 + (size_t)(u_).pn * tstep)
    Unit cur, nxt; int ui = 0; typename Epi::Pre pre;
    if (!S.next(0, cur)) return;
    f32x4 acc[2][2][4][2];
#pragma unroll
    for (int a = 0; a < 2; ++a)
#pragma unroll
        for (int b = 0; b < 2; ++b)
#pragma unroll
            for (int m = 0; m < 4; ++m)
#pragma unroll
                for (int n = 0; n < 2; ++n) acc[a][b][m][n] = (f32x4){0.f, 0.f, 0.f, 0.f};
    bf16x8 At[4][2], B0[2][2], B1[2][2];
    unsigned cva[2][2], nva[2][2];
    PG8_AOFFS(cva, cur);
    const char* cA = PG8_ABASE(cur); const char* cB = PG8_BBASE(cur);
    PG8_STAGE(PG8_SB(0, 0), cB, voffB); PG8_STAGE(PG8_SB(0, 1), cB + hstep, voffB); PG8_STAGE(PG8_SA(0, 0), cA, cva[0]); PG8_STAGE(PG8_SA(0, 1), cA, cva[1]);
    if (wr == 1) PG8_BAR;
    PG8_WAIT_V(2); PG8_BAR;
    PG8_STAGE(PG8_SB(1, 0), cB + kstep, voffB); PG8_STAGE(PG8_SA(1, 0), cA + kstep, cva[0]); PG8_STAGE(PG8_SB(1, 1), cB + hstep + kstep, voffB);
    PG8_WAIT_V(6); PG8_BAR;
    for (;;) {
        const bool has_next = S.next(ui + 1, nxt);
        if (GATHER) { if (has_next) { PG8_AOFFS(nva, nxt); } else {
#pragma unroll
            for (int h = 0; h < 2; ++h)
#pragma unroll
                for (int i = 0; i < 2; ++i) nva[h][i] = cva[h][i]; } }
        const char* nA = has_next ? PG8_ABASE(nxt) : cA; const char* nB = has_next ? PG8_BBASE(nxt) : cB;
        for (int t = 0; t < nt; t += 2) {
            const bool last = (t == nt - 2);
            const char* a1 = cA + (size_t)(t + 1) * kstep;
            const char* a2 = last ? nA : cA + (size_t)(t + 2) * kstep; const char* b2 = last ? nB : cB + (size_t)(t + 2) * kstep;
            const char* a3 = a2 + kstep; const char* b3 = b2 + kstep;
            unsigned va[2][2];
#pragma unroll
            for (int h = 0; h < 2; ++h)
#pragma unroll
                for (int i = 0; i < 2; ++i) va[h][i] = (GATHER && last) ? nva[h][i] : cva[h][i];
            PG8_LDB(B0, 0, 0); PG8_LDB(B1, 0, 1); PG8_SCHED; PG8_LDA(At, 0, 0); PG8_STAGE(PG8_SA(1, 1), a1, cva[1]);
            PG8_WAIT_V(8); PG8_WAIT_L(0); PG8_BAR; PG8_MMA(0, 0, At, B0); PG8_MMA(0, 1, At, B1); PG8_BAR; PG8_SCHED;
            PG8_LDA(At, 0, 1); PG8_STAGE(PG8_SB(0, 0), b2, voffB); PG8_STAGE(PG8_SB(0, 1), b2 + hstep, voffB); PG8_STAGE(PG8_SA(0, 0), a2, va[0]);
            PG8_WAIT_V(8); PG8_WAIT_L(0); PG8_BAR; PG8_MMA(1, 0, At, B0); PG8_MMA(1, 1, At, B1); PG8_BAR; PG8_SCHED;
            PG8_LDB(B0, 1, 0); PG8_LDB(B1, 1, 1); PG8_SCHED; PG8_LDA(At, 1, 0); PG8_STAGE(PG8_SA(0, 1), a2, va[1]);
            PG8_WAIT_V(8); PG8_WAIT_L(0); PG8_BAR; PG8_MMA(0, 0, At, B0); PG8_MMA(0, 1, At, B1); PG8_BAR; PG8_SCHED;
            PG8_LDA(At, 1, 1); PG8_STAGE(PG8_SB(1, 0), b3, voffB); PG8_STAGE(PG8_SB(1, 1), b3 + hstep, voffB); PG8_STAGE(PG8_SA(1, 0), a3, va[0]);
            PG8_WAIT_V(8); PG8_WAIT_L(0); PG8_BAR; PG8_MMA(1, 0, At, B0); PG8_MMA(1, 1, At, B1); PG8_BAR; PG8_SCHED;
        }
        E.prefetch(pre, cur, wc, fq);
        if (wr == 0) PG8_BAR;
        E(acc, cur, wr, wc, fr, fq, pre);
        if (!has_next) break;
#pragma unroll
        for (int a = 0; a < 2; ++a)
#pragma unroll
            for (int b = 0; b < 2; ++b)
#pragma unroll
                for (int m = 0; m < 4; ++m)
#pragma unroll
                    for (int n = 0; n < 2; ++n) acc[a][b][m][n] = (f32x4){0.f, 0.f, 0.f, 0.f};
        cur = nxt; cA = nA; cB = nB; ++ui;
        if (GATHER) {
#pragma unroll
        for (int h = 0; h < 2; ++h)
#pragma unroll
            for (int i = 0; i < 2; ++i) cva[h][i] = nva[h][i]; }
        if (wr == 1) PG8_BAR;
    }
    PG8_WAIT_V(0);
    PG8_BAR;
#undef PG8_SA
#undef PG8_SB
#undef PG8_STAGE
#undef PG8_LDA
#undef PG8_LDB
#undef PG8_MMA
#undef PG8_WAIT_V
#undef PG8_WAIT_L
#undef PG8_BAR
#undef PG8_SCHED
#undef PG8_AOFFS
#undef PG8_ABASE
#undef PG8_BBASE
}
}
constexpr int LDS_RING = 131072;
constexpr int LDS_TAB = LDS_RING;
constexpr int LDS_MISC = LDS_RING + 2048;
constexpr int LDS_BYTES = 147456;

struct MKP {
    const float *x, *meta, *ln_in_g, *ln_in_b, *w_in, *diff_lambda, *diff_subln_g, *fox_forget_b, *gdn_conv_w, *gdn_a_log, *gdn_dt_bias, *gdn_norm_g, *w_out, *ln1_g, *ln1_b,
        *router_w, *router_b, *w1, *b1, *w2, *b2, *ln2_g, *ln2_b;
    float* out;
    bf16_t *Win_t, *Wout_t, *W1_t, *W2_t;
    float* stream;
    bf16_t* actb;
    bf16_t* proj;
    float* gates;
    bf16_t* mixcat;
    bf16_t* act;
    bf16_t* ybuf;
    int* cnt;
    int* etok;
    int* tok_e; int* tok_pos; float* tok_gate;
    unsigned* ctl;
    bf16_t* tmpO;
    unsigned long long* Gk;
    float* wgc;
    float* rwT;
    float* Gf;
    float *fox_loc, *fox_tot;
    unsigned char* gch; float* gcd;
    float *gq, *gk, *gv, *gsc, *gdn_o;
    int ph_lo, ph_hi;
};

#define LDS_WAIT() asm volatile("s_waitcnt lgkmcnt(0)" ::: "memory")
#define VM_WAIT() asm volatile("s_waitcnt vmcnt(0)" ::: "memory")

typedef GAS unsigned gu32;
#define XB_TMO      128
#define XB_XCNT(j)  (256  + 64 * (j))
#define XB_XSUB(j)  (1280 + 64 * (j))
#define XB_XGEN(j)  (2304 + 64 * (j))
#define XB_TOP      3328
#define XB_TOPGEN   3392
#define XCD_BAR_WORDS 3456
#define XB_SPIN_CAP (1u << 18)

__device__ __forceinline__ unsigned xb_ld(unsigned* p)              { return __hip_atomic_load(p, __ATOMIC_RELAXED, __HIP_MEMORY_SCOPE_AGENT); }
__device__ __forceinline__ unsigned xb_add(unsigned* p, unsigned v) { return __hip_atomic_fetch_add(p, v, __ATOMIC_RELAXED, __HIP_MEMORY_SCOPE_AGENT); }
__device__ __forceinline__ unsigned xb_xcc_id() { return (unsigned)__builtin_amdgcn_s_getreg((3 << 11) | 20) & 0xFu; }
#define XB_SPIN(cond, bar) do { unsigned _sp = 0; while (cond) { __builtin_amdgcn_s_sleep(1); \
    if ((++_sp & 255u) == 0u) { if (xb_ld(&(bar)[XB_TMO])) break; if (_sp > XB_SPIN_CAP) { atomicAdd(&(bar)[XB_TMO], 1u); break; } } } } while (0)

struct XcdBarrier {
    unsigned* bar; unsigned x;
    volatile LAS unsigned* st;
};

__device__ __forceinline__ XcdBarrier xcd_barrier_post(unsigned* bar, volatile LAS unsigned* st) {
    XcdBarrier b; b.bar = bar; b.x = xb_xcc_id(); b.st = st;
    if (threadIdx.x == 0) (void)xb_add(&bar[XB_XCNT(b.x)], 1u);
    return b;
}
__device__ __forceinline__ void xcd_barrier_complete(unsigned* bar, unsigned x, unsigned& nloc, unsigned& nx) {
    const unsigned G = gridDim.x * gridDim.y * gridDim.z;
    unsigned sum, cnt, mine, sp = 0u;
    for (;;) {
        sum = 0u; cnt = 0u; mine = 0u;
#pragma unroll
        for (unsigned j = 0; j < 16; ++j) { const unsigned c = xb_ld(&bar[XB_XCNT(j)]); sum += c; cnt += (c > 0u) ? 1u : 0u; mine = (j == x) ? c : mine; }
        if (sum == G) break;
        __builtin_amdgcn_s_sleep(1);
        if ((++sp & 255u) == 0u) { if (xb_ld(&bar[XB_TMO])) break; if (sp > XB_SPIN_CAP) { atomicAdd(&bar[XB_TMO], 1u); break; } }
    }
    nloc = mine > 0u ? mine : 1u; nx = cnt > 0u ? cnt : 1u;
}

__device__ __forceinline__ void xcd_barrier(const XcdBarrier& b) {
    asm volatile("s_waitcnt vmcnt(0)" ::: "memory");
    __syncthreads();
    if (threadIdx.x == 0) {
        unsigned* bar = b.bar;
        __builtin_amdgcn_s_waitcnt(0);
        unsigned nloc = b.st[0], nx = b.st[1];
        if (nloc == 0u) { xcd_barrier_complete(bar, b.x, nloc, nx); b.st[0] = nloc; b.st[1] = nx; }
        const unsigned old = xb_add(&bar[XB_XSUB(b.x)], 1u);
        const unsigned gen = old / nloc;
        if (old + 1u == (gen + 1u) * nloc) {
            __builtin_amdgcn_fence(__ATOMIC_RELEASE, "agent");
            asm volatile("s_waitcnt vmcnt(0)" ::: "memory");
            const unsigned og = xb_add(&bar[XB_TOP], 1u);
            const unsigned tg = og / nx;
            if (og + 1u == (tg + 1u) * nx) xb_add(&bar[XB_TOPGEN], 1u);
            else XB_SPIN(xb_ld(&bar[XB_TOPGEN]) == tg, bar);
            __builtin_amdgcn_fence(__ATOMIC_ACQUIRE, "agent");
            xb_add(&bar[XB_XGEN(b.x)], 1u);
            asm volatile("s_waitcnt vmcnt(0)" ::: "memory");
        } else {
            XB_SPIN(xb_ld(&bar[XB_XGEN(b.x)]) == gen, bar);
            __builtin_amdgcn_fence(__ATOMIC_ACQUIRE, "agent");
            asm volatile("s_waitcnt vmcnt(0)" ::: "memory");
        }
    }
    __syncthreads();
}


struct CvItem { const float* src; bf16_t* dst; int ldw, K; float scale; };
__device__ __forceinline__ void cv_load(const CvItem& it, f32x4 (&v)[16], int lane) {
    const float* s = it.src + (size_t)(lane >> 4) * it.ldw + (lane & 15) * 4;
#pragma unroll
    for (int i = 0; i < 16; ++i) v[i] = __builtin_nontemporal_load((const f32x4*)(s + (size_t)(4 * i) * it.ldw));
}
__device__ __forceinline__ void cv_store(const CvItem& it, const f32x4 (&v)[16], LAS float* scr, int lane) {
#pragma unroll
    for (int i = 0; i < 16; ++i) { const int kk = 4 * i + (lane >> 4); LAS float* d = scr + ((lane & 15) * 4) * 65 + kk;
        d[0] = v[i][0] * it.scale; d[65] = v[i][1] * it.scale; d[130] = v[i][2] * it.scale; d[195] = v[i][3] * it.scale; }
    LDS_WAIT();
    const int c = lane & 7;
#pragma unroll
    for (int j = 0; j < 8; ++j) { const int n = (lane >> 3) + 8 * j; const LAS float* s = scr + n * 65 + 8 * c;
        u32x4 o; o.x = cvt_pk_bf16(s[0], s[1]); o.y = cvt_pk_bf16(s[2], s[3]); o.z = cvt_pk_bf16(s[4], s[5]); o.w = cvt_pk_bf16(s[6], s[7]);
        *(u32x4*)(it.dst + (size_t)n * it.K + 8 * c) = o; }
    LDS_WAIT();
}
__device__ __forceinline__ CvItem cv_w1_item(const MKP& p, int layer, int r) {
    const int le = layer * NE + r / 512, q = r % 512, kb = q / 32, nb = q % 32, n0 = nb * 64;
    const int tile = n0 >> 8, w = n0 & 255; const int src = w < 128 ? tile * 128 + w : 1024 + tile * 128 + (w - 128);
    CvItem it; it.src = p.w1 + (size_t)le * DM * 2 * DE + (size_t)(kb * 64) * (2 * DE) + src; it.ldw = 2 * DE; it.dst = p.W1_t + (size_t)le * 2 * DE * DM + (size_t)n0 * DM + kb * 64; it.K = DM; it.scale = 1.f; return it;
}
constexpr int W1_Q = 3;
constexpr int W1_DEFER_A = (256 - 77) * NWAVES * W1_Q, W1_DEFER_B = (256 - 4) * NWAVES * W1_Q, W1_DEFER = W1_DEFER_A + W1_DEFER_B;
static_assert(W1_DEFER <= NE * 512, "deferred W1 blocks");
__device__ __forceinline__ void convert_w1_deferred(const MKP& p, LAS unsigned char* lds, int layer, int first, int wave, int lane) {
    LAS float* scr = (LAS float*)(lds + wave * 16640);
    f32x4 cur[16], nxt[16]; CvItem ci = cv_w1_item(p, layer, first); cv_load(ci, cur, lane);
    for (int i = 0; i < W1_Q; ++i) { CvItem ni = ci; if (i + 1 < W1_Q) { ni = cv_w1_item(p, layer, first + i + 1); cv_load(ni, nxt, lane); }
        cv_store(ci, cur, scr, lane); ci = ni;
#pragma unroll
        for (int k = 0; k < 16; ++k) cur[k] = nxt[k]; }
}
__device__ __forceinline__ CvItem cv_w2_item(const MKP& p, int r) {
    const int le = r / 256, q = r % 256, kb = q / 16, nb = q % 16; CvItem c;
    c.src = p.w2 + (size_t)le * DE * DM + (size_t)(kb * 64) * DM + nb * 64; c.ldw = DM; c.dst = p.W2_t + (size_t)le * DM * DE + (size_t)(nb * 64) * DE + kb * 64; c.K = DE; c.scale = 1.f; return c;
}
constexpr int W2_DEFER = 8192, W2_L1 = 32 * 256;
__device__ __forceinline__ void convert_w2_blocks(const MKP& p, LAS unsigned char* lds, int first, int step, int n, int wave, int lane) {
    LAS float* scr = (LAS float*)(lds + wave * 16640);
    f32x4 cur[16], nxt[16]; int r = first; if (r >= W2_DEFER || n <= 0) return;
    CvItem ci = cv_w2_item(p, W2_L1 + r); cv_load(ci, cur, lane);
    for (int i = 0; i < n; ++i) { CvItem ni = ci; const int rn = r + step; const bool more = i + 1 < n && rn < W2_DEFER;
        if (more) { ni = cv_w2_item(p, W2_L1 + rn); cv_load(ni, nxt, lane); }
        cv_store(ci, cur, scr, lane); if (!more) break; ci = ni; r = rn;
#pragma unroll
        for (int k = 0; k < 16; ++k) cur[k] = nxt[k]; }
}
__device__ __forceinline__ int moe_last_round_units(int nunits, int G) { return nunits - ((nunits + G - 1) / G - 1) * G; }
__device__ __forceinline__ CvItem cv_p0_item(const MKP& p, int it) {
    constexpr int I_IN = 16 * (NPJ / 64), I_OUT = 16 * 16, I_W1L = NE * 512 - W1_DEFER, I_W2 = 16 * 16;
    constexpr int T_IN = 2 * I_IN, T_OUT = 2 * I_OUT, T_W1 = 2 * I_W1L;
    int r = it; CvItem c;
    if (r < T_IN) { const int l = r / I_IN, q = r % I_IN, kb = q / (NPJ / 64), nb = q % (NPJ / 64), n0 = nb * 64;
        const int src = n0 < 2304 ? n0 : (n0 < 3072 ? n0 + 4 : n0 + 12);
        c.src = p.w_in + (size_t)l * DM * NPROJ + (size_t)(kb * 64) * NPROJ + src; c.ldw = NPROJ; c.dst = p.Win_t + (size_t)l * NPJ * DM + (size_t)n0 * DM + kb * 64; c.K = DM; c.scale = (n0 < 512 || (n0 >= P_FQ && n0 < P_FK)) ? QK_C2 : 1.f; return c; }
    r -= T_IN;
    if (r < T_OUT) { const int l = r / I_OUT, q = r % I_OUT, kb = q / 16, nb = q % 16;
        c.src = p.w_out + (size_t)l * DM * DM + (size_t)(kb * 64) * DM + nb * 64; c.ldw = DM; c.dst = p.Wout_t + (size_t)l * DM * DM + (size_t)(nb * 64) * DM + kb * 64; c.K = DM; c.scale = 1.f; return c; }
    r -= T_OUT;
    if (r < T_W1) return cv_w1_item(p, r / I_W1L, W1_DEFER + r % I_W1L);
    r -= T_W1;
    return cv_w2_item(p, r < W2_L1 ? r : r + W2_DEFER);
}
__device__ __forceinline__ void phase_convert_weights(const MKP& p, LAS unsigned char* lds, int gw, int ngw, int wave, int lane) {
    LAS float* scr = (LAS float*)(lds + wave * 16640);
    constexpr int NIT = 2 * 16 * (NPJ / 64) + 2 * 256 + 2 * (NE * 512 - W1_DEFER) + 64 * 256 - W2_DEFER;
    int it = gw; if (it >= NIT) return;
    f32x4 cur[16], nxt[16]; CvItem ci = cv_p0_item(p, it); cv_load(ci, cur, lane);
    for (; it < NIT; it += ngw) { CvItem ni = ci; const bool more = it + ngw < NIT;
        if (more) { ni = cv_p0_item(p, it + ngw); cv_load(ni, nxt, lane); }
        cv_store(ci, cur, scr, lane); ci = ni;
#pragma unroll
        for (int k = 0; k < 16; ++k) cur[k] = nxt[k]; }
}

__device__ __forceinline__ void ln_core(f32x4 (&v)[4], const float* __restrict__ g, const float* __restrict__ bta, int lane) {
    float s = 0.f;
#pragma unroll
    for (int j = 0; j < 4; ++j) s += (v[j][0] + v[j][1]) + (v[j][2] + v[j][3]);
    const float mean = wave_sum(s) * (1.f / DM); float q = 0.f;
#pragma unroll
    for (int j = 0; j < 4; ++j) { v[j] = v[j] - mean; q += (v[j][0] * v[j][0] + v[j][1] * v[j][1]) + (v[j][2] * v[j][2] + v[j][3] * v[j][3]); }
    const float rstd = rsqrtf(wave_sum(q) * (1.f / DM) + 1e-5f);
#pragma unroll
    for (int j = 0; j < 4; ++j) { const f32x4 gg = ((const f32x4*)g)[lane + 64 * j], bb = ((const f32x4*)bta)[lane + 64 * j]; v[j] = v[j] * rstd * gg + bb; }
}
__device__ __forceinline__ void store_row_bf16(bf16_t* dst, const f32x4 (&v)[4], int lane) {
#pragma unroll
    for (int j = 0; j < 4; ++j) { u32x2 w; w.x = cvt_pk_bf16(v[j][0], v[j][1]); w.y = cvt_pk_bf16(v[j][2], v[j][3]); ((u32x2*)dst)[lane + 64 * j] = w; }
}
__device__ __forceinline__ void zero_row_bf16(bf16_t* dst, int lane) {
#pragma unroll
    for (int j = 0; j < 4; ++j) ((u32x2*)dst)[lane + 64 * j] = (u32x2){0u, 0u};
}
__device__ __forceinline__ void gate_w_load(const float* __restrict__ w_in_l, float (&v)[24], int tid) {
#pragma unroll
    for (int q = 0; q < 24; ++q) { const int i = q * NTHR + tid, k = i / 12, c = i % 12; const int col = c < 4 ? C_FF + c : (c < 8 ? C_GB + (c - 4) : C_GA + (c - 8)); v[q] = w_in_l[(size_t)k * NPROJ + col]; }
}
__device__ __forceinline__ void gate_w_store(const float (&v)[24], LAS float* wg, int tid) {
#pragma unroll
    for (int q = 0; q < 24; ++q) { const int i = q * NTHR + tid, k = i / 12, c = i % 12; wg[c * DM + k] = v[q]; }
}
__device__ __forceinline__ void gates_row(const f32x4 (&v)[4], const LAS float* wg, float* __restrict__ grow, int lane) {
    float mine = 0.f;
#pragma unroll
    for (int cb = 0; cb < 12; cb += 4) { f32x4 w[4][4];
#pragma unroll
        for (int q = 0; q < 4; ++q)
#pragma unroll
            for (int j = 0; j < 4; ++j) w[q][j] = *(const LAS f32x4*)(wg + (cb + q) * DM + 4 * (lane + 64 * j));
        __builtin_amdgcn_sched_barrier(0);
#pragma unroll
        for (int q = 0; q < 4; ++q) { float a = 0.f;
#pragma unroll
            for (int j = 0; j < 4; ++j) a += (v[j][0] * w[q][j][0] + v[j][1] * w[q][j][1]) + (v[j][2] * w[q][j][2] + v[j][3] * w[q][j][3]);
            a = wave_sum(a); if (lane == cb + q) mine = a; } }
    if (lane < 16) grow[lane] = lane < 12 ? mine : 0.f;
}

__device__ __forceinline__ void phase_ln_in(const MKP& p, LAS unsigned char* lds, int gw, int ngw, int tid, int lane, const float (&gwv)[24]) {
    LAS float* wg = (LAS float*)lds;
    gate_w_store(gwv, wg, tid); __syncthreads();
    for (int r = gw; r < MP; r += ngw) { if ((r % LP) < NLEAD) { zero_row_bf16(p.actb + (size_t)r * DM, lane); if (lane < 16) p.gates[(size_t)r * 16 + lane] = 0.f; } }
#define LNIN_SRC(r_) (((r_) % LP) >= NLEAD + NMETA ? p.x + ((size_t)((r_) / LP) * SEQ + (((r_) % LP) - NLEAD - NMETA)) * DM : p.meta + (size_t)(((r_) % LP) - NLEAD) * DM)
    int r = gw; while (r < MP && (r % LP) < NLEAD) r += ngw;
    f32x4 nv[4];
    if (r < MP) { const float* src = LNIN_SRC(r);
#pragma unroll
        for (int j = 0; j < 4; ++j) nv[j] = ((const f32x4*)src)[lane + 64 * j]; }
    while (r < MP) {
        f32x4 v[4];
#pragma unroll
        for (int j = 0; j < 4; ++j) v[j] = nv[j];
        int rn = r + ngw; while (rn < MP && (rn % LP) < NLEAD) rn += ngw;
        if (rn < MP) { const float* src = LNIN_SRC(rn);
#pragma unroll
            for (int j = 0; j < 4; ++j) nv[j] = ((const f32x4*)src)[lane + 64 * j]; }
        ln_core(v, p.ln_in_g, p.ln_in_b, lane);
        store_row_bf16(p.actb + (size_t)r * DM, v, lane);
        gates_row(v, wg, p.gates + (size_t)r * 16, lane);
        r = rn;
    }
#undef LNIN_SRC
    __syncthreads();
}

constexpr int CNT_STRIDE = 32;
__device__ __forceinline__ void phase_ln1_route(const MKP& p, int layer, LAS unsigned char* lds, int gw, int ngw, int tid, int lane, int dump = 0) {
    float* stream_w = dump ? (float*)p.act : p.stream; bf16_t* actb_w = dump ? p.act + (size_t)40 * 1024 * 1024 : p.actb;
    int* tok_e_w = dump ? (int*)p.gch : p.tok_e; int* tok_pos_w = dump ? (int*)p.gch + (1 << 18) : p.tok_pos; float* tok_gate_w = dump ? (float*)p.gch + (2 << 18) : p.tok_gate; int* etok_w = dump ? (int*)p.gch + (4 << 18) : p.etok;
    constexpr int RS = DM + 4;
    constexpr int REC_OFF = 136192, LCNT_OFF = REC_OFF + 8192, BASE_OFF = LCNT_OFF + 128;
    LAS float* rwT = (LAS float*)lds; LAS int* rec = (LAS int*)(lds + REC_OFF); LAS int* lcnt = (LAS int*)(lds + LCNT_OFF); LAS int* lbase = (LAS int*)(lds + BASE_OFF);
    const int wave = tid >> 6;
    if (tid < 32) lcnt[tid] = 0;
    { const f32x4* src = (const f32x4*)(p.rwT + (size_t)layer * NE * RS);
      f32x4 t4[17];
#pragma unroll
      for (int q = 0; q < 17; ++q) { const int i = q * NTHR + tid; if (i < NE * RS / 4) t4[q] = src[i]; }
#pragma unroll
      for (int q = 0; q < 17; ++q) { const int i = q * NTHR + tid; if (i < NE * RS / 4) *(LAS f32x4*)(rwT + 4 * i) = t4[q]; } }
    __syncthreads();
    const float rbl = p.router_b[layer * NE + (lane & 31)]; int* cnt = p.cnt + layer * 2048 + (dump ? 1024 : 0);
    int r = gw; while (r < MP && (r % LP) < NLEAD) r += ngw;
    u32x2 nv[2][4]; int nrec = 0; const bf16_t* sumb = (const bf16_t*)p.stream;
    int rr[2]; rr[0] = r; { int x = r < MP ? r + ngw : MP; while (x < MP && (x % LP) < NLEAD) x += ngw; rr[1] = x < MP ? x : MP; }
#pragma unroll
    for (int k = 0; k < 2; ++k) if (rr[k] < MP) {
#pragma unroll
        for (int j = 0; j < 4; ++j) nv[k][j] = ((const u32x2*)(sumb + (size_t)rr[k] * DM))[lane + 64 * j]; }
    const float* lng = p.ln1_g + layer * DM; const float* lnb = p.ln1_b + layer * DM;
    const int ex_l = ((lane >> 5) << 4) | (((lane >> 4) & 1) << 3) | (((lane >> 3) & 1) << 2) | (((lane >> 2) & 1) << 1) | ((lane >> 1) & 1);
    const float rb_l = shfl_idx(rbl, ex_l);
    while (rr[0] < MP) {
        const bool hasB = rr[1] < MP;
        f32x4 v[2][4];
#pragma unroll
        for (int j = 0; j < 4; ++j) { v[0][j] = (f32x4){bflo(nv[0][j].x), bfhi(nv[0][j].x), bflo(nv[0][j].y), bfhi(nv[0][j].y)};
            const u32x2 wB = hasB ? nv[1][j] : nv[0][j]; v[1][j] = (f32x4){bflo(wB.x), bfhi(wB.x), bflo(wB.y), bfhi(wB.y)}; }
        int nr[2]; { int x = hasB ? rr[1] + ngw : MP; while (x < MP && (x % LP) < NLEAD) x += ngw; nr[0] = x < MP ? x : MP; x = nr[0] < MP ? nr[0] + ngw : MP; while (x < MP && (x % LP) < NLEAD) x += ngw; nr[1] = x < MP ? x : MP; }
#pragma unroll
        for (int k = 0; k < 2; ++k) if (nr[k] < MP) {
#pragma unroll
            for (int j = 0; j < 4; ++j) nv[k][j] = ((const u32x2*)(sumb + (size_t)nr[k] * DM))[lane + 64 * j]; }
        { float s0 = 0.f, s1 = 0.f;
#pragma unroll
          for (int j = 0; j < 4; ++j) { s0 += (v[0][j][0] + v[0][j][1]) + (v[0][j][2] + v[0][j][3]); s1 += (v[1][j][0] + v[1][j][1]) + (v[1][j][2] + v[1][j][3]); }
          const float m0 = wave_sum(s0) * (1.f / DM), m1 = wave_sum(s1) * (1.f / DM); float q0 = 0.f, q1 = 0.f;
#pragma unroll
          for (int j = 0; j < 4; ++j) { v[0][j] = v[0][j] - m0; v[1][j] = v[1][j] - m1;
              q0 += (v[0][j][0] * v[0][j][0] + v[0][j][1] * v[0][j][1]) + (v[0][j][2] * v[0][j][2] + v[0][j][3] * v[0][j][3]); q1 += (v[1][j][0] * v[1][j][0] + v[1][j][1] * v[1][j][1]) + (v[1][j][2] * v[1][j][2] + v[1][j][3] * v[1][j][3]); }
          const float r0 = rsqrtf(wave_sum(q0) * (1.f / DM) + 1e-5f), r1 = rsqrtf(wave_sum(q1) * (1.f / DM) + 1e-5f);
#pragma unroll
          for (int j = 0; j < 4; ++j) { const f32x4 gg = ((const f32x4*)lng)[lane + 64 * j], bb = ((const f32x4*)lnb)[lane + 64 * j]; v[0][j] = v[0][j] * r0 * gg + bb; v[1][j] = v[1][j] * r1 * gg + bb; } }
        store_row_bf16(actb_w + (size_t)rr[0] * DM, v[0], lane);
        if (hasB) store_row_bf16(actb_w + (size_t)rr[1] * DM, v[1], lane);
        float lg[2][32];
#pragma unroll
        for (int eb = 0; eb < 32; eb += 3) { f32x4 w[3][4];
#pragma unroll
            for (int q = 0; q < 3; ++q) if (eb + q < 32) {
#pragma unroll
                for (int j = 0; j < 4; ++j) w[q][j] = *(const LAS f32x4*)(rwT + (eb + q) * RS + 4 * (lane + 64 * j)); }
            __builtin_amdgcn_sched_barrier(0);
#pragma unroll
            for (int q = 0; q < 3; ++q) if (eb + q < 32) { f32x2 a0 = {0.f, 0.f}, a1 = {0.f, 0.f};
#pragma unroll
                for (int j = 0; j < 4; ++j) { const f32x2 wl = {w[q][j][0], w[q][j][1]}, wh = {w[q][j][2], w[q][j][3]};
                    a0 = __builtin_elementwise_fma((f32x2){v[0][j][0], v[0][j][1]}, wl, a0); a0 = __builtin_elementwise_fma((f32x2){v[0][j][2], v[0][j][3]}, wh, a0);
                    a1 = __builtin_elementwise_fma((f32x2){v[1][j][0], v[1][j][1]}, wl, a1); a1 = __builtin_elementwise_fma((f32x2){v[1][j][2], v[1][j][3]}, wh, a1); }
                lg[0][eb + q] = a0[0] + a0[1]; lg[1][eb + q] = a1[0] + a1[1]; }
            __builtin_amdgcn_sched_barrier(0); }
        float h1[2];
#define XSWZ(v_, m_) __int_as_float(__builtin_amdgcn_ds_swizzle(__float_as_int(v_), (((m_) << 10) | 0x1F)))
        { float h16[2][16], h8[2][8], h4[2][4], h2[2][2];
#pragma unroll
          for (int e = 0; e < 16; ++e)
#pragma unroll
              for (int k = 0; k < 2; ++k) { auto sw = __builtin_amdgcn_permlane32_swap(__float_as_uint(lg[k][e]), __float_as_uint(lg[k][16 + e]), false, false);
                  h16[k][e] = __uint_as_float(sw[0]) + __uint_as_float(sw[1]); }
          { const bool up = (lane & 16) != 0;
#pragma unroll
            for (int e = 0; e < 8; ++e)
#pragma unroll
                for (int k = 0; k < 2; ++k) { const float keep = up ? h16[k][8 + e] : h16[k][e], give = up ? h16[k][e] : h16[k][8 + e]; h8[k][e] = keep + XSWZ(give, 16); } }
          { const bool up = (lane & 8) != 0;
#pragma unroll
            for (int e = 0; e < 4; ++e)
#pragma unroll
                for (int k = 0; k < 2; ++k) { const float keep = up ? h8[k][4 + e] : h8[k][e], give = up ? h8[k][e] : h8[k][4 + e]; h4[k][e] = keep + XSWZ(give, 8); } }
          { const bool up = (lane & 4) != 0;
#pragma unroll
            for (int e = 0; e < 2; ++e)
#pragma unroll
                for (int k = 0; k < 2; ++k) { const float keep = up ? h4[k][2 + e] : h4[k][e], give = up ? h4[k][e] : h4[k][2 + e]; h2[k][e] = keep + XSWZ(give, 4); } }
          { const bool up = (lane & 2) != 0;
#pragma unroll
            for (int k = 0; k < 2; ++k) { const float keep = up ? h2[k][1] : h2[k][0], give = up ? h2[k][0] : h2[k][1]; h1[k] = keep + XSWZ(give, 2); } }
#pragma unroll
          for (int k = 0; k < 2; ++k) h1[k] += XSWZ(h1[k], 1); }
#undef XSWZ
        float val[2] = {h1[0] + rb_l, h1[1] + rb_l};
        float tv[2][4]; int ti[2][4];
#pragma unroll
        for (int t4 = 0; t4 < 4; ++t4) { const float mx0 = wave_max(val[0]), mx1 = wave_max(val[1]);
            int c0 = (val[0] == mx0) ? ex_l : 64, c1 = (val[1] == mx1) ? ex_l : 64;
            c0 = -(int)wave_max((float)(-c0)); c1 = -(int)wave_max((float)(-c1));
            tv[0][t4] = mx0; ti[0][t4] = c0; if (ex_l == c0) val[0] = -INFINITY; tv[1][t4] = mx1; ti[1][t4] = c1; if (ex_l == c1) val[1] = -INFINITY; }
#pragma unroll
        for (int k = 0; k < 2; ++k) if (k == 0 || hasB) {
            const float e1 = __expf(tv[k][1] - tv[k][0]), e2 = __expf(tv[k][2] - tv[k][0]), e3 = __expf(tv[k][3] - tv[k][0]); const float inv = 1.f / (1.f + e1 + e2 + e3);
            if (lane < 4) { const float gt = (lane == 0 ? 1.f : lane == 1 ? e1 : lane == 2 ? e2 : e3) * inv; const int ex = lane == 0 ? ti[k][0] : lane == 1 ? ti[k][1] : lane == 2 ? ti[k][2] : ti[k][3];
                const int rank = __hip_atomic_fetch_add(lcnt + ex, 1, __ATOMIC_RELAXED, __HIP_MEMORY_SCOPE_WORKGROUP);
                LAS int* rc = rec + ((wave * 16 + nrec) * 4 + lane) * 4; rc[0] = ex; rc[1] = rank; rc[2] = __float_as_int(gt); rc[3] = rr[k]; }
            ++nrec; }
        rr[0] = nr[0]; rr[1] = nr[1];
    }
    __syncthreads();
    if (tid < 32) lbase[tid] = atomicAdd(&cnt[tid * CNT_STRIDE], lcnt[tid]);
    __syncthreads();
    for (int i = lane; i < nrec * 4; i += 64) { const LAS int* rc = rec + ((wave * 16) * 4 + i) * 4; const int ex = rc[0], pos = lbase[ex] + rc[1], rr_ = rc[3], k = i & 3;
        tok_e_w[(size_t)rr_ * 4 + k] = ex; tok_pos_w[(size_t)rr_ * 4 + k] = pos; tok_gate_w[(size_t)rr_ * 4 + k] = __int_as_float(rc[2]); etok_w[(size_t)ex * MP + pos] = rr_; }
    __syncthreads();
}

__device__ __forceinline__ void build_expert_tab(const int* cnt, volatile LAS int* tab, int tid) {
    __syncthreads();
    if (tid < 64) { const int e = tid & 31; int np = 0; if (tid < 32) np = (__hip_atomic_load(cnt + e * CNT_STRIDE, __ATOMIC_RELAXED, __HIP_MEMORY_SCOPE_AGENT) + 255) >> 8;
        int incl = np;
#pragma unroll
        for (int o = 1; o < 32; o <<= 1) { const int u = shfl_up_li(incl, o, tid); if (tid >= o) incl += u; }
        const int base = incl - np;
        if (tid < 32) { tab[1 + e] = base; for (int q = 0; q < np; ++q) tab[40 + base + q] = e; if (e == 31) { tab[33] = incl; tab[0] = incl; } } }
    __syncthreads();
}

__device__ __forceinline__ void phase_combine_ln2(const MKP& p, int layer, LAS unsigned char* lds, int gw, int ngw, int tid, int lane, int dump = 0) {
    float* stream_w = dump ? (float*)p.act : p.stream; bf16_t* actb_w = dump ? p.act + (size_t)40 * 1024 * 1024 : p.actb; float* gates_w = dump ? (float*)p.gch : p.gates; float* out_w = dump ? (float*)p.act : p.out;
    volatile LAS int* tab = (volatile LAS int*)(lds + LDS_TAB);
    LAS float* wg = (LAS float*)lds;
    build_expert_tab(p.cnt + layer * 2048, tab, tid);
    if (layer == 0) { for (int i = tid; i < 12 * DM / 4; i += NTHR) *(LAS f32x4*)(wg + 4 * i) = *(const f32x4*)(p.wgc + 4 * i); __syncthreads(); }
    if (layer == 0) for (int r = gw; r < MP; r += ngw) { if ((r % LP) < NLEAD) { zero_row_bf16(actb_w + (size_t)r * DM, lane); if (lane < 16) gates_w[(size_t)r * 16 + lane] = 0.f; } }
    int r = gw; while (r < MP && (r % LP) < NLEAD) r += ngw;
    int te = 0, tp = 0; float tg = 0.f;
    if (r < MP && lane < 4) { te = p.tok_e[(size_t)r * 4 + lane]; tp = p.tok_pos[(size_t)r * 4 + lane]; tg = p.tok_gate[(size_t)r * 4 + lane]; }
    while (r < MP) { const int b = r / LP, t = r % LP;
        const bf16_t* yr[4]; float gt[4];
#pragma unroll
        for (int k = 0; k < 4; ++k) { const int e = __builtin_amdgcn_readlane(te, k), pos = __builtin_amdgcn_readlane(tp, k); gt[k] = __int_as_float(__builtin_amdgcn_readlane(__float_as_int(tg), k));
            yr[k] = p.ybuf + ((size_t)tab[1 + e] * 256 + pos) * DM; }
        f32x4 v[4]; u32x2 yw[4][4];
#pragma unroll
        for (int j = 0; j < 4; ++j) { const u32x2 w = ((const u32x2*)(p.actb + (size_t)r * DM))[lane + 64 * j]; v[j] = (f32x4){bflo(w.x), bfhi(w.x), bflo(w.y), bfhi(w.y)}; }
#pragma unroll
        for (int k = 0; k < 4; ++k)
#pragma unroll
            for (int j = 0; j < 4; ++j) yw[k][j] = ((const u32x2*)yr[k])[lane + 64 * j];
        int rn = r + ngw; while (rn < MP && (rn % LP) < NLEAD) rn += ngw;
        if (rn < MP && lane < 4) { te = p.tok_e[(size_t)rn * 4 + lane]; tp = p.tok_pos[(size_t)rn * 4 + lane]; tg = p.tok_gate[(size_t)rn * 4 + lane]; }
#pragma unroll
        for (int j = 0; j < 4; ++j) { v[j] = v[j] * DN_ALPHA;
#pragma unroll
            for (int k = 0; k < 4; ++k) { const u32x2 w = yw[k][j]; v[j][0] += gt[k] * bflo(w.x); v[j][1] += gt[k] * bfhi(w.x); v[j][2] += gt[k] * bflo(w.y); v[j][3] += gt[k] * bfhi(w.y); } }
        ln_core(v, p.ln2_g + layer * DM, p.ln2_b + layer * DM, lane);
        if (layer == 0) {
            store_row_bf16(actb_w + (size_t)r * DM, v, lane);
            gates_row(v, wg, gates_w + (size_t)r * 16, lane);
        } else if (t >= NLEAD + NMETA) {
#pragma unroll
            for (int j = 0; j < 4; ++j) ((f32x4*)(out_w + ((size_t)b * SEQ + (t - NLEAD - NMETA)) * DM))[lane + 64 * j] = v[j];
        }
        r = rn;
    }
    __syncthreads();
}
namespace attn_body {
using bf16=unsigned short;
using bf16x8=__attribute__((ext_vector_type(8)))short;
using s16x4=__attribute__((ext_vector_type(4)))short;
using f32x16=__attribute__((ext_vector_type(16)))float;
using u32x4=__attribute__((ext_vector_type(4)))unsigned;
constexpr int D=64,PQ=NPJ;
constexpr int NW=8,QBLK=32,QB=QBLK*NW,KVBLK=64;
__device__ __forceinline__ int crow(int r,int hi){return (r&3)+8*(r>>2)+4*hi;}
#define SBAR() __builtin_amdgcn_sched_barrier(0)
template<int MODE> __device__ __forceinline__ void cmask(f32x16&p0,f32x16&p1,int jb,int qrel,int hi){
  const float NEG=-INFINITY;
  if(MODE==0||MODE==2){ if(jb>(qrel>>6)){
      #pragma unroll
      for(int r=0;r<16;++r){p0[r]=NEG;p1[r]=NEG;} } }
  else{ int kb=64*jb+4*hi;
    #pragma unroll
    for(int r=0;r<16;++r){int kv=kb+(r&3)+8*(r>>2); if(kv>qrel)p0[r]=NEG; if(kv+32>qrel)p1[r]=NEG;} }
}

constexpr int NSLOT=3, SLOTB=8192;
constexpr int LDS_K=0, LDS_V=NSLOT*SLOTB, LDS_WS=2*NSLOT*SLOTB, LDS_OST=LDS_WS+NW*64*4, LDS_BYTES=LDS_OST+NW*4096+NSLOT*SLOTB;
constexpr float C2=0.125f*1.4426950408889634f;
__device__ __forceinline__ void glds16(const void*gsrc,unsigned lds_dst){unsigned keep;
  asm volatile("s_mov_b32 %0, m0\n\ts_mov_b32 m0, %2\n\ts_nop 0\n\tglobal_load_lds_dwordx4 %1, off\n\ts_mov_b32 m0, %0":"=&s"(keep):"v"(gsrc),"s"(lds_dst):"memory");}
__device__ __forceinline__ float max3f(float a,float b,float c){float r;asm("v_max3_f32 %0, %1, %2, %3":"=v"(r):"v"(a),"v"(b),"v"(c));return r;}
__device__ __forceinline__ float max2f(float a,float b){float r;asm("v_max_f32_e32 %0, %1, %2":"=v"(r):"v"(a),"v"(b));return r;}
__device__ __forceinline__ float fadd_s(float a,float b){float r;asm("v_add_f32_e32 %0, %1, %2":"=v"(r):"v"(a),"v"(b));return r;}
__device__ __forceinline__ float fsub_s(float a,float b){float r;asm("v_sub_f32_e32 %0, %1, %2":"=v"(r):"v"(a),"v"(b));return r;}
typedef float f32x2_t __attribute__((ext_vector_type(2))); typedef __bf16 bf16x2_t __attribute__((ext_vector_type(2)));
__device__ __forceinline__ unsigned cvtpk_s(float lo,float hi){f32x2_t v={lo,hi};bf16x2_t b=__builtin_convertvector(v,bf16x2_t);return __builtin_bit_cast(unsigned,b);}
#define WAIT_BAR(N) asm volatile("s_waitcnt vmcnt(" #N ") lgkmcnt(0)\n\ts_barrier":::"memory")

__device__ __forceinline__ void qkt(f32x16&p0,f32x16&p1,const char*Kslot,const bf16x8*qr,const f32x16&ci0,const f32x16&ci1,int r32,int hi){
  const char*kb=Kslot+hi*1024+r32*16;
  #pragma unroll
  for(int d0=0;d0<4;++d0){
    const bf16x8 b0=*reinterpret_cast<const bf16x8*>(kb+d0*2048);
    const bf16x8 b1=*reinterpret_cast<const bf16x8*>(kb+d0*2048+512);
    if(d0==0){p0=__builtin_amdgcn_mfma_f32_32x32x16_bf16(b0,qr[0],ci0,0,0,0);p1=__builtin_amdgcn_mfma_f32_32x32x16_bf16(b1,qr[0],ci1,0,0,0);}
    else{p0=__builtin_amdgcn_mfma_f32_32x32x16_bf16(b0,qr[d0],p0,0,0,0);p1=__builtin_amdgcn_mfma_f32_32x32x16_bf16(b1,qr[d0],p1,0,0,0);}}
}
typedef __attribute__((address_space(3))) const char* lds_cptr;
typedef short v4i16_t __attribute__((ext_vector_type(4)));
__device__ __forceinline__ void kload8(bf16x8*kf,lds_cptr kp){
  kf[0]=*(const __attribute__((address_space(3))) bf16x8*)(kp);      kf[1]=*(const __attribute__((address_space(3))) bf16x8*)(kp+512);
  kf[2]=*(const __attribute__((address_space(3))) bf16x8*)(kp+2048); kf[3]=*(const __attribute__((address_space(3))) bf16x8*)(kp+2560);
  kf[4]=*(const __attribute__((address_space(3))) bf16x8*)(kp+4096); kf[5]=*(const __attribute__((address_space(3))) bf16x8*)(kp+4608);
  kf[6]=*(const __attribute__((address_space(3))) bf16x8*)(kp+6144); kf[7]=*(const __attribute__((address_space(3))) bf16x8*)(kp+6656);
}
__device__ __forceinline__ void kload2(bf16x8*kf,lds_cptr kp,int j){ kf[2*j]=*(const __attribute__((address_space(3))) bf16x8*)(kp+j*2048); kf[2*j+1]=*(const __attribute__((address_space(3))) bf16x8*)(kp+j*2048+512); }
__device__ __forceinline__ s16x4 vtr(lds_cptr p){ return __builtin_bit_cast(s16x4,__builtin_amdgcn_ds_read_tr16_b64_v4i16((__attribute__((address_space(3))) v4i16_t*)p)); }
__device__ __forceinline__ float rowmax(const f32x16&p0,const f32x16&p1){
  float a=max3f(p0[0],p0[1],p1[0]),b=max3f(p0[2],p0[3],p1[1]);a=max3f(a,p1[2],p1[3]);
  #pragma unroll
  for(int r=4;r<16;r+=4){a=max3f(a,p0[r],p0[r+1]);b=max3f(b,p0[r+2],p0[r+3]);a=max3f(a,p1[r],p1[r+1]);b=max3f(b,p1[r+2],p1[r+3]);}
  const float m=max2f(a,b);
  auto rr=__builtin_amdgcn_permlane32_swap(__float_as_uint(m),__float_as_uint(m),false,false);
  return max2f(__uint_as_float(rr[0]),__uint_as_float(rr[1]));
}
template<int NDB_> __device__ __forceinline__ void pv(f32x16*o,int vb,bf16x8 pa0,bf16x8 pa1,bf16x8 pa2,bf16x8 pa3){
  #pragma unroll
  for(int d0=0;d0<NDB_;++d0){s16x4 lo[4],hi[4];
    #pragma unroll
    for(int ks=0;ks<4;++ks){
      asm volatile("ds_read_b64_tr_b16 %0,%1 offset:%c2":"=&v"(lo[ks]):"v"(vb),"i"(d0*4096+ks*1024):"memory");
      asm volatile("ds_read_b64_tr_b16 %0,%1 offset:%c2":"=&v"(hi[ks]):"v"(vb),"i"(d0*4096+ks*1024+512):"memory");}
    asm volatile("s_waitcnt lgkmcnt(0)":::"memory");SBAR();
    #define PK(k) (bf16x8){lo[k][0],lo[k][1],lo[k][2],lo[k][3],hi[k][0],hi[k][1],hi[k][2],hi[k][3]}
    o[d0]=__builtin_amdgcn_mfma_f32_32x32x16_bf16(pa0,PK(0),o[d0],0,0,0);
    o[d0]=__builtin_amdgcn_mfma_f32_32x32x16_bf16(pa1,PK(1),o[d0],0,0,0);
    o[d0]=__builtin_amdgcn_mfma_f32_32x32x16_bf16(pa2,PK(2),o[d0],0,0,0);
    o[d0]=__builtin_amdgcn_mfma_f32_32x32x16_bf16(pa3,PK(3),o[d0],0,0,0);
    #undef PK
  }
}

__device__ __forceinline__ bf16x8 make_qx(float nm){
  const unsigned p1=cvtpk_s(nm,0.f)&0xffffu; const float r1=nm-__uint_as_float(p1<<16);
  const unsigned p2=cvtpk_s(r1,0.f)&0xffffu; const float r2=r1-__uint_as_float(p2<<16);
  const unsigned p3=cvtpk_s(r2,0.f)&0xffffu;
  u32x4 w; w.x=0x3F803F80u; w.y=0x3F80u|(p1<<16); w.z=p2|(p3<<16); w.w=0u; return __builtin_bit_cast(bf16x8,w);
}
__device__ __forceinline__ bf16x8 make_gf(unsigned long long g,unsigned msk){
  u32x4 w; w.x=(unsigned)g&msk; w.y=(unsigned)(g>>32)&msk; w.z=0x3F803F80u&msk; w.w=0u; return __builtin_bit_cast(bf16x8,w);
}
__device__ __forceinline__ void gload(unsigned long long&d,const unsigned long long*sbase,unsigned voff){ asm volatile("global_load_dwordx2 %0, %1, %2":"=&v"(d):"v"(voff),"s"(sbase):"memory"); }
#ifndef ATTN_STORE16
#define ATTN_STORE16(p,v) (*(u32x4*)(p)=(v))
#endif
template<int MODE,int THRL,int DUP=0> __device__ __forceinline__ void attn_unit(int qb,const bf16*Qh,const bf16*__restrict__ Kh,const bf16*__restrict__ Vh,bf16*Oh,int po,const unsigned long long*__restrict__ Gk0,float lcorr,char*shm,const int tid,const long ohalf=0,const int tile0=0){
  constexpr int VM=(MODE==2?2:1),NDB=(MODE==2?4:2),LWS=LDS_V+NSLOT*SLOTB*VM,LOST=LWS+NW*64*4;
  const int lane=tid&63,r32=lane&31,hi=lane>>5; const int wid=__builtin_amdgcn_readfirstlane(tid>>6);
  const int q0=qb*QB;
  const bf16*Qw=Qh+(long)(q0+wid*QBLK)*PQ;
  Kh+=(long)tile0*KVBLK*PQ; Vh+=(long)tile0*KVBLK*PQ; const unsigned long long*__restrict__ Gk=Gk0+tile0*KVBLK;
  const unsigned lds0=(unsigned)(uintptr_t)shm;
  float*wsf=(float*)(shm+LWS)+wid*64;
  const bf16*ksrc=Kh+(long)lane*PQ+wid*8;
  const bf16*vsrc=Vh+(long)(16*(wid&3)+(lane>>2))*PQ+(wid>>2)*32+(lane&3)*8;
  const unsigned kdst=lds0+LDS_K+wid*1024, vdst=lds0+LDS_V+wid*1024;
  #define DMA_K(t,slot) glds16(ksrc+(long)(t)*KVBLK*PQ,(unsigned)__builtin_amdgcn_readfirstlane(kdst+(slot)))
  #define DMA_V(t,slot) do{ glds16(vsrc+(long)(t)*KVBLK*PQ,(unsigned)__builtin_amdgcn_readfirstlane(vdst+(slot)*VM)); if(MODE==2) glds16(vsrc+64+(long)(t)*KVBLK*PQ,(unsigned)__builtin_amdgcn_readfirstlane(vdst+(slot)*VM+8192)); }while(0)
  const int vb0=(int)(lds0+LDS_V)+((lane>>4)&1)*32+(lane&3)*8+(4*hi+((lane&15)>>2))*64;
  const char*Kbase=shm+LDS_K; bf16x8 kf[8];
  const lds_cptr shm3=(lds_cptr)shm; const lds_cptr kp0=shm3+LDS_K+hi*1024+r32*16; const lds_cptr vp0=shm3+LDS_V+((lane>>4)&1)*32+(lane&3)*8+(4*hi+((lane&15)>>2))*64;
  const int NT=(q0+QB)/KVBLK-tile0;
  unsigned long long gc0=0,gc1=0; const unsigned goff=(unsigned)r32*8u;
  #define GMSK (hi?0u:0xffffffffu)
  #define QX make_qx(-mhat)
  if(MODE==1){ gload(gc0,Gk,goff); gload(gc1,Gk+32,goff); }
  DMA_K(0,0);DMA_V(0,0);DMA_K(1,SLOTB);
  bf16x8 qr[4];
  #pragma unroll
  for(int d0=0;d0<4;++d0)qr[d0]=*reinterpret_cast<const bf16x8*>(&Qw[(long)r32*PQ+d0*16+hi*8]);
  float mhat=0.f,l_reg=0.f;f32x16 o[NDB];
  #pragma unroll
  for(int d_=0;d_<NDB;++d_)o[d_]=f32x16{};
  f32x16 negm=f32x16{};if(MODE==0)asm volatile("":"+v"(negm));
  const int qrel=wid*QBLK+r32;
  #define CMASK(P0,P1,t) do{int jb_=(t)-(NT-4); if(jb_>=0)cmask<MODE>(P0,P1,jb_,qrel,hi);}while(0)
  #define NEGM_UPD() do{ if(MODE==1){ } else { _Pragma("unroll") for(int r=0;r<16;++r)negm[r]=-mhat; asm volatile("":"+v"(negm)); } }while(0)
  bool resc=false;
  #define START(P0,P1) do{ const float rm=rowmax(P0,P1); resc=false; \
    { const float dl=rm; mhat=fadd_s(mhat,dl); \
      _Pragma("unroll") for(int r=0;r<16;++r){P0[r]=fsub_s(P0[r],dl);P1[r]=fsub_s(P1[r],dl);} \
      NEGM_UPD(); } \
    _Pragma("unroll") for(int r=0;r<16;++r)P0[r]=__builtin_amdgcn_exp2f(P0[r]); }while(0)
  #define RESC() do{ if(resc){ asm volatile("s_waitcnt lgkmcnt(0)":::"memory"); \
      _Pragma("unroll") for(int d_=0;d_<NDB;++d_) _Pragma("unroll") for(int r=0;r<16;++r)o[d_][r]*=wsf[crow(r,hi)]; } }while(0)
  f32x16 pA0,pA1,pB0,pB1;
  int sl_prev=0,sl_cur=0,sl_next=SLOTB;
  #define ROT() do{sl_prev=sl_cur;sl_cur=sl_next;sl_next=(sl_next==(NSLOT-1)*SLOTB)?0:sl_next+SLOTB;}while(0)
  DMA_K(2,2*SLOTB);
  #define GPIN() asm volatile("":"+v"(gc0),"+v"(gc1))
  #define WB_A() do{ if(MODE==2){WAIT_BAR(3);}else{WAIT_BAR(2);} }while(0)
  #define WB_B() do{ if(MODE==2){WAIT_BAR(2);}else{WAIT_BAR(1);} }while(0)
  if(MODE==2){WAIT_BAR(4);}else{WAIT_BAR(3);} GPIN();
  const f32x16 zero16=f32x16{};
  if(MODE==1){ const bf16x8 qx0=make_qx(0.f); const f32x16 cb0=__builtin_amdgcn_mfma_f32_32x32x16_bf16(make_gf(gc0,GMSK),qx0,zero16,0,0,0),cb1=__builtin_amdgcn_mfma_f32_32x32x16_bf16(make_gf(gc1,GMSK),qx0,zero16,0,0,0);
    qkt(pA0,pA1,Kbase,qr,cb0,cb1,r32,hi); gload(gc0,Gk+64,goff); gload(gc1,Gk+96,goff); }
  else qkt(pA0,pA1,Kbase,qr,negm,negm,r32,hi);
  asm volatile("s_nop 15\n\ts_nop 7":"+v"(pA0),"+v"(pA1));CMASK(pA0,pA1,0);
  START(pA0,pA1);
  _Pragma("unroll") for(int r=0;r<16;++r)pA1[r]=__builtin_amdgcn_exp2f(pA1[r]);
  #define GADV() do{ if(MODE==1){ GPIN(); } }while(0)
  WAIT_BAR(0); GADV();
  DMA_K(3,0);DMA_V(1,SLOTB);
  ROT();
  kload8(kf,kp0+sl_cur);
  WB_A();
  s16x4 vlo[8],vhi[8]; u32x4 pw0,pw1,pw2,pw3;
  #define PKW(P,B) cvtpk_s(P[B],P[B+1])
  #define PAF(k) __builtin_bit_cast(bf16x8,pw##k)
  #define VFR(i) (bf16x8){vlo[i][0],vlo[i][1],vlo[i][2],vlo[i][3],vhi[i][0],vhi[i][1],vhi[i][2],vhi[i][3]}
  #define PIN(x) asm volatile("":"+v"(x))
  #define MX3(a,b,c) __builtin_fmaxf(__builtin_fmaxf((a),(b)),(c))
  #define GAPA(MF,A0,A1,A2,A3,W0,W1,PW) do{ MF; sacc+=A0; sacc+=A1; sacc+=A2; sacc+=A3; PIN(sacc); W0; W1; PIN(PW); SBAR(); }while(0)
  #define EX(v) __builtin_amdgcn_exp2f(v)
  #define GAPB(MF,X,B) do{ MF; if(DUP){ MF; } X[B]=EX(X[B]); X[B+1]=EX(X[B+1]); X[B+2]=EX(X[B+2]); X[B+3]=EX(X[B+3]); PIN(X); SBAR(); }while(0)
  #define VRD(i) do{ vlo[i]=vtr(vp_+(((i)>>2)*4096+((i)&3)*1024)); vhi[i]=vtr(vp_+(((i)>>2)*4096+((i)&3)*1024+512)); }while(0)
  #define KRD(G,j) do{ if(G){ kload2(kf,kp0+sl_next,j); SBAR(); } }while(0)
  #define STEP(C0,C1,P0,P1,t,GK,GV,GL) do{ SBAR(); \
    if(MODE==1){ const bf16x8 qx_=QX; { const bf16x8 gf0_=make_gf(gc0,GMSK); C0=__builtin_amdgcn_mfma_f32_32x32x16_bf16(gf0_,qx_,zero16,0,0,0); } SBAR(); \
      { const bf16x8 gf1_=make_gf(gc1,GMSK); C1=__builtin_amdgcn_mfma_f32_32x32x16_bf16(gf1_,qx_,zero16,0,0,0); } SBAR(); \
      if((t)+1<NT){ gload(gc0,Gk+((t)+1)*64,goff); gload(gc1,Gk+((t)+1)*64+32,goff); } } \
    const lds_cptr vp_=vp0+sl_prev; \
    VRD(0); SBAR(); float sacc=(P0[0]+P0[1]); \
    GAPA(C0=__builtin_amdgcn_mfma_f32_32x32x16_bf16(kf[0],qr[0],(MODE==1?C0:negm),0,0,0), P0[2],P0[3],P0[4],P0[5],     pw0[0]=PKW(P0,0), pw0[1]=PKW(P0,2), pw0); \
    VRD(4); SBAR(); GAPA(C1=__builtin_amdgcn_mfma_f32_32x32x16_bf16(kf[1],qr[0],(MODE==1?C1:negm),0,0,0), P0[6],P0[7],P0[8],P0[9],     pw0[2]=PKW(P0,4), pw0[3]=PKW(P0,6), pw0); \
    VRD(1); SBAR(); GAPA(C0=__builtin_amdgcn_mfma_f32_32x32x16_bf16(kf[2],qr[1],C0,0,0,0),   P0[10],P0[11],P0[12],P0[13], pw1[0]=PKW(P0,8), pw1[1]=PKW(P0,10), pw1); \
    VRD(5); SBAR(); GAPA(C1=__builtin_amdgcn_mfma_f32_32x32x16_bf16(kf[3],qr[1],C1,0,0,0),   P0[14],P0[15],P1[0],P1[1],   pw1[2]=PKW(P0,12),pw1[3]=PKW(P0,14), pw1); \
    if(MODE==0){VRD(2);} SBAR(); GAPA(C0=__builtin_amdgcn_mfma_f32_32x32x16_bf16(kf[4],qr[2],C0,0,0,0),   P1[2],P1[3],P1[4],P1[5],     pw2[0]=PKW(P1,0), pw2[1]=PKW(P1,2), pw2); \
    if(MODE==0){VRD(6);} SBAR(); GAPA(C1=__builtin_amdgcn_mfma_f32_32x32x16_bf16(kf[5],qr[2],C1,0,0,0),   P1[6],P1[7],P1[8],P1[9],     pw2[2]=PKW(P1,4), pw2[3]=PKW(P1,6), pw2); \
    if(MODE==0){VRD(3);} SBAR(); GAPA(C0=__builtin_amdgcn_mfma_f32_32x32x16_bf16(kf[6],qr[3],C0,0,0,0),   P1[10],P1[11],P1[12],P1[13], pw3[0]=PKW(P1,8), pw3[1]=PKW(P1,10), pw3); \
    if(MODE==0){VRD(7);} SBAR(); GAPA(C1=__builtin_amdgcn_mfma_f32_32x32x16_bf16(kf[7],qr[3],C1,0,0,0),   P1[14],P1[15],0.f,0.f,       pw3[2]=PKW(P1,12),pw3[3]=PKW(P1,14), pw3); \
    l_reg+=sacc; \
    if(GK){DMA_K((t)+3,sl_cur);} if(GV){DMA_V((t)+1,sl_next);} \
    CMASK(C0,C1,t); \
    { float a=MX3(C0[0],C0[1],C1[0]),b=MX3(C0[2],C0[3],C1[1]); a=MX3(a,C1[2],C1[3]); \
      _Pragma("unroll") for(int r=4;r<16;r+=4){a=MX3(a,C0[r],C0[r+1]);b=MX3(b,C0[r+2],C0[r+3]);a=MX3(a,C1[r],C1[r+1]);b=MX3(b,C1[r+2],C1[r+3]);} \
      float rm=__builtin_fmaxf(a,b); { auto rr=__builtin_amdgcn_permlane32_swap(__float_as_uint(rm),__float_as_uint(rm),false,false); rm=__builtin_fmaxf(__uint_as_float(rr[0]),__uint_as_float(rr[1])); } \
      resc=false; \
      if(__builtin_expect(__any(rm>(float)THRL),0)){ const float dl=__builtin_fmaxf(rm,0.f); mhat+=dl; \
        _Pragma("unroll") for(int r=0;r<16;++r){C0[r]-=dl;C1[r]-=dl;} \
        NEGM_UPD(); \
        const float f=__builtin_amdgcn_exp2f(-dl); l_reg*=f; if(hi==0)wsf[r32]=f; resc=true; } } \
    SBAR(); \
    if(MODE==1){VRD(2);VRD(6);SBAR();} GAPB(o[0]=__builtin_amdgcn_mfma_f32_32x32x16_bf16(PAF(0),VFR(0),o[0],0,0,0), C0,0); \
    GAPB(o[1]=__builtin_amdgcn_mfma_f32_32x32x16_bf16(PAF(0),VFR(4),o[1],0,0,0), C0,4); \
    if(MODE==1){VRD(3);VRD(7);SBAR();} KRD(GL,0); GAPB(o[0]=__builtin_amdgcn_mfma_f32_32x32x16_bf16(PAF(1),VFR(1),o[0],0,0,0), C0,8); \
    KRD(GL,1); GAPB(o[1]=__builtin_amdgcn_mfma_f32_32x32x16_bf16(PAF(1),VFR(5),o[1],0,0,0), C0,12); \
    KRD(GL,2); GAPB(o[0]=__builtin_amdgcn_mfma_f32_32x32x16_bf16(PAF(2),VFR(2),o[0],0,0,0), C1,0); \
    KRD(GL,3); GAPB(o[1]=__builtin_amdgcn_mfma_f32_32x32x16_bf16(PAF(2),VFR(6),o[1],0,0,0), C1,4); \
    GAPB(o[0]=__builtin_amdgcn_mfma_f32_32x32x16_bf16(PAF(3),VFR(3),o[0],0,0,0), C1,8); \
    GAPB(o[1]=__builtin_amdgcn_mfma_f32_32x32x16_bf16(PAF(3),VFR(7),o[1],0,0,0), C1,12); \
    }while(0)
  #define GAPB2(MF,X,B) do{ MF; if(DUP){ MF; } X[B]=EX(X[B]); X[B+1]=EX(X[B+1]); PIN(X); SBAR(); }while(0)
  #define VRD2(sl_,i) do{ vlo[sl_]=vtr(vp_+(((i)>>2)*4096+((i)&3)*1024)); vhi[sl_]=vtr(vp_+(((i)>>2)*4096+((i)&3)*1024+512)); }while(0)
  #define FI(j) ((((j)&3)<<2)|((j)>>2))
  #define PVJ(j,X,B) GAPB2(o[(j)&3]=__builtin_amdgcn_mfma_f32_32x32x16_bf16(PAFS((j)>>2),VFR((j)&3),o[(j)&3],0,0,0), X,B)
  #define PAFS(k) ((k)==0?PAF(0):(k)==1?PAF(1):(k)==2?PAF(2):PAF(3))
  #define STEP2(C0,C1,P0,P1,t,GK,GV,GL) do{ SBAR(); \
    const lds_cptr vp_=vp0+sl_prev*VM; \
    float sacc=(P0[0]+P0[1]); \
    GAPA(C0=__builtin_amdgcn_mfma_f32_32x32x16_bf16(kf[0],qr[0],negm,0,0,0), P0[2],P0[3],P0[4],P0[5],     pw0[0]=PKW(P0,0), pw0[1]=PKW(P0,2), pw0); \
    GAPA(C1=__builtin_amdgcn_mfma_f32_32x32x16_bf16(kf[1],qr[0],negm,0,0,0), P0[6],P0[7],P0[8],P0[9],     pw0[2]=PKW(P0,4), pw0[3]=PKW(P0,6), pw0); \
    GAPA(C0=__builtin_amdgcn_mfma_f32_32x32x16_bf16(kf[2],qr[1],C0,0,0,0),   P0[10],P0[11],P0[12],P0[13], pw1[0]=PKW(P0,8), pw1[1]=PKW(P0,10), pw1); \
    GAPA(C1=__builtin_amdgcn_mfma_f32_32x32x16_bf16(kf[3],qr[1],C1,0,0,0),   P0[14],P0[15],P1[0],P1[1],   pw1[2]=PKW(P0,12),pw1[3]=PKW(P0,14), pw1); \
    VRD2(0,FI(0)); SBAR(); GAPA(C0=__builtin_amdgcn_mfma_f32_32x32x16_bf16(kf[4],qr[2],C0,0,0,0),   P1[2],P1[3],P1[4],P1[5],     pw2[0]=PKW(P1,0), pw2[1]=PKW(P1,2), pw2); \
    VRD2(1,FI(1)); SBAR(); GAPA(C1=__builtin_amdgcn_mfma_f32_32x32x16_bf16(kf[5],qr[2],C1,0,0,0),   P1[6],P1[7],P1[8],P1[9],     pw2[2]=PKW(P1,4), pw2[3]=PKW(P1,6), pw2); \
    VRD2(2,FI(2)); SBAR(); GAPA(C0=__builtin_amdgcn_mfma_f32_32x32x16_bf16(kf[6],qr[3],C0,0,0,0),   P1[10],P1[11],P1[12],P1[13], pw3[0]=PKW(P1,8), pw3[1]=PKW(P1,10), pw3); \
    VRD2(3,FI(3)); SBAR(); GAPA(C1=__builtin_amdgcn_mfma_f32_32x32x16_bf16(kf[7],qr[3],C1,0,0,0),   P1[14],P1[15],0.f,0.f,       pw3[2]=PKW(P1,12),pw3[3]=PKW(P1,14), pw3); \
    l_reg+=sacc; \
    if(GK){DMA_K((t)+3,sl_cur);} if(GV){DMA_V((t)+1,sl_next);} \
    CMASK(C0,C1,t); \
    { float a=MX3(C0[0],C0[1],C1[0]),b=MX3(C0[2],C0[3],C1[1]); a=MX3(a,C1[2],C1[3]); \
      _Pragma("unroll") for(int r=4;r<16;r+=4){a=MX3(a,C0[r],C0[r+1]);b=MX3(b,C0[r+2],C0[r+3]);a=MX3(a,C1[r],C1[r+1]);b=MX3(b,C1[r+2],C1[r+3]);} \
      float rm=__builtin_fmaxf(a,b); { auto rr=__builtin_amdgcn_permlane32_swap(__float_as_uint(rm),__float_as_uint(rm),false,false); rm=__builtin_fmaxf(__uint_as_float(rr[0]),__uint_as_float(rr[1])); } \
      resc=false; \
      if(__builtin_expect(__any(rm>(float)THRL),0)){ const float dl=__builtin_fmaxf(rm,0.f); mhat+=dl; \
        _Pragma("unroll") for(int r=0;r<16;++r){C0[r]-=dl;C1[r]-=dl;} \
        NEGM_UPD(); \
        const float f=__builtin_amdgcn_exp2f(-dl); l_reg*=f; if(hi==0)wsf[r32]=f; resc=true; } } \
    SBAR(); \
    PVJ(0,C0,0);  VRD2(0,FI(4));  SBAR(); \
    PVJ(1,C0,2);  VRD2(1,FI(5));  SBAR(); \
    PVJ(2,C0,4);  VRD2(2,FI(6));  SBAR(); \
    PVJ(3,C0,6);  VRD2(3,FI(7));  SBAR(); \
    KRD(GL,0); PVJ(4,C0,8);  VRD2(0,FI(8));  SBAR(); \
    KRD(GL,1); PVJ(5,C0,10); VRD2(1,FI(9));  SBAR(); \
    KRD(GL,2); PVJ(6,C0,12); VRD2(2,FI(10)); SBAR(); \
    KRD(GL,3); PVJ(7,C0,14); VRD2(3,FI(11)); SBAR(); \
    PVJ(8,C1,0);  VRD2(0,FI(12)); SBAR(); \
    PVJ(9,C1,2);  VRD2(1,FI(13)); SBAR(); \
    PVJ(10,C1,4); VRD2(2,FI(14)); SBAR(); \
    PVJ(11,C1,6); VRD2(3,FI(15)); SBAR(); \
    PVJ(12,C1,8); PVJ(13,C1,10); PVJ(14,C1,12); PVJ(15,C1,14); \
    }while(0)
  #define STEPX(C0,C1,P0,P1,t,GK,GV,GL) do{ if(MODE==2){ STEP2(C0,C1,P0,P1,t,GK,GV,GL); } else { STEP(C0,C1,P0,P1,t,GK,GV,GL); } }while(0)
  int t=1;
  #undef CMASK
  #define CMASK(P0,P1,t) do{}while(0)
  for(;t+5<NT;t+=2){
    STEPX(pB0,pB1,pA0,pA1,t,true,true,true);     WB_A(); GADV(); RESC(); ROT();
    STEPX(pA0,pA1,pB0,pB1,t+1,true,true,true);   WB_A(); GADV(); RESC(); ROT();
  }
  #undef CMASK
  #define CMASK(P0,P1,t) do{int jb_=(t)-(NT-4); if(jb_>=0)cmask<MODE>(P0,P1,jb_,qrel,hi);}while(0)
  #define ENDW(tt) do{ if((tt)+3<NT){WB_A();} else if((tt)+2<NT){WB_B();} else {WAIT_BAR(0);} }while(0)
  for(;t+1<NT;t+=2){
    STEPX(pB0,pB1,pA0,pA1,t,(t+3<NT),(t+1<NT),(t+1<NT));       ENDW(t);   GADV(); RESC(); ROT();
    STEPX(pA0,pA1,pB0,pB1,t+1,(t+4<NT),(t+2<NT),(t+2<NT));     ENDW(t+1); GADV(); RESC(); ROT();
  }
  STEPX(pB0,pB1,pA0,pA1,NT-1,false,false,false); RESC();
  { float sacc=pB0[0]+pB0[1]; _Pragma("unroll") for(int r=2;r<16;++r)sacc+=pB0[r]; _Pragma("unroll") for(int r=0;r<16;++r)sacc+=pB1[r]; l_reg+=sacc;
    pw0=(u32x4){PKW(pB0,0),PKW(pB0,2),PKW(pB0,4),PKW(pB0,6)};pw1=(u32x4){PKW(pB0,8),PKW(pB0,10),PKW(pB0,12),PKW(pB0,14)};pw2=(u32x4){PKW(pB1,0),PKW(pB1,2),PKW(pB1,4),PKW(pB1,6)};pw3=(u32x4){PKW(pB1,8),PKW(pB1,10),PKW(pB1,12),PKW(pB1,14)};
    SBAR(); pv<NDB>(o,vb0+sl_cur*VM,PAF(0),PAF(1),PAF(2),PAF(3)); }
  #undef PKW
  #undef PAF
  #undef VFR
  #undef PIN
  #undef MX3
  #undef GAPA
  #undef GAPB
  #undef EX
  #undef VRD
  #undef KRD
  #undef STEP
  #undef STEP2
  #undef STEPX
  #undef GAPB2
  #undef VRD2
  #undef FI
  #undef PVJ
  #undef PAFS
  #undef ENDW
  {auto rr=__builtin_amdgcn_permlane32_swap(__float_as_uint(l_reg),__float_as_uint(l_reg),false,false);l_reg=__uint_as_float(rr[0])+__uint_as_float(rr[1]);}
  if(MODE!=1) l_reg=__builtin_fmaxf(l_reg-lcorr*__builtin_amdgcn_exp2f(-mhat),1e-30f);
  if(hi==0)wsf[32+r32]=l_reg;asm volatile("s_waitcnt lgkmcnt(0)":::"memory");
  float rli[16];
  #pragma unroll
  for(int r=0;r<16;++r)rli[r]=__builtin_amdgcn_rcpf(wsf[32+crow(r,hi)]);
  bf16*Ow=Oh+(long)(q0+wid*QBLK)*po; const int rlim=LL-(q0+wid*QBLK);
  #pragma unroll
  for(int pp=0;pp<NDB/2;++pp){ bf16*stg=(bf16*)(shm+LOST)+wid*2048;
    #pragma unroll
    for(int r=0;r<16;++r){const int orow=crow(r,hi);
      #pragma unroll
      for(int d0=0;d0<2;++d0)stg[orow*64+d0*32+r32]=(bf16)(cvtpk_s(o[2*pp+d0][r]*rli[r],0.f)&0xffffu);}
    asm volatile("s_waitcnt lgkmcnt(0)":::"memory");
    #pragma unroll
    for(int i=0;i<4;++i){const int row=i*8+(lane>>3),ch=lane&7; const u32x4 v=*(const u32x4*)(stg+row*64+ch*8); if(row<rlim) ATTN_STORE16(Ow+pp*ohalf+(long)row*po+ch*8,v);}
    asm volatile("s_waitcnt lgkmcnt(0)":::"memory"); }
  asm volatile("s_waitcnt lgkmcnt(0)\n\ts_barrier":::"memory");
  #undef GADV
  #undef WB_A
  #undef WB_B
  #undef GMSK
  #undef QX
  #undef GPIN
  #undef NEGM_UPD
  #undef DMA_K
  #undef DMA_V
  #undef CMASK
  #undef START
  #undef RESC
  #undef ROT
}
constexpr int ATTN_LDS_BYTES=LDS_BYTES;
#undef SBAR
#undef WAIT_BAR
}
constexpr int GCH_BYTES = 49152, GCH_UNITS = NB * 4 * (LL / 64);
__device__ __forceinline__ int gch_unit(int b, int h, int n) { return (b * 4 + h) * (LL / 64) + n; }

template <int J> struct FwdRow {
    static constexpr int I0 = J + 1, IA = ((I0 + 3) & ~3) < 64 ? ((I0 + 3) & ~3) : 64, NH = IA - I0, NG = (64 - IA) / 4;
};
template <int J> __device__ __forceinline__ void fwd_load(const LAS float* AT, f32x4 (&v)[16], float (&hd)[3]) {
    using R = FwdRow<J>;
#pragma unroll
    for (int q = 0; q < R::NH; ++q) hd[q] = AT[J * 64 + R::I0 + q];
#pragma unroll
    for (int g = 0; g < R::NG; ++g) v[g] = *(const LAS f32x4*)(AT + J * 64 + R::IA + 4 * g);
}
template <int J> struct FwdSubPK {
    static __device__ __forceinline__ void run(f32x2 (&x)[32], const LAS float* AT) {
        using R = FwdRow<J>;
        f32x4 cur[16]; float curh[3];
        fwd_load<J>(AT, cur, curh);
        __builtin_amdgcn_sched_barrier(0);
        const float xj = x[J >> 1][J & 1]; const f32x2 nxj = {-xj, -xj};
#pragma unroll
        for (int q = 0; q < R::NH; ++q) x[(R::I0 + q) >> 1][(R::I0 + q) & 1] -= curh[q] * xj;
#pragma unroll
        for (int g = 0; g < R::NG; ++g) { x[(R::IA + 4 * g) >> 1] = __builtin_elementwise_fma((f32x2){cur[g][0], cur[g][1]}, nxj, x[(R::IA + 4 * g) >> 1]);
            x[((R::IA + 4 * g) >> 1) + 1] = __builtin_elementwise_fma((f32x2){cur[g][2], cur[g][3]}, nxj, x[((R::IA + 4 * g) >> 1) + 1]); }
        __builtin_amdgcn_sched_barrier(0);
        FwdSubPK<J + 1>::run(x, AT);
    }
};
template <> struct FwdSubPK<63> { static __device__ __forceinline__ void run(f32x2 (&)[32], const LAS float*) {} };
template <int J> struct FwdSubRL {
    static __device__ __forceinline__ void run(float (&x)[64], const LAS float* AT) {
        using R = FwdRow<J>;
        f32x4 cur[16]; float curh[3];
        fwd_load<J>(AT, cur, curh);
        __builtin_amdgcn_sched_barrier(0);
        const float xj = x[J];
#pragma unroll
        for (int q = 0; q < R::NH; ++q) x[R::I0 + q] -= curh[q] * xj;
#pragma unroll
        for (int g = 0; g < R::NG; ++g) { x[R::IA + 4 * g] -= cur[g][0] * xj; x[R::IA + 4 * g + 1] -= cur[g][1] * xj; x[R::IA + 4 * g + 2] -= cur[g][2] * xj; x[R::IA + 4 * g + 3] -= cur[g][3] * xj; }
        __builtin_amdgcn_sched_barrier(0);
        FwdSubRL<J + 1>::run(x, AT);
    }
};
template <> struct FwdSubRL<63> { static __device__ __forceinline__ void run(float (&)[64], const LAS float*) {} };

#define LDS_BAR() asm volatile("s_waitcnt lgkmcnt(0)\n\ts_barrier" ::: "memory")
constexpr int GCU_LDS = (3 * 64 * 68 + 128 + 768) * 4;
#ifndef PREP_ABL
#define PREP_ABL 0
#endif
template <bool PK>
__device__ __forceinline__ void gdn_chunk_unit(const MKP& p, int layer, int b, int h, int n, bool active, LAS unsigned char* ldsU, int t_in, int lane_in, int dump = 0, int shi = 0) {
    int t = t_in, lane = lane_in; asm volatile("" : "+v"(t), "+v"(lane));
    constexpr int KS = 68;
    LAS float* Kt = (LAS float*)ldsU;
    LAS float* Qt = Kt + 64 * KS;
    LAS float* Vt = Qt + 64 * KS;
    LAS float* At = Qt;
    LAS float* sc = Vt + 64 * KS;
    LAS float* cwl = sc + 128;
    const float* cw = p.gdn_conv_w + layer * 4 * 768;
    const size_t r0 = (size_t)b * LP + n * 64;
    unsigned char* ub = (dump ? (unsigned char*)p.act : (unsigned char*)p.gch) + (size_t)gch_unit(b, h, n) * GCH_BYTES;
    bf16_t* gW = (bf16_t*)ub; bf16_t* gQd = gW + 4096; bf16_t* gQK = gQd + 4096; bf16_t* gKdT = gQK + 4096; float* gU = (float*)(ub + 32768);
    LDS_BAR();
    if (active) { for (int q = t; q < 768; q += 256) { const int tp = q / 192, c = q % 192; cwl[q] = cw[tp * 768 + (c >> 6) * 256 + h * 64 + (c & 63)]; } }
    LDS_BAR();
    if (active && !(dump && (PREP_ABL & 1))) {
        float bl = 0.f, al = 0.f;
        if (t < 64) { bl = p.gates[(r0 + t) * 16 + 4 + h]; al = p.gates[(r0 + t) * 16 + 8 + h] + p.gdn_dt_bias[layer * 4 + h]; }
        if constexpr (PK) { u32x4 raw2[2][3][4];
#pragma unroll
        for (int bt = 0; bt < 2; ++bt) {
#pragma unroll
            for (int it = 0; it < 3; ++it) { const int item = (bt * 3 + it) * 256 + t, row = item / 24, vec = item % 24, ch = (vec >> 3) * 256 + h * 64 + (vec & 7) * 8; const bf16_t* pr = p.proj + (r0 + row) * NPJ + P_GQKV + ch;
#pragma unroll
                for (int tp = 0; tp < 4; ++tp) raw2[bt][it][tp] = *(const u32x4*)(pr - (size_t)(3 - tp) * NPJ); }
        }
#pragma unroll
        for (int bt = 0; bt < 2; ++bt) {
#pragma unroll
            for (int it = 0; it < 3; ++it) { const int item = (bt * 3 + it) * 256 + t, row = item / 24, vec = item % 24, part = vec >> 3, d0 = (vec & 7) * 8, ch = part * 256 + h * 64 + d0; float a[8];
#pragma unroll
                for (int e = 0; e < 8; ++e) a[e] = 0.f;
#pragma unroll
                for (int tp = 0; tp < 4; ++tp) { const f32x4 w0 = *(const LAS f32x4*)(cwl + tp * 192 + part * 64 + d0), w1 = *(const LAS f32x4*)(cwl + tp * 192 + part * 64 + d0 + 4); const u32x4 r = raw2[bt][it][tp];
                    a[0] += w0[0] * bflo(r.x); a[1] += w0[1] * bfhi(r.x); a[2] += w0[2] * bflo(r.y); a[3] += w0[3] * bfhi(r.y); a[4] += w1[0] * bflo(r.z); a[5] += w1[1] * bfhi(r.z); a[6] += w1[2] * bflo(r.w); a[7] += w1[3] * bfhi(r.w); }
                float ss = 0.f;
#pragma unroll
                for (int e = 0; e < 8; ++e) { a[e] = a[e] * __builtin_amdgcn_rcpf(1.f + __expf(-a[e])); ss += a[e] * a[e]; }
                ss += __int_as_float(__builtin_amdgcn_update_dpp(0, __float_as_int(ss), 0xB1, 0xf, 0xf, true)); ss += __int_as_float(__builtin_amdgcn_update_dpp(0, __float_as_int(ss), 0x4E, 0xf, 0xf, true));
                ss += __int_as_float(__builtin_amdgcn_update_dpp(0, __float_as_int(ss), 0x141, 0xf, 0xf, true));
                const float rn = part == 2 ? 1.f : rsqrtf(ss + 1e-6f) * (part == 0 ? 0.125f : 1.f);
                LAS float* dst = (part == 0 ? Qt : part == 1 ? Kt : Vt) + row * KS + d0;
                *(LAS f32x4*)dst = (f32x4){a[0] * rn, a[1] * rn, a[2] * rn, a[3] * rn}; *(LAS f32x4*)(dst + 4) = (f32x4){a[4] * rn, a[5] * rn, a[6] * rn, a[7] * rn}; }
        } } else {
#pragma unroll 1
        for (int bt = 0; bt < 2; ++bt) { u32x4 raw[3][4];
#pragma unroll
            for (int it = 0; it < 3; ++it) { const int item = (bt * 3 + it) * 256 + t, row = item / 24, vec = item % 24, ch = (vec >> 3) * 256 + h * 64 + (vec & 7) * 8; const bf16_t* pr = p.proj + (r0 + row) * NPJ + P_GQKV + ch;
#pragma unroll
                for (int tp = 0; tp < 4; ++tp) raw[it][tp] = *(const u32x4*)(pr - (size_t)(3 - tp) * NPJ); }
#pragma unroll
            for (int it = 0; it < 3; ++it) { const int item = (bt * 3 + it) * 256 + t, row = item / 24, vec = item % 24, part = vec >> 3, d0 = (vec & 7) * 8, ch = part * 256 + h * 64 + d0; float a[8];
#pragma unroll
                for (int e = 0; e < 8; ++e) a[e] = 0.f;
#pragma unroll
                for (int tp = 0; tp < 4; ++tp) { const f32x4 w0 = *(const LAS f32x4*)(cwl + tp * 192 + part * 64 + d0), w1 = *(const LAS f32x4*)(cwl + tp * 192 + part * 64 + d0 + 4); const u32x4 r = raw[it][tp];
                    a[0] += w0[0] * bflo(r.x); a[1] += w0[1] * bfhi(r.x); a[2] += w0[2] * bflo(r.y); a[3] += w0[3] * bfhi(r.y); a[4] += w1[0] * bflo(r.z); a[5] += w1[1] * bfhi(r.z); a[6] += w1[2] * bflo(r.w); a[7] += w1[3] * bfhi(r.w); }
                float ss = 0.f;
#pragma unroll
                for (int e = 0; e < 8; ++e) { a[e] = a[e] * __builtin_amdgcn_rcpf(1.f + __expf(-a[e])); ss += a[e] * a[e]; }
                ss += __int_as_float(__builtin_amdgcn_update_dpp(0, __float_as_int(ss), 0xB1, 0xf, 0xf, true)); ss += __int_as_float(__builtin_amdgcn_update_dpp(0, __float_as_int(ss), 0x4E, 0xf, 0xf, true));
                ss += __int_as_float(__builtin_amdgcn_update_dpp(0, __float_as_int(ss), 0x141, 0xf, 0xf, true));
                const float rn = part == 2 ? 1.f : rsqrtf(ss + 1e-6f) * (part == 0 ? 0.125f : 1.f);
                LAS float* dst = (part == 0 ? Qt : part == 1 ? Kt : Vt) + row * KS + d0;
                *(LAS f32x4*)dst = (f32x4){a[0] * rn, a[1] * rn, a[2] * rn, a[3] * rn}; *(LAS f32x4*)(dst + 4) = (f32x4){a[4] * rn, a[5] * rn, a[6] * rn, a[7] * rn}; } }
        }
        if (t < 64) { const float sp = fmaxf(al, 0.f) + __logf(1.f + __expf(-fabsf(al)));
            float gv = -__expf(p.gdn_a_log[layer * 4 + h]) * sp;
            int ll_ = lane; asm volatile("" : "+v"(ll_));
#pragma unroll
            for (int o = 1; o < 64; o <<= 1) { const float t_ = shfl_up_l(gv, o, ll_); if (ll_ >= o) gv += t_; }
            sc[t] = 1.f / (1.f + __expf(-bl)); sc[64 + t] = gv; }
    }
    LDS_BAR();
    float kk[16]; const int gi_ = t & 63, gj0 = (t >> 6) * 16;
    if (active) {
        const float gl = sc[64 + 63];
        if (!(dump && (PREP_ABL & 2))) { const int i = gi_, j0 = gj0; float qk[16]; int zg_ = 0; asm volatile("" : "+v"(zg_));
            if constexpr (PK) {
            f32x2 kk2[16], qk2[16];
#pragma unroll
            for (int jj = 0; jj < 16; ++jj) { kk2[jj] = (f32x2){0.f, 0.f}; qk2[jj] = (f32x2){0.f, 0.f}; }
#pragma unroll 1
            for (int d = 0; d < 64; d += 4) { const f32x4 ki = *(const LAS f32x4*)(Kt + i * KS + d), qi = *(const LAS f32x4*)(Qt + i * KS + d);
                const f32x2 kil = {ki[0], ki[1]}, kih = {ki[2], ki[3]}, qil = {qi[0], qi[1]}, qih = {qi[2], qi[3]};
#pragma unroll
                for (int hb = 0; hb < 2; ++hb) { f32x4 kj[8];
#pragma unroll
                    for (int jj = 0; jj < 8; ++jj) kj[jj] = *(const LAS f32x4*)(Kt + zg_ + (j0 + hb * 8 + jj) * KS + d);
                    __builtin_amdgcn_sched_barrier(0);
#pragma unroll
                    for (int jj = 0; jj < 8; ++jj) { const f32x2 jl = {kj[jj][0], kj[jj][1]}, jh = {kj[jj][2], kj[jj][3]};
                        kk2[hb * 8 + jj] = __builtin_elementwise_fma(kil, jl, kk2[hb * 8 + jj]); kk2[hb * 8 + jj] = __builtin_elementwise_fma(kih, jh, kk2[hb * 8 + jj]);
                        qk2[hb * 8 + jj] = __builtin_elementwise_fma(qil, jl, qk2[hb * 8 + jj]); qk2[hb * 8 + jj] = __builtin_elementwise_fma(qih, jh, qk2[hb * 8 + jj]); }
                    __builtin_amdgcn_sched_barrier(0); } }
#pragma unroll
            for (int jj = 0; jj < 16; ++jj) { kk[jj] = kk2[jj][0] + kk2[jj][1]; qk[jj] = qk2[jj][0] + qk2[jj][1]; }
            } else {
#pragma unroll
            for (int jj = 0; jj < 16; ++jj) { kk[jj] = 0.f; qk[jj] = 0.f; }
#pragma unroll 1
            for (int d = 0; d < 64; d += 4) { const f32x4 ki = *(const LAS f32x4*)(Kt + i * KS + d), qi = *(const LAS f32x4*)(Qt + i * KS + d);
#pragma unroll
                for (int hb = 0; hb < 2; ++hb) { f32x4 kj[8];
#pragma unroll
                    for (int jj = 0; jj < 8; ++jj) kj[jj] = *(const LAS f32x4*)(Kt + zg_ + (j0 + hb * 8 + jj) * KS + d);
                    __builtin_amdgcn_sched_barrier(0);
#pragma unroll
                    for (int jj = 0; jj < 8; ++jj) { kk[hb * 8 + jj] += (ki[0] * kj[jj][0] + ki[1] * kj[jj][1]) + (ki[2] * kj[jj][2] + ki[3] * kj[jj][3]); qk[hb * 8 + jj] += (qi[0] * kj[jj][0] + qi[1] * kj[jj][1]) + (qi[2] * kj[jj][2] + qi[3] * kj[jj][3]); }
                    __builtin_amdgcn_sched_barrier(0); } }
            }
            const float gi = sc[64 + i], bi = sc[i]; unsigned w[8];
#pragma unroll
            for (int jj = 0; jj < 16; ++jj) { const int j = j0 + jj; const float dec = __expf(fminf(gi - sc[64 + j], 0.f));
                kk[jj] = j < i ? bi * kk[jj] * dec : 0.f; qk[jj] = j <= i ? qk[jj] * dec : 0.f; }
#pragma unroll
            for (int jj = 0; jj < 8; ++jj) w[jj] = cvt_pk_bf16(qk[2 * jj], qk[2 * jj + 1]);
            *(u32x4*)(gQK + i * 64 + j0) = (u32x4){w[0], w[1], w[2], w[3]}; *(u32x4*)(gQK + i * 64 + j0 + 8) = (u32x4){w[4], w[5], w[6], w[7]}; }
        if (!(dump && (PREP_ABL & 4))) for (int idx = t; idx < 64 * 32; idx += 256) { const int row = idx >> 5, d = (idx & 31) * 2; const float eg = __expf(sc[64 + row]);
            *(unsigned*)(gQd + row * 64 + d) = cvt_pk_bf16(Qt[row * KS + d] * eg, Qt[row * KS + d + 1] * eg); }
        if (!(dump && (PREP_ABL & 4))) for (int idx = t; idx < 64 * 32; idx += 256) { const int d = idx >> 5, i = (idx & 31) * 2;
            *(unsigned*)(gKdT + d * 64 + i) = cvt_pk_bf16(Kt[i * KS + d] * __expf(gl - sc[64 + i]), Kt[(i + 1) * KS + d] * __expf(gl - sc[64 + i + 1])); }
        if (t == 0) (dump ? (float*)((unsigned char*)p.act + (64u << 20)) : p.gcd)[gch_unit(b, h, n)] = __expf(gl);
    }
    LDS_BAR();
    if (active) {
#pragma unroll
        for (int jj = 0; jj < 16; ++jj) At[(gj0 + jj) * 64 + gi_] = kk[jj];
        if (t < 64) cwl[t] = sc[t] * __expf(sc[64 + t]); }
    LDS_BAR();
    const int ts = shi ? t - 128 : t;
    if (active && ts >= 0 && ts < 128 && !(dump && (PREP_ABL & 8))) { const int c = ts & 63;
        if constexpr (PK) { f32x2 x[32];
            { int zi_ = 0; asm volatile("" : "+v"(zi_));
              const LAS float* src = (ts < 64 ? Vt : Kt) + c; const LAS float* fac = (ts < 64 ? sc : cwl) + zi_;
#pragma unroll
              for (int hh = 0; hh < 2; ++hh) { float xv[32], fv[32];
#pragma unroll
                  for (int i = 0; i < 32; ++i) { xv[i] = src[(32 * hh + i) * KS]; fv[i] = fac[32 * hh + i]; }
                  __builtin_amdgcn_sched_barrier(0);
#pragma unroll
                  for (int i = 0; i < 32; ++i) x[(32 * hh + i) >> 1][i & 1] = xv[i] * fv[i];
                  __builtin_amdgcn_sched_barrier(0); } }
            if (!(dump && (PREP_ABL & 16))) { int z_ = 0; asm volatile("" : "+v"(z_)); FwdSubPK<0>::run(x, At + z_); }
            if (ts < 64) {
#pragma unroll
                for (int i = 0; i < 64; ++i) gU[i * 64 + c] = x[i >> 1][i & 1]; }
            else {
#pragma unroll
                for (int i = 0; i < 64; ++i) gW[i * 64 + c] = (bf16_t)(cvt_pk_bf16(x[i >> 1][i & 1], 0.f) & 0xffffu); }
        } else { float x[64];
#pragma unroll
            for (int i = 0; i < 64; ++i) x[i] = ts < 64 ? sc[i] * Vt[i * KS + c] : sc[i] * __expf(sc[64 + i]) * Kt[i * KS + c];
            { int z_ = 0; asm volatile("" : "+v"(z_)); FwdSubRL<0>::run(x, At + z_); }
            if (ts < 64) {
#pragma unroll
                for (int i = 0; i < 64; ++i) gU[i * 64 + c] = x[i]; }
            else {
#pragma unroll
                for (int i = 0; i < 64; ++i) gW[i * 64 + c] = (bf16_t)(cvt_pk_bf16(x[i], 0.f) & 0xffffu); } } }
}
__device__ __forceinline__ void phase_gdn_chunk_prep(const MKP& p, int layer, int vcu, int G, LAS unsigned char* lds, int tid, int lane, int dump = 0) {
    const int hf = tid >> 8, t = tid & 255; constexpr int NU = NB * 4 * (LL / 64 - 2);
    for (int u0 = vcu * 2; u0 < NU; u0 += G * 2) { const int u = u0 + hf; const bool active = u < NU; const int uu = active ? u : 0;
        const int bh = uu / (LL / 64 - 2), n = 2 + uu % (LL / 64 - 2);
        gdn_chunk_unit<true>(p, layer, bh >> 2, bh & 3, n, active, lds + hf * GCU_LDS, t, lane, dump, hf); }
    __syncthreads();
}

struct ScanG { static constexpr int AMAT = 8192, UOFF = 4 * AMAT, UROW = 272, CDOFF = UOFF + 64 * UROW, STG = CDOFF + 16, PRIV = 2 * STG, SMAT = 2048, NCH = LL / 64; };
__device__ __forceinline__ void gdn_scan_step(const MKP& p, int b, int h, int n, const LAS unsigned char* st, f32x4 (&S)[4], LAS unsigned char* StT, LAS unsigned char* VnT, int wave, int c16, int kg, int a0, int a1, int wb) {
    constexpr int AMAT = ScanG::AMAT, UOFF = ScanG::UOFF, UROW = ScanG::UROW;
    bf16x8 sb[2], wf[4][2], qdf[4][2], qkf[4][2], kdf[4][2]; float uu[16];
    sb[0] = *(const LAS bf16x8*)(StT + a0); sb[1] = *(const LAS bf16x8*)(StT + a1);
#pragma unroll
    for (int rt = 0; rt < 4; ++rt) { wf[rt][0] = *(const LAS bf16x8*)(st + rt * 2048 + a0); wf[rt][1] = *(const LAS bf16x8*)(st + rt * 2048 + a1); }
#pragma unroll
    for (int rt = 0; rt < 4; ++rt)
#pragma unroll
        for (int i = 0; i < 4; ++i) uu[4 * rt + i] = *(const LAS float*)(st + UOFF + (16 * rt + 4 * kg + i) * UROW + (16 * wave + c16) * 4);
    const float cd = *(const LAS float*)(st + ScanG::CDOFF);
#pragma unroll
    for (int rt = 0; rt < 4; ++rt) { qdf[rt][0] = *(const LAS bf16x8*)(st + AMAT + rt * 2048 + a0); qdf[rt][1] = *(const LAS bf16x8*)(st + AMAT + rt * 2048 + a1); }
#pragma unroll
    for (int rt = 0; rt < 4; ++rt) { kdf[rt][0] = *(const LAS bf16x8*)(st + 3 * AMAT + rt * 2048 + a0); kdf[rt][1] = *(const LAS bf16x8*)(st + 3 * AMAT + rt * 2048 + a1); }
#pragma unroll
    for (int rt = 0; rt < 4; ++rt) { qkf[rt][0] = *(const LAS bf16x8*)(st + 2 * AMAT + rt * 2048 + a0); qkf[rt][1] = *(const LAS bf16x8*)(st + 2 * AMAT + rt * 2048 + a1); }
    __builtin_amdgcn_sched_barrier(0);
#pragma unroll
    for (int rt = 0; rt < 4; ++rt) { f32x4 acc = f32x4{0.f, 0.f, 0.f, 0.f};
        acc = __builtin_amdgcn_mfma_f32_16x16x32_bf16(wf[rt][0], sb[0], acc, 0, 0, 0); acc = __builtin_amdgcn_mfma_f32_16x16x32_bf16(wf[rt][1], sb[1], acc, 0, 0, 0);
        *(LAS u32x2*)(VnT + (wb ^ (rt << 5))) = (u32x2){cvt_pk_bf16_m(uu[4 * rt] - acc[0], uu[4 * rt + 1] - acc[1]), cvt_pk_bf16_m(uu[4 * rt + 2] - acc[2], uu[4 * rt + 3] - acc[3])}; }
    asm volatile("s_waitcnt lgkmcnt(0)" ::: "memory");
    bf16x8 vb[2]; vb[0] = *(const LAS bf16x8*)(VnT + a0); vb[1] = *(const LAS bf16x8*)(VnT + a1);
#pragma unroll
    for (int kt = 0; kt < 4; ++kt) { f32x4 acc = S[kt] * cd;
        acc = __builtin_amdgcn_mfma_f32_16x16x32_bf16(kdf[kt][0], vb[0], acc, 0, 0, 0); acc = __builtin_amdgcn_mfma_f32_16x16x32_bf16(kdf[kt][1], vb[1], acc, 0, 0, 0);
        S[kt] = acc;
        *(LAS u32x2*)(StT + (wb ^ (kt << 5))) = (u32x2){cvt_pk_bf16_m(acc[0], acc[1]), cvt_pk_bf16_m(acc[2], acc[3])}; }
    float* og = p.gdn_o + ((size_t)b * LP + (size_t)n * 64) * 256 + h * 64 + 16 * wave + c16;
#pragma unroll
    for (int rt = 0; rt < 4; ++rt) { f32x4 acc = f32x4{0.f, 0.f, 0.f, 0.f};
        acc = __builtin_amdgcn_mfma_f32_16x16x32_bf16(qdf[rt][0], sb[0], acc, 0, 0, 0); acc = __builtin_amdgcn_mfma_f32_16x16x32_bf16(qdf[rt][1], sb[1], acc, 0, 0, 0);
        acc = __builtin_amdgcn_mfma_f32_16x16x32_bf16(qkf[rt][0], vb[0], acc, 0, 0, 0); acc = __builtin_amdgcn_mfma_f32_16x16x32_bf16(qkf[rt][1], vb[1], acc, 0, 0, 0);
#pragma unroll
        for (int i = 0; i < 4; ++i) og[(size_t)(16 * rt + 4 * kg + i) * 256] = acc[i]; }
}
__device__ __forceinline__ void gdn_scan_chunked(const MKP& p, int layer, int b, int h, LAS unsigned char* lds, int tid) {
    gdn_chunk_unit<false>(p, layer, b, h, 1, tid < 256, lds + (tid >> 8) * GCU_LDS, tid & 255, tid & 63);
    asm volatile("s_waitcnt vmcnt(0)" ::: "memory"); __syncthreads();
    constexpr int AMAT = ScanG::AMAT, UOFF = ScanG::UOFF, UROW = ScanG::UROW, STG = ScanG::STG, PRIV = ScanG::PRIV, SMAT = ScanG::SMAT, NCH = ScanG::NCH;
    const int lane = tid & 63, wave = __builtin_amdgcn_readfirstlane(tid >> 6);
    const int unit0 = gch_unit(b, h, 0);
    if (wave < 4) {
        const int c16 = lane & 15, kg = lane >> 4, x7 = c16 & 7;
        const int a0 = c16 * 128 + ((kg ^ x7) << 4), a1 = a0 ^ 64;
        const int wb = c16 * 128 + ((((kg >> 1) ^ x7)) << 4) + (kg & 1) * 8;
        f32x4 S[4];
#pragma unroll
        for (int i = 0; i < 4; ++i) S[i] = f32x4{0.f, 0.f, 0.f, 0.f};
        LAS unsigned char* StT = lds + PRIV + wave * 2 * SMAT; LAS unsigned char* VnT = StT + SMAT;
#pragma unroll
        for (int i = 0; i < 2; ++i) *(LAS u32x4*)(StT + c16 * 128 + kg * 32 + i * 16) = (u32x4){0u, 0u, 0u, 0u};
        __syncthreads();
        for (int n = 1; n < NCH; ++n) {
            gdn_scan_step(p, b, h, n, lds + (n & 1) * STG, S, StT, VnT, wave, c16, kg, a0, a1, wb);
            __syncthreads(); }
    } else {
        const int t2 = tid - 256;
        f32x4 ldA[12], ldB[12]; float cdA = 0.f, cdB = 0.f;
#define SC_LOADX(L_, C_, n_) do { const unsigned char* src_ = (const unsigned char*)p.gch + (size_t)(unit0 + (n_)) * GCH_BYTES; _Pragma("unroll") for (int i = 0; i < 12; ++i) L_[i] = *(const f32x4*)(src_ + (size_t)(i * 256 + t2) * 16); C_ = p.gcd[unit0 + (n_)]; } while (0)
#define SC_STOREX(L_, C_, st_) do { LAS unsigned char* dst_ = lds + (st_) * STG; \
        _Pragma("unroll") for (int i = 0; i < 8; ++i) { const int o16 = i * 256 + t2, row = (o16 >> 3) & 63; *(LAS f32x4*)(dst_ + (o16 >> 9) * AMAT + row * 128 + (((o16 & 7) ^ (row & 7)) << 4)) = L_[i]; } \
        _Pragma("unroll") for (int i = 0; i < 4; ++i) { const int u16 = i * 256 + t2; *(LAS f32x4*)(dst_ + UOFF + (u16 >> 4) * UROW + (u16 & 15) * 16) = L_[8 + i]; } \
        if (t2 == 0) *(LAS float*)(dst_ + ScanG::CDOFF) = C_; } while (0)
        SC_LOADX(ldA, cdA, 1); SC_STOREX(ldA, cdA, 1);
        SC_LOADX(ldA, cdA, 2); SC_LOADX(ldB, cdB, 3);
        __syncthreads();
        for (int n = 1; n < NCH; n += 2) {
            if (n + 1 < NCH) { SC_STOREX(ldA, cdA, 0); if (n + 3 < NCH) SC_LOADX(ldA, cdA, n + 3); }
            __syncthreads();
            if (n + 1 >= NCH) break;
            if (n + 2 < NCH) { SC_STOREX(ldB, cdB, 1); if (n + 4 < NCH) SC_LOADX(ldB, cdB, n + 4); }
            __syncthreads();
        }
#undef SC_LOADX
#undef SC_STOREX
    }
}

__device__ __forceinline__ void gdn_scan_chunked_g(const MKP& p, int b, int h, LAS unsigned char* lds, int tid) {
    typedef float f32x16 __attribute__((ext_vector_type(16)));
    constexpr int AROW = 144, AMAT = 64 * AROW, STG = 4 * AMAT + 16384, PRIV = 2 * STG, SROW = 144, SMAT = 32 * SROW;
    const int lane = tid & 63, wave = __builtin_amdgcn_readfirstlane(tid >> 6), r32 = lane & 31, hi = lane >> 5;
    const int unit0 = gch_unit(b, h, 0);
    f32x4 ld[6]; float cdn = 0.f;
#define SC_LOAD(n_) do { const unsigned char* src_ = (const unsigned char*)p.gch + (size_t)(unit0 + (n_)) * GCH_BYTES; _Pragma("unroll") for (int i = 0; i < 6; ++i) ld[i] = *(const f32x4*)(src_ + (size_t)(i * 512 + tid) * 16); cdn = p.gcd[unit0 + (n_)]; } while (0)
#define SC_STORE(st_) do { LAS unsigned char* dst_ = lds + (st_) * STG; _Pragma("unroll") for (int i = 0; i < 6; ++i) { const int off = (i * 512 + tid) * 16; \
        if (off < 32768) { const int m = off >> 13, wi = off & 8191; *(LAS f32x4*)(dst_ + m * AMAT + (wi >> 7) * AROW + (wi & 127)) = ld[i]; } else *(LAS f32x4*)(dst_ + 4 * AMAT + (off - 32768)) = ld[i]; } } while (0)
    f32x16 S[2]; S[0] = f32x16{}; S[1] = f32x16{};
    LAS unsigned char* StT = lds + PRIV + wave * 2 * SMAT; LAS unsigned char* VnT = StT + SMAT;
    if (wave < 2) {
#pragma unroll
        for (int i = 0; i < 4; ++i) *(LAS u32x4*)(StT + r32 * SROW + hi * 64 + i * 16) = (u32x4){0u, 0u, 0u, 0u};
    }
    __syncthreads();
    for (int n = 1; n < LL / 64; ++n) {
        const int cur = n & 1;
        if (wave < 2) {
            const unsigned char* st = (const unsigned char*)p.gch + (size_t)(unit0 + n) * GCH_BYTES; const unsigned char* Wm = st, *Qdm = st + 8192, *QKm = st + 16384, *KdTm = st + 24576; const float* Um = (const float*)(st + 32768); const float cd = p.gcd[unit0 + n];
            bf16x8 sb[4], vb[4];
#pragma unroll
            for (int s = 0; s < 4; ++s) sb[s] = *(const LAS bf16x8*)(StT + r32 * SROW + (16 * s + 8 * hi) * 2);
#pragma unroll
            for (int ct = 0; ct < 2; ++ct) { f32x16 acc = f32x16{};
#pragma unroll
                for (int s = 0; s < 4; ++s) acc = __builtin_amdgcn_mfma_f32_32x32x16_bf16(*(const bf16x8*)(Wm + (32 * ct + r32) * 128 + (16 * s + 8 * hi) * 2), sb[s], acc, 0, 0, 0);
#pragma unroll
                for (int g4 = 0; g4 < 4; ++g4) { float v4[4];
#pragma unroll
                    for (int i = 0; i < 4; ++i) v4[i] = Um[(32 * ct + 8 * g4 + 4 * hi + i) * 64 + 32 * wave + r32] - acc[4 * g4 + i];
                    *(LAS u32x2*)(VnT + r32 * SROW + (32 * ct + 8 * g4 + 4 * hi) * 2) = (u32x2){cvt_pk_bf16_m(v4[0], v4[1]), cvt_pk_bf16_m(v4[2], v4[3])}; } }
            asm volatile("s_waitcnt lgkmcnt(0)" ::: "memory");
#pragma unroll
            for (int s = 0; s < 4; ++s) vb[s] = *(const LAS bf16x8*)(VnT + r32 * SROW + (16 * s + 8 * hi) * 2);
            float* og = p.gdn_o + ((size_t)b * LP + (size_t)n * 64) * 256 + h * 64 + 32 * wave + r32;
#pragma unroll
            for (int ct = 0; ct < 2; ++ct) { f32x16 acc = f32x16{};
#pragma unroll
                for (int s = 0; s < 4; ++s) acc = __builtin_amdgcn_mfma_f32_32x32x16_bf16(*(const bf16x8*)(Qdm + (32 * ct + r32) * 128 + (16 * s + 8 * hi) * 2), sb[s], acc, 0, 0, 0);
#pragma unroll
                for (int s = 0; s < 4; ++s) acc = __builtin_amdgcn_mfma_f32_32x32x16_bf16(*(const bf16x8*)(QKm + (32 * ct + r32) * 128 + (16 * s + 8 * hi) * 2), vb[s], acc, 0, 0, 0);
#pragma unroll
                for (int r = 0; r < 16; ++r) og[(size_t)(32 * ct + (r & 3) + 8 * (r >> 2) + 4 * hi) * 256] = acc[r]; }
#pragma unroll
            for (int kt = 0; kt < 2; ++kt) { f32x16 acc = S[kt] * cd;
#pragma unroll
                for (int s = 0; s < 4; ++s) acc = __builtin_amdgcn_mfma_f32_32x32x16_bf16(*(const bf16x8*)(KdTm + (32 * kt + r32) * 128 + (16 * s + 8 * hi) * 2), vb[s], acc, 0, 0, 0);
                S[kt] = acc;
#pragma unroll
                for (int g4 = 0; g4 < 4; ++g4) *(LAS u32x2*)(StT + r32 * SROW + (32 * kt + 8 * g4 + 4 * hi) * 2) = (u32x2){cvt_pk_bf16_m(acc[4 * g4], acc[4 * g4 + 1]), cvt_pk_bf16_m(acc[4 * g4 + 2], acc[4 * g4 + 3])}; }
        }
        __syncthreads();
    }
#undef SC_LOAD
#undef SC_STORE
}

#define RB(x) bflo(cvt_pk_bf16((x), 0.f) & 0xffffu)
__device__ __forceinline__ void gdn_scan_simple(const MKP& p, int b, int h, LAS unsigned char* lds, int tid) {
    LAS float* S = (LAS float*)lds;
    LAS float* Vn = S + 4096;
    LAS float* Sn = Vn + 4096;
    for (int i = tid; i < 4096; i += NTHR) S[i] = 0.f;
    __syncthreads();
    for (int n = 1; n < LL / 64; ++n) {
        const unsigned char* ub = (const unsigned char*)p.gch + (size_t)gch_unit(b, h, n) * GCH_BYTES;
        const bf16_t* gW = (const bf16_t*)ub; const bf16_t* gQd = gW + 4096; const bf16_t* gQK = gQd + 4096; const bf16_t* gKdT = gQK + 4096; const float* gU = (const float*)(ub + 32768);
        const float cd = p.gcd[gch_unit(b, h, n)];
        for (int e = tid; e < 4096; e += NTHR) { const int c = e >> 6, v = e & 63; float a = gU[e];
            for (int k = 0; k < 64; ++k) a -= bf2f(gW[c * 64 + k]) * RB(S[k * 64 + v]);
            Vn[e] = RB(a); }
        __syncthreads();
        for (int e = tid; e < 4096; e += NTHR) { const int c = e >> 6, v = e & 63; float a = 0.f;
            for (int k = 0; k < 64; ++k) a += bf2f(gQd[c * 64 + k]) * RB(S[k * 64 + v]) + bf2f(gQK[c * 64 + k]) * Vn[k * 64 + v];
            p.gdn_o[((size_t)b * LP + (size_t)n * 64 + c) * 256 + h * 64 + v] = a;
            float s = cd * S[e];
            for (int cc = 0; cc < 64; ++cc) s += bf2f(gKdT[c * 64 + cc]) * Vn[cc * 64 + v];
            Sn[e] = s; }
        __syncthreads();
        for (int e = tid; e < 4096; e += NTHR) S[e] = Sn[e];
        __syncthreads();
    }
}

constexpr int GSTRIDE = LL + 256;
constexpr int N_ATT_ITEMS = 33 * 24;
constexpr float LOG2E = 1.4426950408889634f;

constexpr int FOX_SEGS = (GSTRIDE + 511) / 512, FOX_WGS = NB * 4 * FOX_SEGS;
__device__ __forceinline__ void fox_seg_scan(const MKP& p, int layer, int bx, LAS unsigned char* lds, int tid, int lane, int wave) {
    if (bx >= FOX_WGS) return;
    const int bh = bx / FOX_SEGS, seg = bx % FOX_SEGS, b = bh >> 2, h = bh & 3, t = seg * 512 + tid; const float fb = p.fox_forget_b[layer * 4 + h];
    volatile LAS float* wt = (volatile LAS float*)(lds + LDS_MISC + 128);
    float ls = 0.f;
    if (t >= NLEAD && t < LL) { const float z = p.gates[((size_t)b * LP + t) * 16 + h] + fb; ls = fminf(z, 0.f) - __logf(1.f + __expf(-fabsf(z))); }
#pragma unroll
    for (int o = 1; o < 64; o <<= 1) { const float u = shfl_up_l(ls, o, lane); if (lane >= o) ls += u; }
    if (lane == 63) wt[wave] = ls;
    __syncthreads();
    float pre = 0.f;
    for (int w = 0; w < wave; ++w) pre += wt[w];
    ls += pre;
    p.fox_loc[(size_t)bh * (FOX_SEGS * 512) + t] = ls;
    if (tid == 511) p.fox_tot[bh * 32 + seg] = ls;
    __syncthreads();
}
__device__ __forceinline__ void fox_finalize(const MKP& p, int layer, int bx, int tid, int lane) {
    if (bx >= FOX_WGS) return;
    const int bh = bx / FOX_SEGS, seg = bx % FOX_SEGS, b = bh >> 2, h = bh & 3, t = seg * 512 + tid;
    float nq = 0.f, nk = 0.f;
    { const int t0 = seg * 512 + (tid & ~63), c = lane & 7; u32x4 wq[8], wk[8];
#pragma unroll
      for (int i = 0; i < 8; ++i) { int row = t0 + 8 * i + (lane >> 3); row = row < LL ? row : LL - 1; const bf16_t* pr = p.proj + ((size_t)b * LP + row) * NPJ + h * 64 + 8 * c;
          wq[i] = *(const u32x4*)(pr + P_FQ); wk[i] = *(const u32x4*)(pr + P_FK); }
      float tot[FOX_SEGS];
#pragma unroll
      for (int s2 = 0; s2 < FOX_SEGS; ++s2) tot[s2] = p.fox_tot[bh * 32 + s2];
      double base = 0.0;
#pragma unroll
      for (int s2 = 0; s2 < FOX_SEGS; ++s2) base += s2 < seg ? (double)tot[s2] : 0.0;
      if (t < GSTRIDE) {
          const float loc = p.fox_loc[(size_t)bh * (FOX_SEGS * 512) + t];
          const float gv = t < NLEAD ? -30000.f : (t < LL ? (float)(-(base + (double)loc) * (double)LOG2E) : 0.f);
          const unsigned p1 = cvt_pk_bf16(gv, 0.f) & 0xffffu; const float r1 = gv - __uint_as_float(p1 << 16);
          const unsigned p2 = cvt_pk_bf16(r1, 0.f) & 0xffffu; const float r2 = r1 - __uint_as_float(p2 << 16);
          const unsigned p3 = cvt_pk_bf16(r2, 0.f) & 0xffffu;
          p.Gk[(size_t)bh * GSTRIDE + t] = (unsigned long long)(p1 | (p2 << 16)) | ((unsigned long long)(p3 | (0x3F80u << 16)) << 32);
          p.Gf[(size_t)bh * GSTRIDE + t] = gv; }
#pragma unroll
      for (int i = 0; i < 8; ++i) { const int row = t0 + 8 * i + (lane >> 3); const u32x4 q4 = wq[i], k4 = wk[i];
          float sq = (bflo(q4.x) * bflo(q4.x) + bfhi(q4.x) * bfhi(q4.x)) + (bflo(q4.y) * bflo(q4.y) + bfhi(q4.y) * bfhi(q4.y)) + (bflo(q4.z) * bflo(q4.z) + bfhi(q4.z) * bfhi(q4.z)) + (bflo(q4.w) * bflo(q4.w) + bfhi(q4.w) * bfhi(q4.w));
          float sk = (bflo(k4.x) * bflo(k4.x) + bfhi(k4.x) * bfhi(k4.x)) + (bflo(k4.y) * bflo(k4.y) + bfhi(k4.y) * bfhi(k4.y)) + (bflo(k4.z) * bflo(k4.z) + bfhi(k4.z) * bfhi(k4.z)) + (bflo(k4.w) * bflo(k4.w) + bfhi(k4.w) * bfhi(k4.w));
          sq += __int_as_float(__builtin_amdgcn_update_dpp(0, __float_as_int(sq), 0xB1, 0xf, 0xf, true)); sk += __int_as_float(__builtin_amdgcn_update_dpp(0, __float_as_int(sk), 0xB1, 0xf, 0xf, true));
          sq += __int_as_float(__builtin_amdgcn_update_dpp(0, __float_as_int(sq), 0x4E, 0xf, 0xf, true)); sk += __int_as_float(__builtin_amdgcn_update_dpp(0, __float_as_int(sk), 0x4E, 0xf, 0xf, true));
          sq += __int_as_float(__builtin_amdgcn_update_dpp(0, __float_as_int(sq), 0x141, 0xf, 0xf, true)); sk += __int_as_float(__builtin_amdgcn_update_dpp(0, __float_as_int(sk), 0x141, 0xf, 0xf, true));
          if (row >= NLEAD && row < LL) { nq = fmaxf(nq, sq); nk = fmaxf(nk, sk); } } }
    nq = wave_max(nq); nk = wave_max(nk);
    if (lane == 0) { unsigned* mx = p.ctl + 3072 + layer * 64 + bh * 2; atomicMax(mx, __float_as_uint(nq)); atomicMax(mx + 1, __float_as_uint(nk)); }
}

__device__ __forceinline__ void phase_mixer_attn(const MKP& p, int layer, int qslot, char* lds_gen, LAS unsigned char* lds, int tid, int bx) {
    if (bx < NB * 4 && qslot < 2) {
        gdn_scan_chunked(p, layer, bx >> 2, bx & 3, lds, tid);
        __syncthreads();
#if PROBE_SUB == 103
        gdn_scan_chunked(p, layer, bx >> 2, bx & 3, lds, tid);
        __syncthreads();
#endif
        }
    volatile LAS int* misc = (volatile LAS int*)(lds + LDS_MISC);
    unsigned* qctr = p.ctl + 1024 + qslot * 64;
    for (;;) {
        if (tid == 0) misc[0] = (int)atomicAdd(qctr, 1u);
        __syncthreads(); const int item = __builtin_amdgcn_readfirstlane(misc[0]); __syncthreads();
        if (item >= N_ATT_ITEMS) break;
        int tid_u = tid; asm volatile("" : "+v"(tid_u));
        const int qb = 32 - item / 24, sub = item % 24;
#ifdef ATT_ABL
        if (qslot >= 2 && ((ATT_ABL & 1) ? sub < 16 : sub >= 16)) continue;
#endif
        if (sub < 16) { const int b = sub >> 3, h = (sub >> 1) & 3, s = sub & 1; const bf16_t* base = p.proj + (size_t)b * LP * NPJ;
            attn_body::attn_unit<2, 8>(qb, base + P_DQ + h * 128 + s * 64, base + P_DK + h * 128 + s * 64, base + P_DV + h * 128,
                                       (qslot >= 2 ? p.act : p.tmpO) + ((size_t)(h * 4 + s * 2) * MP + (size_t)b * LP) * 64, 64, nullptr, (float)NLEAD, lds_gen, tid_u, (long)MP * 64);
        } else { const int f = sub - 16, b = f >> 2, h = f & 3; const bf16_t* base = p.proj + (size_t)b * LP * NPJ;
            int tile0 = 0;
            if (qb > 0) { const unsigned* mx = p.ctl + 3072 + layer * 64 + (b * 4 + h) * 2; const float* gf = p.Gf + (size_t)(b * 4 + h) * GSTRIDE;
                const float thr = gf[qb * 256] - (2.f * sqrtf(__uint_as_float(mx[0]) * __uint_as_float(mx[1])) + 230.f); const int ntf = 4 * qb + 4, ln = tid & 63; int c = 0;
#pragma unroll
                for (int q3 = 0; q3 < 3; ++q3) { const int tt = ln + 64 * q3; const bool sk = tt < ntf - 4 && gf[tt * 64 + 63] < thr; c += __builtin_popcountll(__ballot(sk)); }
                tile0 = c & ~1; }
            attn_body::attn_unit<1, 60>(qb, base + P_FQ + h * 64, base + P_FK + h * 64, base + P_FV + h * 64,
                                        (qslot >= 2 ? p.act + (size_t)32 * MP * 64 : p.mixcat) + (size_t)b * LP * DM + 512 + h * 64, DM, p.Gk + (size_t)(b * 4 + h) * GSTRIDE, 0.f, lds_gen, tid_u, 0, tile0);
        }
    }
}

__device__ __forceinline__ void phase_diff_combine(const MKP& p, int layer, int gw, int ngw, int lane) {
    const float* lv = p.diff_lambda + layer * 256; const float* sg = p.diff_subln_g + layer * 128;
    const float lam_init = 0.8f - 0.6f * __expf(-0.3f * (float)layer);
    const float lam = __expf(wave_sum(lv[lane] * lv[64 + lane])) - __expf(wave_sum(lv[128 + lane] * lv[192 + lane])) + lam_init;
    const float g0 = sg[lane] * (1.f - lam_init), g1 = sg[64 + lane] * (1.f - lam_init); const float ng = p.gdn_norm_g[layer * 64 + lane];
    for (int row = gw; row < MP; row += ngw) { if ((row % LP) < NLEAD) { bf16_t* o = p.mixcat + (size_t)row * DM;
#pragma unroll
            for (int h = 0; h < 4; ++h) { o[h * 128 + lane] = 0; o[h * 128 + 64 + lane] = 0; o[768 + h * 64 + lane] = 0; } } }
    unsigned short a[4][4], na[4][4]; float ov[4], nov[4]; unsigned short zz[4], nzz[4];
#define D2_LOAD(row_, A_, O_, Z_) do { _Pragma("unroll") for (int h = 0; h < 4; ++h) { \
            _Pragma("unroll") for (int k = 0; k < 4; ++k) A_[h][k] = p.tmpO[((size_t)(h * 4 + k) * MP + (row_)) * 64 + lane]; \
            O_[h] = p.gdn_o[(size_t)(row_) * 256 + h * 64 + lane]; Z_[h] = p.proj[(size_t)(row_) * NPJ + P_GZ + h * 64 + lane]; } } while (0)
    int row = gw; while (row < MP && (row % LP) < NLEAD) row += ngw;
    if (row < MP) D2_LOAD(row, a, ov, zz);
    while (row < MP) { bf16_t* o = p.mixcat + (size_t)row * DM;
        int rn = row + ngw; while (rn < MP && (rn % LP) < NLEAD) rn += ngw;
        if (rn < MP) D2_LOAD(rn, na, nov, nzz);
#pragma unroll
        for (int h = 0; h < 4; ++h) { const float o0 = bf2f(a[h][0]) - lam * bf2f(a[h][2]), o1 = bf2f(a[h][1]) - lam * bf2f(a[h][3]);
            const float r = rsqrtf(wave_sum(o0 * o0 + o1 * o1) * (1.f / 128.f) + 1e-5f);
            o[h * 128 + lane] = (bf16_t)(cvt_pk_bf16(o0 * r * g0, 0.f) & 0xffffu); o[h * 128 + 64 + lane] = (bf16_t)(cvt_pk_bf16(o1 * r * g1, 0.f) & 0xffffu);
            const float rr = rsqrtf(wave_sum(ov[h] * ov[h]) * (1.f / 64.f) + 1e-6f); const float z = bf2f(zz[h]);
            o[768 + h * 64 + lane] = (bf16_t)(cvt_pk_bf16(ov[h] * rr * ng * z * __builtin_amdgcn_rcpf(1.f + __expf(-z)), 0.f) & 0xffffu); }
        row = rn;
#pragma unroll
        for (int h = 0; h < 4; ++h) { ov[h] = nov[h]; zz[h] = nzz[h];
#pragma unroll
            for (int k = 0; k < 4; ++k) a[h][k] = na[h][k]; }
    }
#undef D2_LOAD
}

#ifndef PROBE_SUB
#define PROBE_SUB -1
#endif
#ifndef PROBE_NREP
#define PROBE_NREP 1
#endif
constexpr int PH_PER_LAYER = 9, N_PHASES = PROBE_SUB == 100 ? 2 + 2 * PH_PER_LAYER : (PROBE_SUB >= 0 ? 1 + 2 * (PH_PER_LAYER + PROBE_NREP) : 1 + 2 * PH_PER_LAYER);

template <class T> __device__ __forceinline__ T* lnd_global(T* x) { __attribute__((address_space(1))) T* g = (__attribute__((address_space(1))) T*)x; asm volatile("" : "+s"(g)); return (T*)g; }
#define LND(x) x = lnd_global(x)
__global__ void __launch_bounds__(NTHR, 2) mk_fwd(MKP p) {
    extern __shared__ __attribute__((aligned(16))) unsigned char lds_raw[];
    LAS unsigned char* lds0 = (LAS unsigned char*)lds_raw;
    { volatile LAS unsigned* st0 = (volatile LAS unsigned*)(lds0 + LDS_MISC + 64); if (threadIdx.x < 2) st0[threadIdx.x] = 0u; __syncthreads(); }
    XcdBarrier bar = xcd_barrier_post(p.ctl + 4096, (volatile LAS unsigned*)(lds0 + LDS_MISC + 64));
    const int lo = p.ph_lo, hi = p.ph_hi;
    const int wave_s = __builtin_amdgcn_readfirstlane((int)threadIdx.x >> 6);
#ifndef PROBE_SUB
#define PROBE_SUB -1
#endif
    for (int ph = lo; ph < hi; ++ph) {
        bool phase_is0; int layer = 0, sub = 0, rep = 0;
        if (PROBE_SUB == 100) { phase_is0 = ph < 2; if (!phase_is0) { layer = (ph - 2) / PH_PER_LAYER; sub = (ph - 2) % PH_PER_LAYER; } }
        else if (PROBE_SUB >= 0) { phase_is0 = ph == 0; if (!phase_is0) { layer = (ph - 1) / (PH_PER_LAYER + PROBE_NREP); const int s = (ph - 1) % (PH_PER_LAYER + PROBE_NREP); sub = s <= PROBE_SUB ? s : (s <= PROBE_SUB + PROBE_NREP ? PROBE_SUB : s - PROBE_NREP); rep = s > PROBE_SUB && s <= PROBE_SUB + PROBE_NREP; } }
        else { phase_is0 = ph == 0; if (!phase_is0) { layer = (ph - 1) / PH_PER_LAYER; sub = (ph - 1) % PH_PER_LAYER; } }
        int tid, G = gridDim.x, bx = blockIdx.x; asm volatile("v_mbcnt_lo_u32_b32 %0, -1, 0\n\tv_mbcnt_hi_u32_b32 %0, -1, %0" : "=v"(tid)); tid += wave_s * 64; asm volatile("" : "+v"(tid), "+s"(G), "+s"(bx));
        const int vcu = (G % 8 == 0) ? (bx % 8) * (G / 8) + bx / 8 : bx;
        const int ngw = G * NWAVES;
        const int lane = tid & 63, wave = __builtin_amdgcn_readfirstlane(tid >> 6), gw = vcu * NWAVES + wave;
        LAS unsigned char* lds = lds0; asm volatile("" : "+s"(lds));
        MKP q = p;
        if (phase_is0) {
#ifndef NO_P0
            LND(q.w_in); LND(q.w_out); LND(q.w1); LND(q.w2); LND(q.Win_t); LND(q.Wout_t); LND(q.W1_t); LND(q.W2_t); LND(q.wgc);
            float gwv[24]; gate_w_load(q.w_in, gwv, tid);
            if (bx >= 12 && bx < 14) { LND(q.router_w); LND(q.rwT); const int l = bx - 12; const float* rw = q.router_w + (size_t)l * DM * NE; float* dst = q.rwT + (size_t)l * NE * (DM + 4);
                for (int i = tid; i < DM * NE; i += NTHR) { const int k = i >> 5, e = i & 31; dst[e * (DM + 4) + k] = rw[i]; }
                for (int i = tid; i < NE * 4; i += NTHR) dst[(i >> 2) * (DM + 4) + DM + (i & 3)] = 0.f; }
            if (bx < 12) { const float* wl = q.w_in + (size_t)DM * NPROJ; const int col = bx < 4 ? C_FF + bx : (bx < 8 ? C_GB + (bx - 4) : C_GA + (bx - 8)); for (int k = tid; k < DM; k += NTHR) q.wgc[bx * DM + k] = wl[(size_t)k * NPROJ + col]; }
            phase_convert_weights(q, lds, gw, ngw, wave, lane);
#if PROBE_SUB == 101
            __syncthreads(); phase_convert_weights(q, lds, gw, ngw, wave, lane);
#endif
            __syncthreads();
            LND(q.x); LND(q.meta); LND(q.ln_in_g); LND(q.ln_in_b); LND(q.stream); LND(q.actb); LND(q.gates);
            phase_ln_in(q, lds, gw, ngw, tid, lane, gwv);
#endif
        } else {
            if (sub == 0) {
#ifndef NO_S0
                LND(q.fox_forget_b); LND(q.gates); LND(q.fox_loc); LND(q.fox_tot); fox_seg_scan(q, layer, bx, lds, tid, lane, wave);
                LND(q.actb); LND(q.Win_t); LND(q.proj);
                pg8::Gemm g{q.actb, q.Win_t + (size_t)layer * NPJ * DM, DM, 0}; pg8::DenseOrder S; S.init(MP / 256, NPJ / 256, G, bx);
                pg8::EpiStoreBf16 E{q.proj, NPJ, nullptr, 0};
                pg8::gemm_phase<pg8::EpiStoreBf16, pg8::DenseOrder, false>(lds, g, S, E, tid);
                if (bx >= 77) { LND(q.w1); LND(q.W1_t); convert_w1_deferred(q, lds, layer, ((bx - 77) * NWAVES + wave) * W1_Q, wave, lane); }
#endif
            } else if (sub == 1) { LND(q.fox_loc); LND(q.fox_tot); LND(q.Gk); LND(q.Gf); LND(q.proj); LND(q.ctl); if (!rep) fox_finalize(q, layer, bx, tid, lane);
                LND(q.gdn_conv_w); LND(q.gdn_a_log); LND(q.gdn_dt_bias); LND(q.proj); LND(q.gch); LND(q.gcd); LND(q.act); phase_gdn_chunk_prep(q, layer, vcu, G, lds, tid, lane, rep);
            } else if (sub == 2) { LND(q.proj); LND(q.tmpO); LND(q.mixcat); LND(q.Gk); LND(q.Gf); LND(q.ctl); LND(q.act); LND(q.gch); LND(q.gcd); LND(q.gdn_o); LND(q.gdn_conv_w); LND(q.gdn_a_log); LND(q.gdn_dt_bias); LND(q.gates); phase_mixer_attn(q, layer, layer + 2 * rep, (char*)lds_raw, lds, tid, bx);
            } else if (sub == 3) { LND(q.diff_lambda); LND(q.diff_subln_g); LND(q.tmpO); LND(q.mixcat); LND(q.gdn_o); LND(q.gdn_norm_g); LND(q.proj); phase_diff_combine(q, layer, gw, ngw, lane);
            } else if (sub == 4) {
#ifndef NO_S4
                LND(q.mixcat); LND(q.Wout_t); LND(q.stream);
                pg8::Gemm g{q.mixcat, q.Wout_t + (size_t)layer * DM * DM, DM, 0}; pg8::DenseOrder S; S.init(MP / 256, DM / 256, G, bx);
                LND(q.actb); pg8::EpiResid E{(bf16_t*)q.stream, q.actb, DM, DN_ALPHA};
                pg8::gemm_phase<pg8::EpiResid, pg8::DenseOrder, false>(lds, g, S, E, tid);
                if (bx >= 4) { LND(q.w1); LND(q.W1_t); convert_w1_deferred(q, lds, layer, W1_DEFER_A + ((bx - 4) * NWAVES + wave) * W1_Q, wave, lane); }
#endif
            } else if (sub == 5) {
#ifndef NO_S5
                LND(q.rwT); LND(q.router_b); LND(q.cnt); LND(q.stream); LND(q.ln1_g); LND(q.ln1_b); LND(q.actb); LND(q.tok_e); LND(q.tok_pos); LND(q.tok_gate); LND(q.etok);
                LND(q.act); LND(q.gch); phase_ln1_route(q, layer, lds, gw, ngw, tid, lane, rep);
#endif
            } else if (sub == 6) {
#ifndef NO_S6
                LND(q.actb); LND(q.W1_t); LND(q.cnt); LND(q.etok); LND(q.act); LND(q.b1);
                if (layer == 1) {
                    int np = 0; if (lane < NE) np = (q.cnt[lane * CNT_STRIDE] + 255) >> 8; const int P0 = (int)(wave_sum((float)np) + 0.5f);
                    const int idle = (G - moe_last_round_units(8 * P0, G)) + (G - moe_last_round_units(4 * P0, G)), covered = idle * NWAVES * W1_Q;
                    LND(q.w2); LND(q.W2_t); convert_w2_blocks(q, lds, covered + gw, ngw, 1 << 20, wave, lane); __syncthreads(); }
                volatile LAS int* tab = (volatile LAS int*)(lds + LDS_TAB); build_expert_tab(q.cnt + layer * 2048, tab, tid);
                pg8::Gemm g{q.actb, q.W1_t + (size_t)layer * NE * 2 * DE * DM, DM, (size_t)2 * DE * DM};
                pg8::ExpertOrder S{tab, q.cnt + layer * 2048, q.etok, 8, G, bx};
                pg8::EpiSwiglu E{q.act, q.b1 + (size_t)layer * NE * 2 * DE};
                const int P_ = __builtin_amdgcn_readfirstlane(tab[0]);
                pg8::gemm_phase<pg8::EpiSwiglu, pg8::ExpertOrder, true>(lds, g, S, E, tid);
                if (layer == 0) { const int rem = moe_last_round_units(8 * P_, G);
                    if (bx >= rem) { LND(q.w2); LND(q.W2_t); convert_w2_blocks(q, lds, ((bx - rem) * NWAVES + wave) * W1_Q, 1, W1_Q, wave, lane); } }
#endif
            } else if (sub == 7) {
#ifndef NO_S7
                LND(q.act); LND(q.W2_t); LND(q.cnt); LND(q.etok); LND(q.ybuf); LND(q.b2);
                volatile LAS int* tab = (volatile LAS int*)(lds + LDS_TAB); build_expert_tab(q.cnt + layer * 2048, tab, tid);
                pg8::Gemm g{q.act, q.W2_t + (size_t)layer * NE * DM * DE, DE, (size_t)DM * DE};
                pg8::ExpertOrder S{tab, q.cnt + layer * 2048, q.etok, 4, G, bx};
                pg8::EpiStoreBf16 E{q.ybuf, DM, q.b2 + (size_t)layer * NE * DM, DM};
                const int P_ = __builtin_amdgcn_readfirstlane(tab[0]);
                pg8::gemm_phase<pg8::EpiStoreBf16, pg8::ExpertOrder, false>(lds, g, S, E, tid);
                if (layer == 0) { const int idle1 = G - moe_last_round_units(8 * P_, G), rem = moe_last_round_units(4 * P_, G);
                    if (bx >= rem) { LND(q.w2); LND(q.W2_t); convert_w2_blocks(q, lds, ((idle1 + bx - rem) * NWAVES + wave) * W1_Q, 1, W1_Q, wave, lane); } }
#endif
            } else if (sub == 8) {
#ifndef NO_S8
                LND(q.cnt); LND(q.wgc); LND(q.stream); LND(q.tok_e); LND(q.tok_pos); LND(q.tok_gate); LND(q.ybuf); LND(q.ln2_g); LND(q.ln2_b); LND(q.actb); LND(q.gates); LND(q.out);
                LND(q.act); LND(q.gch); phase_combine_ln2(q, layer, lds, gw, ngw, tid, lane, rep);
#endif
            }
        }
        if (ph + 1 < hi) xcd_barrier(bar);
    }
}

__global__ __launch_bounds__(256) void k_proj_to_naive(const bf16_t* __restrict__ proj, const float* __restrict__ gates, float* __restrict__ nproj) {
    const int row = blockIdx.x;
    for (int c = threadIdx.x; c < NPROJ; c += 256) { float v;
        if (c < 2304) { v = bf2f(proj[(size_t)row * NPJ + c]); if (c < 512 || (c >= C_FQ && c < C_FK)) v *= (1.f / QK_C2); }
        else if (c < 2308) v = gates[(size_t)row * 16 + (c - 2304)];
        else if (c < 3076) v = bf2f(proj[(size_t)row * NPJ + P_GQKV + (c - 2308)]);
        else if (c < 3084) v = gates[(size_t)row * 16 + 4 + (c - 3076)];
        else v = bf2f(proj[(size_t)row * NPJ + P_GZ + (c - 3084)]);
        nproj[(size_t)row * NPROJ + c] = v; }
}
__global__ __launch_bounds__(256) void k_gdn_to_fast(const float* __restrict__ nm, bf16_t* __restrict__ m) {
    const int row = blockIdx.x, c = threadIdx.x, t = row % LP; const float v = (t >= 64 && t < LL) ? nm[(size_t)row * DM + 768 + c] : 0.f; m[(size_t)row * DM + 768 + c] = (bf16_t)(cvt_pk_bf16(v, 0.f) & 0xffffu);
}
__global__ __launch_bounds__(256) void k_mixcat_to_fast(const float* __restrict__ nm, bf16_t* __restrict__ m) {
    const size_t i = ((size_t)blockIdx.x * 256 + threadIdx.x) * 2; if (i >= (size_t)MP * DM) return; *(unsigned*)(m + i) = cvt_pk_bf16(nm[i], nm[i + 1]);
}


#ifdef GDN_DEBUG
__global__ __launch_bounds__(256) void k_dbg_cmp(const float* __restrict__ ref, const bf16_t* __restrict__ fast, float* __restrict__ stats) {
    const int row = blockIdx.x, c = threadIdx.x, t = row % LP; if (t < NLEAD) return;
    const int h = c >> 6, tm = t & 63, cls = 3 * h + (tm == 0 ? 0 : tm == 63 ? 1 : 2);
    const float r = ref[(size_t)row * DM + 768 + c], f = bf2f(fast[(size_t)row * DM + 768 + c]);
    float e = wave_sum((r - f) * (r - f)), q = wave_sum(r * r);
    if ((c & 63) == 0) { atomicAdd(&stats[2 * cls], e); atomicAdd(&stats[2 * cls + 1], q); }
}
__global__ void k_dbg_scale(const float* __restrict__ stats, float* __restrict__ out, int n) {
    float worst = 0.f; int wc = -1;
    for (int c = 0; c < 12; ++c) { const float rel = stats[2 * c] / fmaxf(stats[2 * c + 1], 1e-30f); if (rel > worst) { worst = rel; wc = c; } }
    float scale = 1.f;
#if GDN_DEBUG == 1
    if (worst > 1e-3f) scale = 1.f + 0.1f * (float)(wc + 1);
#else
    { const int c = GDN_DEBUG % 100; scale = 1.f + sqrtf(stats[2 * c] / fmaxf(stats[2 * c + 1], 1e-30f)); }
#endif
    for (size_t i = (size_t)blockIdx.x * blockDim.x + threadIdx.x; i < (size_t)n; i += (size_t)gridDim.x * blockDim.x) out[i] *= scale;
}
#endif
struct Bump { char* base; size_t off, cap; void* get(size_t bytes) { off = (off + 255) & ~(size_t)255; void* p = base + off; off += bytes; return p; } };
struct NaiveBufs { float *stream, *proj, *mixcat, *mix, *x1, *tmpA, *cum, *gq, *gk, *gv, *gbeta, *gg, *gate, *act, *y; int *rowmask, *topidx, *pos, *tokslot, *cnt, *offs, *slot_tok; };

static void launch_mk(MKP p, int lo, int hi, int grid, hipStream_t st) {
    p.ph_lo = lo; p.ph_hi = hi; void* args[] = {&p};
    hipError_t e = hipLaunchCooperativeKernel((const void*)mk_fwd, dim3(grid), dim3(NTHR), args, LDS_BYTES, st);
    if (e != hipSuccess) fprintf(stderr, "cooperative launch failed: %s (grid %d)\n", hipGetErrorString(e), grid);
}
static void naive_mixer(void* const* d_in, int layer, NaiveBufs& nb, hipStream_t st) {
    const float* diff_lambda = (const float*)d_in[5]; const float* diff_subln_g = (const float*)d_in[6]; const float* fox_forget_b = (const float*)d_in[7];
    const float* gdn_conv_w = (const float*)d_in[8]; const float* gdn_a_log = (const float*)d_in[9]; const float* gdn_dt_bias = (const float*)d_in[10]; const float* gdn_norm_g = (const float*)d_in[11];
    const float lam_init = 0.8f - 0.6f * expf(-0.3f * (float)layer);
    k_fox_cum<<<NB * 4, 64, 0, st>>>(nb.proj, fox_forget_b + layer * 4, nb.cum);
    k_nattn<<<dim3(LL / 64, 20, NB), 64, 0, st>>>(nb.proj, nb.cum, nb.tmpA, nb.mixcat);
    k_diff_combine<<<(MP * 4 * 64 + 255) / 256, 256, 0, st>>>(nb.tmpA, diff_lambda + layer * 256, diff_subln_g + layer * 128, lam_init, nb.mixcat);
    k_gdn_prep<<<MP, 256, 0, st>>>(nb.proj, gdn_conv_w + layer * 4 * 768, gdn_a_log + layer * 4, gdn_dt_bias + layer * 4, nb.gq, nb.gk, nb.gv, nb.gbeta, nb.gg);
    k_gdn_seq<<<NB * 4, 64, 0, st>>>(nb.gq, nb.gk, nb.gv, nb.gbeta, nb.gg, nb.proj, gdn_norm_g + layer * 64, nb.mixcat);
    k_gdn_gate<<<MP, 256, 0, st>>>(nb.proj, nb.mixcat);
    k_zero_pad_rows<<<(MP * 64 + 255) / 256, 256, 0, st>>>(nb.mixcat);
}

extern "C" void kernel_launch(void* const* d_in, const int* in_sizes, int n_in, void* d_out, int out_size, void* d_ws, size_t ws_size, hipStream_t stream) {
    static int grid = 0;
    if (grid == 0) {
        int dev = 0, cus = 0, per_cu = 0; hipGetDevice(&dev); hipDeviceGetAttribute(&cus, hipDeviceAttributeMultiprocessorCount, dev);
        if (hipFuncSetAttribute((const void*)mk_fwd, hipFuncAttributeMaxDynamicSharedMemorySize, LDS_BYTES) != hipSuccess) fprintf(stderr, "hipFuncSetAttribute failed\n");
        if (hipOccupancyMaxActiveBlocksPerMultiprocessor(&per_cu, (const void*)mk_fwd, NTHR, LDS_BYTES) != hipSuccess || per_cu < 1) { fprintf(stderr, "occupancy query: %d\n", per_cu); per_cu = 1; }
        (void)hipGetLastError();
        grid = cus * 1;
    }
    Bump bp{(char*)d_ws, 0, ws_size};
    MKP p{};
    p.x = (const float*)d_in[0]; p.meta = (const float*)d_in[1]; p.ln_in_g = (const float*)d_in[2]; p.ln_in_b = (const float*)d_in[3]; p.w_in = (const float*)d_in[4];
    p.diff_lambda = (const float*)d_in[5]; p.diff_subln_g = (const float*)d_in[6]; p.fox_forget_b = (const float*)d_in[7]; p.gdn_conv_w = (const float*)d_in[8]; p.gdn_a_log = (const float*)d_in[9];
    p.gdn_dt_bias = (const float*)d_in[10]; p.gdn_norm_g = (const float*)d_in[11]; p.w_out = (const float*)d_in[12]; p.ln1_g = (const float*)d_in[13]; p.ln1_b = (const float*)d_in[14];
    p.router_w = (const float*)d_in[15]; p.router_b = (const float*)d_in[16]; p.w1 = (const float*)d_in[17]; p.b1 = (const float*)d_in[18]; p.w2 = (const float*)d_in[19]; p.b2 = (const float*)d_in[20];
    p.ln2_g = (const float*)d_in[21]; p.ln2_b = (const float*)d_in[22]; p.out = (float*)d_out;
    p.ctl = (unsigned*)bp.get(1 << 20); p.cnt = (int*)(p.ctl + 65536);
    p.Win_t = (bf16_t*)bp.get((size_t)2 * NPJ * DM * 2); p.Wout_t = (bf16_t*)bp.get((size_t)2 * DM * DM * 2);
    p.W1_t = (bf16_t*)bp.get((size_t)2 * NE * 2 * DE * DM * 2); p.W2_t = (bf16_t*)bp.get((size_t)2 * NE * DM * DE * 2);
    p.stream = (float*)bp.get((size_t)MP * DM * 4); p.actb = (bf16_t*)bp.get((size_t)MP * DM * 2); p.proj = (bf16_t*)bp.get((size_t)(MP + 256) * NPJ * 2);
    p.gates = (float*)bp.get((size_t)MP * 16 * 4); p.mixcat = (bf16_t*)bp.get((size_t)MP * DM * 2);
    p.act = (bf16_t*)bp.get((size_t)PMAX * 256 * DE * 2); p.ybuf = (bf16_t*)bp.get((size_t)PMAX * 256 * DM * 2);
    p.tmpO = (bf16_t*)bp.get((size_t)16 * MP * 64 * 2 + 65536); p.Gk = (unsigned long long*)bp.get((size_t)8 * GSTRIDE * 8);
    p.wgc = (float*)bp.get(12 * DM * 4); p.rwT = (float*)bp.get((size_t)2 * NE * (DM + 4) * 4);
    p.Gf = (float*)bp.get((size_t)8 * GSTRIDE * 4);
    p.fox_loc = (float*)bp.get((size_t)8 * 17 * 512 * 4); p.fox_tot = (float*)bp.get(8 * 32 * 4);
    p.gch = (unsigned char*)bp.get((size_t)GCH_UNITS * GCH_BYTES); p.gcd = (float*)bp.get((size_t)GCH_UNITS * 4);
    p.gq = (float*)bp.get((size_t)MP * 256 * 4); p.gk = (float*)bp.get((size_t)MP * 256 * 4); p.gv = (float*)bp.get((size_t)MP * 256 * 4); p.gsc = (float*)bp.get((size_t)MP * 16 * 4); p.gdn_o = (float*)bp.get((size_t)MP * 256 * 4);
    p.etok = (int*)bp.get((size_t)NE * MP * 4); p.tok_e = (int*)bp.get((size_t)MP * 4 * 4); p.tok_pos = (int*)bp.get((size_t)MP * 4 * 4); p.tok_gate = (float*)bp.get((size_t)MP * 4 * 4);
    if (bp.off > ws_size) { fprintf(stderr, "kernel_launch: workspace too small: need %zu have %zu\n", bp.off, ws_size); return; }
    (void)hipMemsetAsync(p.ctl, 0, 1 << 20, stream);
    launch_mk(p, 0, N_PHASES, grid, stream);
#ifdef GDN_DEBUG
    { NaiveBufs nb{}; nb.proj = (float*)bp.get((size_t)MP * NPROJ * 4); nb.mixcat = (float*)bp.get((size_t)MP * DM * 4);
      nb.gq = (float*)bp.get((size_t)MP * 256 * 4); nb.gk = (float*)bp.get((size_t)MP * 256 * 4); nb.gv = (float*)bp.get((size_t)MP * 256 * 4); nb.gbeta = (float*)bp.get((size_t)MP * 4 * 4); nb.gg = (float*)bp.get((size_t)MP * 4 * 4);
      float* stats = (float*)bp.get(256); (void)hipMemsetAsync(stats, 0, 256, stream); const int layer = 1;
      k_proj_to_naive<<<MP, 256, 0, stream>>>(p.proj, p.gates, nb.proj);
      k_gdn_prep<<<MP, 256, 0, stream>>>(nb.proj, (const float*)d_in[8] + layer * 4 * 768, (const float*)d_in[9] + layer * 4, (const float*)d_in[10] + layer * 4, nb.gq, nb.gk, nb.gv, nb.gbeta, nb.gg);
      k_gdn_seq<<<NB * 4, 64, 0, stream>>>(nb.gq, nb.gk, nb.gv, nb.gbeta, nb.gg, nb.proj, (const float*)d_in[11] + layer * 64, nb.mixcat);
      k_gdn_gate<<<MP, 256, 0, stream>>>(nb.proj, nb.mixcat);
      k_dbg_cmp<<<MP, 256, 0, stream>>>(nb.mixcat, p.mixcat, stats);
      k_dbg_scale<<<256, 256, 0, stream>>>(stats, (float*)d_out, out_size); }
#endif
}
```

```cpp
#include <hip/hip_runtime.h>
#include <cstdio>
#include <cstdint>
#include <cmath>

constexpr int NB = 2, SEQ = 8192, DM = 1024, NLEAD = 112, NMETA = 16, LL = 8320;
constexpr int LP = 8320, MP = NB * LP;
constexpr int NPROJ = 3340;
constexpr int C_DQ = 0, C_DK = 512, C_DV = 1024, C_FQ = 1536, C_FK = 1792, C_FV = 2048, C_FF = 2304, C_GQKV = 2308, C_GB = 3076, C_GA = 3080, C_GZ = 3084;
constexpr int NE = 32, TOPK = 4, DE = 1024;
constexpr float DN_ALPHA = 1.4142135623730951f;
constexpr int NSLOT = TOPK * MP;

#define WAVE_RED(OP) \
    v = OP(v, __int_as_float(__builtin_amdgcn_update_dpp(0, __float_as_int(v), 0xB1, 0xf, 0xf, true)));     \
    v = OP(v, __int_as_float(__builtin_amdgcn_update_dpp(0, __float_as_int(v), 0x4E, 0xf, 0xf, true)));     \
    v = OP(v, __int_as_float(__builtin_amdgcn_update_dpp(0, __float_as_int(v), 0x141, 0xf, 0xf, true)));    \
    v = OP(v, __int_as_float(__builtin_amdgcn_update_dpp(0, __float_as_int(v), 0x140, 0xf, 0xf, true)));    \
    v = OP(v, __int_as_float(__builtin_amdgcn_ds_swizzle(__float_as_int(v), 0x401F)));                      \
    { auto rr = __builtin_amdgcn_permlane32_swap(__float_as_uint(v), __float_as_uint(v), false, false); v = OP(__uint_as_float(rr[0]), __uint_as_float(rr[1])); }
__device__ __forceinline__ float wave_sum(float v) {
#define OPADD(a, b) ((a) + (b))
    WAVE_RED(OPADD)
#undef OPADD
    return v;
}
__device__ __forceinline__ float wave_max(float v) {
    WAVE_RED(fmaxf)
    return v;
}
__device__ __forceinline__ float shfl_up_l(float v, int o, int lane) { const float u = __int_as_float(__builtin_amdgcn_ds_bpermute(((lane - o) & 63) << 2, __float_as_int(v))); return u; }
__device__ __forceinline__ int shfl_up_li(int v, int o, int lane) { return __builtin_amdgcn_ds_bpermute(((lane - o) & 63) << 2, v); }
__device__ __forceinline__ float shfl_idx(float v, int idx) { return __int_as_float(__builtin_amdgcn_ds_bpermute(idx << 2, __float_as_int(v))); }
__device__ __forceinline__ bool row_valid(int t) { return t >= NLEAD && t < LL; }

__global__ __launch_bounds__(256) void k_ln_in(const float* __restrict__ x, const float* __restrict__ meta, const float* __restrict__ g, const float* __restrict__ bta, float* __restrict__ stream) {
    const int w = (blockIdx.x * 256 + threadIdx.x) >> 6, lane = threadIdx.x & 63;
    if (w >= NB * LL) return;
    const int b = w / LL, t = w % LL;
    const float* src = nullptr;
    if (t >= NLEAD + NMETA) src = x + ((size_t)b * SEQ + (t - NLEAD - NMETA)) * DM;
    else if (t >= NLEAD) src = meta + (size_t)(t - NLEAD) * DM;
    float4 v[4]; float s = 0.f;
#pragma unroll
    for (int j = 0; j < 4; ++j) { v[j] = src ? ((const float4*)src)[lane + 64 * j] : make_float4(0.f, 0.f, 0.f, 0.f); s += (v[j].x + v[j].y) + (v[j].z + v[j].w); }
    const float mean = wave_sum(s) * (1.f / DM); float q = 0.f;
#pragma unroll
    for (int j = 0; j < 4; ++j) { v[j].x -= mean; v[j].y -= mean; v[j].z -= mean; v[j].w -= mean; q += (v[j].x * v[j].x + v[j].y * v[j].y) + (v[j].z * v[j].z + v[j].w * v[j].w); }
    const float rstd = rsqrtf(wave_sum(q) * (1.f / DM) + 1e-5f);
    float4* o = (float4*)(stream + ((size_t)b * LP + t) * DM);
#pragma unroll
    for (int j = 0; j < 4; ++j) { const float4 gg = ((const float4*)g)[lane + 64 * j], bb = ((const float4*)bta)[lane + 64 * j];
        o[lane + 64 * j] = make_float4(v[j].x * rstd * gg.x + bb.x, v[j].y * rstd * gg.y + bb.y, v[j].z * rstd * gg.z + bb.z, v[j].w * rstd * gg.w + bb.w); }
}

struct NG {
    const float* A; int lda; const int* arow;
    const float* B; int ldb; size_t strideB;
    float* C; int ldc; int M, N, K;
    const int* Mdev; const int* offs;
    const float* bias; int strideBias;
};
template <int MODE> __global__ __launch_bounds__(256) void k_ngemm(NG p) {
    __shared__ float As[16][68]; __shared__ float Bs[16][64]; __shared__ float Bs2[MODE == 1 ? 16 : 1][64];
    const int z = blockIdx.z; const int M = p.Mdev ? p.Mdev[z] : p.M;
    const int m0 = blockIdx.y * 64, n0 = blockIdx.x * 64; if (m0 >= M) return;
    const int rowbase = p.offs ? p.offs[z] : 0;
    const float* B = p.B + (size_t)z * p.strideB;
    const int tid = threadIdx.x, lr = tid >> 2, lk = (tid & 3) * 4;
    const float* ap = nullptr;
    { const int r = m0 + lr; if (r < M) { int idx; if (MODE == 1) idx = p.arow[rowbase + r]; else if (MODE == 2) idx = rowbase + r; else idx = p.arow ? p.arow[r] : r; if (idx >= 0) ap = p.A + (size_t)idx * p.lda; } }
    const int bk = tid >> 4, bn = (tid & 15) * 4; const bool bok = (n0 + bn) < p.N;
    const int tx = tid & 15, ty = tid >> 4;
    float acc[4][4], acc2[4][4];
#pragma unroll
    for (int i = 0; i < 4; ++i)
#pragma unroll
        for (int j = 0; j < 4; ++j) { acc[i][j] = 0.f; acc2[i][j] = 0.f; }
    float4 av = ap ? *(const float4*)(ap + lk) : make_float4(0.f, 0.f, 0.f, 0.f);
    float4 bv = bok ? *(const float4*)(B + (size_t)bk * p.ldb + n0 + bn) : make_float4(0.f, 0.f, 0.f, 0.f);
    float4 bv2 = make_float4(0.f, 0.f, 0.f, 0.f);
    if (MODE == 1) bv2 = *(const float4*)(B + (size_t)bk * p.ldb + DE + n0 + bn);
    for (int k0 = 0; k0 < p.K; k0 += 16) {
        __syncthreads();
        As[lk + 0][lr] = av.x; As[lk + 1][lr] = av.y; As[lk + 2][lr] = av.z; As[lk + 3][lr] = av.w;
        *(float4*)&Bs[bk][bn] = bv; if (MODE == 1) *(float4*)&Bs2[bk][bn] = bv2;
        __syncthreads();
        if (k0 + 16 < p.K) {
            av = ap ? *(const float4*)(ap + k0 + 16 + lk) : make_float4(0.f, 0.f, 0.f, 0.f);
            bv = bok ? *(const float4*)(B + (size_t)(k0 + 16 + bk) * p.ldb + n0 + bn) : make_float4(0.f, 0.f, 0.f, 0.f);
            if (MODE == 1) bv2 = *(const float4*)(B + (size_t)(k0 + 16 + bk) * p.ldb + DE + n0 + bn);
        }
#pragma unroll
        for (int kk = 0; kk < 16; ++kk) {
            const float4 a = *(const float4*)&As[kk][ty * 4]; const float4 b = *(const float4*)&Bs[kk][tx * 4];
            const float aa[4] = {a.x, a.y, a.z, a.w}, bb[4] = {b.x, b.y, b.z, b.w};
#pragma unroll
            for (int i = 0; i < 4; ++i)
#pragma unroll
                for (int j = 0; j < 4; ++j) acc[i][j] += aa[i] * bb[j];
            if (MODE == 1) { const float4 b2 = *(const float4*)&Bs2[kk][tx * 4]; const float b2b[4] = {b2.x, b2.y, b2.z, b2.w};
#pragma unroll
                for (int i = 0; i < 4; ++i)
#pragma unroll
                    for (int j = 0; j < 4; ++j) acc2[i][j] += aa[i] * b2b[j]; }
        }
    }
#pragma unroll
    for (int i = 0; i < 4; ++i) { const int r = m0 + ty * 4 + i; if (r >= M) continue;
#pragma unroll
        for (int j = 0; j < 4; ++j) { const int n = n0 + tx * 4 + j; if (n >= p.N) continue;
            if (MODE == 0) p.C[(size_t)r * p.ldc + n] = acc[i][j];
            else if (MODE == 1) { const float* bs = p.bias + (size_t)z * p.strideBias; float glu = acc[i][j] + bs[n], lin = acc2[i][j] + bs[DE + n];
                glu = fminf(glu, 7.f); lin = fminf(fmaxf(lin, -7.f), 7.f); const float sg = 1.f / (1.f + expf(-1.702f * glu));
                p.C[(size_t)(rowbase + r) * p.ldc + n] = glu * sg * (lin + 1.f); }
            else { const float* bs = p.bias + (size_t)z * p.strideBias; p.C[(size_t)(rowbase + r) * p.ldc + n] = acc[i][j] + bs[n]; } }
    }
}

__global__ void k_rowmask(int* rm) { const int r = blockIdx.x * 256 + threadIdx.x; if (r < MP) rm[r] = row_valid(r % LP) ? r : -1; }

__global__ __launch_bounds__(64) void k_fox_cum(const float* __restrict__ proj, const float* __restrict__ fbias, float* __restrict__ cum) {
    const int b = blockIdx.x >> 2, h = blockIdx.x & 3, lane = threadIdx.x; double base = 0.0; const float fb = fbias[h];
    for (int t0 = 0; t0 < LL; t0 += 64) { const int t = t0 + lane; const float z = proj[((size_t)b * LP + t) * NPROJ + C_FF + h] + fb;
        float ls = fminf(z, 0.f) - log1pf(expf(-fabsf(z)));
#pragma unroll
        for (int o = 1; o < 64; o <<= 1) { const float u = __shfl_up(ls, o); if (lane >= o) ls += u; }
        cum[((size_t)b * 4 + h) * LP + t] = (float)(base + (double)ls); base += (double)__shfl(ls, 63); }
}

__global__ __launch_bounds__(64) void k_nattn(const float* __restrict__ proj, const float* __restrict__ cum, float* __restrict__ tmpA, float* __restrict__ mixcat) {
    __shared__ float Ks[64][64]; __shared__ float Vs[64][64];
    const int c = blockIdx.x, job = blockIdx.y, b = blockIdx.z, lane = threadIdx.x;
    int qcol, kcol, vcol, mode; float* out; int old; const float* cm = nullptr;
    if (job < 16) { const int h = job >> 2, s = (job >> 1) & 1, half = job & 1; qcol = C_DQ + h * 128 + s * 64; kcol = C_DK + h * 128 + s * 64; vcol = C_DV + h * 128 + half * 64; mode = 0;
        out = tmpA + (size_t)job * MP * 64; old = 64; }
    else { const int h = job - 16; qcol = C_FQ + h * 64; kcol = C_FK + h * 64; vcol = C_FV + h * 64; mode = 1; out = mixcat + 512 + h * 64; old = DM; cm = cum + ((size_t)b * 4 + h) * LP; }
    const int t = c * 64 + lane; const size_t row = (size_t)b * LP + t;
    float q[64], o[64];
#pragma unroll
    for (int d = 0; d < 64; d += 4) { const float4 v = *(const float4*)(proj + row * NPROJ + qcol + d); q[d] = v.x * 0.125f; q[d + 1] = v.y * 0.125f; q[d + 2] = v.z * 0.125f; q[d + 3] = v.w * 0.125f; }
#pragma unroll
    for (int d = 0; d < 64; ++d) o[d] = 0.f;
    float m = -1e30f, l = 0.f; const float cq = cm ? cm[t] : 0.f;
    for (int j = 1; j <= c; ++j) {
        __syncthreads();
        for (int it = 0; it < 16; ++it) { const int rr = it * 4 + (lane >> 4), cc = (lane & 15) * 4; const size_t kr = ((size_t)b * LP + j * 64 + rr) * NPROJ;
            *(float4*)&Ks[rr][cc] = *(const float4*)(proj + kr + kcol + cc); *(float4*)&Vs[rr][cc] = *(const float4*)(proj + kr + vcol + cc); }
        __syncthreads();
        for (int kk = 0; kk < 64; ++kk) { const int kt = j * 64 + kk; if (kt < NLEAD) continue; if (mode == 1 && kt > t) continue;
            float s = 0.f;
#pragma unroll
            for (int d = 0; d < 64; d += 4) { const float4 kv = *(const float4*)&Ks[kk][d]; s += q[d] * kv.x + q[d + 1] * kv.y + q[d + 2] * kv.z + q[d + 3] * kv.w; }
            if (mode == 1) s += cq - cm[kt];
            if (s > m) { const float corr = expf(m - s); l *= corr;
#pragma unroll
                for (int d = 0; d < 64; ++d) o[d] *= corr;
                m = s; }
            const float pp = expf(s - m); l += pp;
#pragma unroll
            for (int d = 0; d < 64; d += 4) { const float4 vv = *(const float4*)&Vs[kk][d]; o[d] += pp * vv.x; o[d + 1] += pp * vv.y; o[d + 2] += pp * vv.z; o[d + 3] += pp * vv.w; }
        }
    }
    const float inv = (l > 0.f && t >= NLEAD) ? 1.f / l : 0.f;
#pragma unroll
    for (int d = 0; d < 64; d += 4) *(float4*)(out + row * old + d) = make_float4(o[d] * inv, o[d + 1] * inv, o[d + 2] * inv, o[d + 3] * inv);
}

__global__ __launch_bounds__(256) void k_diff_combine(const float* __restrict__ tmpA, const float* __restrict__ lamv, const float* __restrict__ subg, float lam_init, float* __restrict__ mixcat) {
    const int w = (blockIdx.x * 256 + threadIdx.x) >> 6, lane = threadIdx.x & 63; if (w >= MP * 4) return;
    const int row = w >> 2, h = w & 3; const int t = row % LP;
    float d01 = lamv[lane] * lamv[64 + lane], d23 = lamv[128 + lane] * lamv[192 + lane];
    const float lam = expf(wave_sum(d01)) - expf(wave_sum(d23)) + lam_init;
    float o0 = 0.f, o1 = 0.f;
    if (t < LL) {
        const float a1lo = tmpA[((size_t)(h * 4 + 0) * MP + row) * 64 + lane], a1hi = tmpA[((size_t)(h * 4 + 1) * MP + row) * 64 + lane];
        const float a2lo = tmpA[((size_t)(h * 4 + 2) * MP + row) * 64 + lane], a2hi = tmpA[((size_t)(h * 4 + 3) * MP + row) * 64 + lane];
        o0 = a1lo - lam * a2lo; o1 = a1hi - lam * a2hi;
    }
    const float ms = wave_sum(o0 * o0 + o1 * o1) * (1.f / 128.f); const float r = rsqrtf(ms + 1e-5f) * (1.f - lam_init);
    mixcat[(size_t)row * DM + h * 128 + lane] = o0 * r * subg[lane]; mixcat[(size_t)row * DM + h * 128 + 64 + lane] = o1 * r * subg[64 + lane];
}

__global__ __launch_bounds__(256) void k_gdn_prep(const float* __restrict__ proj, const float* __restrict__ convw, const float* __restrict__ a_log, const float* __restrict__ dt_bias,
                                                  float* __restrict__ gq, float* __restrict__ gk, float* __restrict__ gv, float* __restrict__ gbeta, float* __restrict__ gg) {
    const int row = blockIdx.x, b = row / LP, t = row % LP, tid = threadIdx.x, h = tid >> 6;
    float val[3];
#pragma unroll
    for (int part = 0; part < 3; ++part) { const int ch = part * 256 + tid; float a = 0.f;
#pragma unroll
        for (int i = 0; i < 4; ++i) { const int tt = t - 3 + i; if (tt >= 0 && tt < LL) a += convw[i * 768 + ch] * proj[((size_t)b * LP + tt) * NPROJ + C_GQKV + ch]; }
        val[part] = a / (1.f + expf(-a)); }
    const float qn = rsqrtf(wave_sum(val[0] * val[0]) + 1e-6f) * 0.125f, kn = rsqrtf(wave_sum(val[1] * val[1]) + 1e-6f);
    gq[(size_t)row * 256 + tid] = val[0] * qn; gk[(size_t)row * 256 + tid] = val[1] * kn; gv[(size_t)row * 256 + tid] = val[2];
    if ((tid & 63) == 0) { const float bl = proj[(size_t)row * NPROJ + C_GB + h], al = proj[(size_t)row * NPROJ + C_GA + h] + dt_bias[h];
        const float sp = fmaxf(al, 0.f) + log1pf(expf(-fabsf(al)));
        gbeta[(size_t)row * 4 + h] = 1.f / (1.f + expf(-bl)); gg[(size_t)row * 4 + h] = -expf(a_log[h]) * sp; }
}
__global__ __launch_bounds__(64) void k_gdn_seq(const float* __restrict__ gq, const float* __restrict__ gk, const float* __restrict__ gv, const float* __restrict__ gbeta, const float* __restrict__ gg,
                                                const float* __restrict__ proj, const float* __restrict__ normg, float* __restrict__ mixcat) {
    __shared__ float Kt[64][64]; __shared__ float Qt[64][64]; __shared__ float Vt[64][64]; __shared__ float bg[64][2];
    const int b = blockIdx.x >> 2, h = blockIdx.x & 3, j = threadIdx.x;
    float S[64];
#pragma unroll
    for (int i = 0; i < 64; ++i) S[i] = 0.f;
    const float ng = normg[j];
    for (int c = 1; c < LL / 64; ++c) {
        __syncthreads();
        for (int it = 0; it < 16; ++it) { const int rr = it * 4 + (j >> 4), cc = (j & 15) * 4; const size_t r = (size_t)b * LP + c * 64 + rr;
            *(float4*)&Kt[rr][cc] = *(const float4*)(gk + r * 256 + h * 64 + cc); *(float4*)&Qt[rr][cc] = *(const float4*)(gq + r * 256 + h * 64 + cc); *(float4*)&Vt[rr][cc] = *(const float4*)(gv + r * 256 + h * 64 + cc); }
        { const size_t r = (size_t)b * LP + c * 64 + j; bg[j][0] = gbeta[r * 4 + h]; bg[j][1] = expf(gg[r * 4 + h]); }
        __syncthreads();
        for (int tt = 0; tt < 64; ++tt) { const size_t r = (size_t)b * LP + c * 64 + tt;
            const float vj = Vt[tt][j];
            const float beta = bg[tt][0], dec = bg[tt][1]; float rr = 0.f;
#pragma unroll
            for (int i = 0; i < 64; i += 4) { const float4 kv = *(const float4*)&Kt[tt][i]; S[i] *= dec; S[i + 1] *= dec; S[i + 2] *= dec; S[i + 3] *= dec;
                rr += S[i] * kv.x + S[i + 1] * kv.y + S[i + 2] * kv.z + S[i + 3] * kv.w; }
            const float coef = beta * (vj - rr); float oj = 0.f;
#pragma unroll
            for (int i = 0; i < 64; i += 4) { const float4 kv = *(const float4*)&Kt[tt][i]; const float4 qv = *(const float4*)&Qt[tt][i];
                S[i] += coef * kv.x; S[i + 1] += coef * kv.y; S[i + 2] += coef * kv.z; S[i + 3] += coef * kv.w;
                oj += S[i] * qv.x + S[i + 1] * qv.y + S[i + 2] * qv.z + S[i + 3] * qv.w; }
            const float ms = wave_sum(oj * oj) * (1.f / 64.f);
            mixcat[r * DM + 768 + h * 64 + j] = oj * rsqrtf(ms + 1e-6f) * ng;
        }
    }
}
__global__ __launch_bounds__(256) void k_gdn_gate(const float* __restrict__ proj, float* __restrict__ mixcat) {
    const int row = blockIdx.x, c = threadIdx.x; const int t = row % LP; if (t < 64 || t >= LL) return;
    const float z = proj[(size_t)row * NPROJ + C_GZ + c]; mixcat[(size_t)row * DM + 768 + c] *= z / (1.f + expf(-z));
}
__global__ __launch_bounds__(256) void k_zero_pad_rows(float* __restrict__ buf) {
    const int w = (blockIdx.x * 256 + threadIdx.x) >> 6, lane = threadIdx.x & 63; if (w >= MP) return; const int t = w % LP; if (t >= 64 && t < LL) return;
    float4* o = (float4*)(buf + (size_t)w * DM);
#pragma unroll
    for (int j = 0; j < 4; ++j) o[lane + 64 * j] = make_float4(0.f, 0.f, 0.f, 0.f);
}

__global__ __launch_bounds__(256) void k_ln1_route(const float* __restrict__ stream, const float* __restrict__ mix, const float* __restrict__ g, const float* __restrict__ bta,
                                                   const float* __restrict__ rw, const float* __restrict__ rb, float* __restrict__ x1, int* __restrict__ topidx, float* __restrict__ gate, int* __restrict__ pos, int* __restrict__ cnt) {
    __shared__ float xs[4][DM];
    const int wv = threadIdx.x >> 6, row = blockIdx.x * 4 + wv, lane = threadIdx.x & 63; if (row >= MP) return; const int t = row % LP;
    float4* o = (float4*)(x1 + (size_t)row * DM);
    if (!row_valid(t)) {
#pragma unroll
        for (int j = 0; j < 4; ++j) o[lane + 64 * j] = make_float4(0.f, 0.f, 0.f, 0.f);
        return; }
    float4 v[4]; float s = 0.f;
#pragma unroll
    for (int j = 0; j < 4; ++j) { const float4 a = ((const float4*)(stream + (size_t)row * DM))[lane + 64 * j], m = ((const float4*)(mix + (size_t)row * DM))[lane + 64 * j];
        v[j] = make_float4(DN_ALPHA * a.x + m.x, DN_ALPHA * a.y + m.y, DN_ALPHA * a.z + m.z, DN_ALPHA * a.w + m.w); s += (v[j].x + v[j].y) + (v[j].z + v[j].w); }
    const float mean = wave_sum(s) * (1.f / DM); float q = 0.f;
#pragma unroll
    for (int j = 0; j < 4; ++j) { v[j].x -= mean; v[j].y -= mean; v[j].z -= mean; v[j].w -= mean; q += (v[j].x * v[j].x + v[j].y * v[j].y) + (v[j].z * v[j].z + v[j].w * v[j].w); }
    const float rstd = rsqrtf(wave_sum(q) * (1.f / DM) + 1e-5f);
#pragma unroll
    for (int j = 0; j < 4; ++j) { const float4 gg = ((const float4*)g)[lane + 64 * j], bb = ((const float4*)bta)[lane + 64 * j];
        const float4 r = make_float4(v[j].x * rstd * gg.x + bb.x, v[j].y * rstd * gg.y + bb.y, v[j].z * rstd * gg.z + bb.z, v[j].w * rstd * gg.w + bb.w);
        o[lane + 64 * j] = r; *(float4*)&xs[wv][(lane + 64 * j) * 4] = r; }
    asm volatile("s_waitcnt lgkmcnt(0)" ::: "memory");
    const int e = lane & 31, half = lane >> 5; float acc = 0.f;
    for (int k = half * 512; k < half * 512 + 512; ++k) acc += xs[wv][k] * rw[(size_t)k * NE + e];
    acc += __shfl_xor(acc, 32); acc += rb[e];
    float val = acc; float tv[4]; int ti[4];
#pragma unroll
    for (int k = 0; k < 4; ++k) { const float mx = wave_max(val); const unsigned long long bal = __ballot(val == mx); const int win = (int)(__ffsll((long long)(bal & 0xffffffffull)) - 1);
        tv[k] = mx; ti[k] = win; if (e == win) val = -INFINITY; }
    const float e0 = 1.f, e1 = expf(tv[1] - tv[0]), e2 = expf(tv[2] - tv[0]), e3 = expf(tv[3] - tv[0]); const float inv = 1.f / (e0 + e1 + e2 + e3);
    if (lane < 4) { const float gt = (lane == 0 ? e0 : lane == 1 ? e1 : lane == 2 ? e2 : e3) * inv; const int ex = lane == 0 ? ti[0] : lane == 1 ? ti[1] : lane == 2 ? ti[2] : ti[3];
        topidx[(size_t)row * 4 + lane] = ex; gate[(size_t)row * 4 + lane] = gt; pos[(size_t)row * 4 + lane] = atomicAdd(&cnt[ex], 1); }
}
__global__ void k_offsets(const int* __restrict__ cnt, int* __restrict__ offs) { if (threadIdx.x == 0) { int a = 0; for (int e = 0; e < NE; ++e) { offs[e] = a; a += cnt[e]; } offs[NE] = a; } }
__global__ void k_fill_slots(const int* __restrict__ topidx, const int* __restrict__ pos, const int* __restrict__ offs, int* __restrict__ slot_tok, int* __restrict__ tokslot) {
    const int i = blockIdx.x * 256 + threadIdx.x; if (i >= MP * 4) return; const int row = i >> 2; if (!row_valid(row % LP)) return;
    const int s = offs[topidx[i]] + pos[i]; slot_tok[s] = row; tokslot[i] = s;
}
__global__ __launch_bounds__(256) void k_combine_ln2(const float* __restrict__ x1, const float* __restrict__ y, const int* __restrict__ tokslot, const float* __restrict__ gate,
                                                     const float* __restrict__ g, const float* __restrict__ bta, float* __restrict__ stream, float* __restrict__ out) {
    const int row = (blockIdx.x * 256 + threadIdx.x) >> 6, lane = threadIdx.x & 63; if (row >= MP) return; const int t = row % LP, b = row / LP;
    float4* o = (float4*)(stream + (size_t)row * DM);
    if (!row_valid(t)) {
#pragma unroll
        for (int j = 0; j < 4; ++j) o[lane + 64 * j] = make_float4(0.f, 0.f, 0.f, 0.f);
        return; }
    float4 v[4];
#pragma unroll
    for (int j = 0; j < 4; ++j) { const float4 a = ((const float4*)(x1 + (size_t)row * DM))[lane + 64 * j]; v[j] = make_float4(DN_ALPHA * a.x, DN_ALPHA * a.y, DN_ALPHA * a.z, DN_ALPHA * a.w); }
    for (int k = 0; k < 4; ++k) { const int s = tokslot[(size_t)row * 4 + k]; const float gt = gate[(size_t)row * 4 + k];
#pragma unroll
        for (int j = 0; j < 4; ++j) { const float4 a = ((const float4*)(y + (size_t)s * DM))[lane + 64 * j]; v[j].x += gt * a.x; v[j].y += gt * a.y; v[j].z += gt * a.z; v[j].w += gt * a.w; } }
    float s = 0.f;
#pragma unroll
    for (int j = 0; j < 4; ++j) s += (v[j].x + v[j].y) + (v[j].z + v[j].w);
    const float mean = wave_sum(s) * (1.f / DM); float q = 0.f;
#pragma unroll
    for (int j = 0; j < 4; ++j) { v[j].x -= mean; v[j].y -= mean; v[j].z -= mean; v[j].w -= mean; q += (v[j].x * v[j].x + v[j].y * v[j].y) + (v[j].z * v[j].z + v[j].w * v[j].w); }
    const float rstd = rsqrtf(wave_sum(q) * (1.f / DM) + 1e-5f);
    float4* oo = (out && t >= NLEAD + NMETA) ? (float4*)(out + ((size_t)b * SEQ + (t - NLEAD - NMETA)) * DM) : nullptr;
#pragma unroll
    for (int j = 0; j < 4; ++j) { const float4 gg = ((const float4*)g)[lane + 64 * j], bb = ((const float4*)bta)[lane + 64 * j];
        const float4 r = make_float4(v[j].x * rstd * gg.x + bb.x, v[j].y * rstd * gg.y + bb.y, v[j].z * rstd * gg.z + bb.z, v[j].w * rstd * gg.w + bb.w);
        o[lane + 64 * j] = r; if (oo) oo[lane + 64 * j] = r; }
}

#define LAS __attribute__((address_space(3)))
#define GAS __attribute__((address_space(1)))
typedef unsigned short bf16_t;
typedef short bf16x8 __attribute__((ext_vector_type(8)));
typedef float f32x4 __attribute__((ext_vector_type(4)));
typedef float f32x2 __attribute__((ext_vector_type(2)));
typedef unsigned u32x4 __attribute__((ext_vector_type(4)));
typedef unsigned u32x2 __attribute__((ext_vector_type(2)));

constexpr int NPJ = 3328;
constexpr int P_DQ = 0, P_DK = 512, P_DV = 1024, P_FQ = 1536, P_FK = 1792, P_FV = 2048, P_GQKV = 2304, P_GZ = 3072;
constexpr float QK_C2 = 0.125f * 1.4426950408889634f;
constexpr int NWAVES = 8, NTHR = 512;
constexpr int PMAX = 320;
constexpr int FILL_ROW = NLEAD;

__device__ __forceinline__ unsigned cvt_pk_bf16(float lo, float hi) { unsigned r; asm volatile("v_cvt_pk_bf16_f32 %0, %1, %2" : "=v"(r) : "v"(lo), "v"(hi)); return r; }
typedef __bf16 bf16x2_nat __attribute__((ext_vector_type(2)));
__device__ __forceinline__ unsigned cvt_pk_bf16_m(float lo, float hi) { const f32x2 v = {lo, hi}; const bf16x2_nat b = __builtin_convertvector(v, bf16x2_nat); return __builtin_bit_cast(unsigned, b); }
__device__ __forceinline__ float bf2f(unsigned short h) { return __uint_as_float((unsigned)h << 16); }
__device__ __forceinline__ float bflo(unsigned w) { return __uint_as_float(w << 16); }
__device__ __forceinline__ float bfhi(unsigned w) { return __uint_as_float(w & 0xffff0000u); }

namespace pg8 {
constexpr int BM = 256, BK = 64, HALF = 128, HTB = HALF * BK * 2, STAGE_BYTES = 8 * HTB;
__host__ __device__ __forceinline__ int lds_byte(int r, int c) { const int st = (r >> 4) * 2 + (c >> 5), rr = r & 15, cc = c & 31, ob = rr * 64 + cc * 2; return st * 1024 + (ob ^ (((ob >> 9) & 1) << 5)); }
__host__ __device__ __forceinline__ void stage_rc(int b, int& R, int& C) { const int st = b / 1024, sb = b % 1024, swz = sb ^ (((sb >> 9) & 1) << 5); R = (st >> 1) * 16 + swz / 64; C = (st & 1) * 32 + (swz % 64) / 2; }
__host__ __device__ __forceinline__ int perm32(int rho) { const int n = rho >> 4, i = rho & 15; return 8 * (i >> 2) + 4 * n + (i & 3); }

struct Unit { int pm, pn, e; };
struct Gemm { const bf16_t* A; const bf16_t* Bt; int K; size_t bstride_e; };

struct DenseOrder {
    int nM, nN, nwg, G, c;
    __device__ void init(int nM_, int nN_, int G_, int c_) { nM = nM_; nN = nN_; nwg = nM * nN; G = G_; c = c_; }
    __device__ bool next(int i, Unit& u) const {
        const long L = (long)i * G + c; if (L >= nwg) return false;
        int wgid = (int)L; { const int q = nwg / 8, r = nwg % 8, xcd = wgid % 8, off = wgid / 8; wgid = (xcd < r ? xcd * (q + 1) : r * (q + 1) + (xcd - r) * q) + off; }
        const int nig = 8 * nN, gid = wgid / nig, fm = gid * 8, gsz = (nM - fm) < 8 ? (nM - fm) : 8;
        u.pm = fm + ((wgid % nig) % gsz); u.pn = (wgid % nig) / gsz; u.e = 0; return true;
    }
    __device__ void rows(const Unit&, const int*& list, int& nvalid) const { list = nullptr; nvalid = 0; }
};
struct ExpertOrder {
    const volatile LAS int* tab;
    const int* cnt; const int* etok; int nN, G, c;
    __device__ bool next(int i, Unit& u) const {
        const int L = i * G + c; const int P = __builtin_amdgcn_readfirstlane(tab[0]); if (L >= P * nN) return false;
        u.pm = L / nN; u.pn = L % nN; u.e = __builtin_amdgcn_readfirstlane(tab[40 + u.pm]); return true;
    }
    __device__ void rows(const Unit& u, const int*& list, int& nvalid) const {
        const int lt = u.pm - __builtin_amdgcn_readfirstlane(tab[1 + u.e]); list = etok + (size_t)u.e * MP + lt * 256; int nv = __builtin_amdgcn_readfirstlane(cnt[u.e * 32]) - lt * 256; nvalid = nv > 256 ? 256 : nv;
    }
};

struct EpiStoreBf16 {
    static constexpr bool PERM = true;
    bf16_t* O; int ldc; const float* bias; int bias_stride;
    __device__ __forceinline__ void operator()(const f32x4 (&acc)[2][2][4][2], const Unit& u, int wr, int wc, int fr, int fq) const {
        const int row0 = u.pm * BM + wr * 64 + fr, col0 = u.pn * BM + wc * 32 + 8 * fq;
        f32x4 bv[2][2];
#pragma unroll
        for (int bj = 0; bj < 2; ++bj)
#pragma unroll
            for (int n = 0; n < 2; ++n) bv[bj][n] = bias ? *(const f32x4*)(bias + (size_t)u.e * bias_stride + col0 + bj * HALF + 4 * n) : (f32x4){0.f, 0.f, 0.f, 0.f};
#pragma unroll
        for (int ai = 0; ai < 2; ++ai)
#pragma unroll
            for (int m = 0; m < 4; ++m) { bf16_t* rowp = O + (size_t)(row0 + ai * HALF + m * 16) * ldc + col0;
#pragma unroll
                for (int bj = 0; bj < 2; ++bj) { const f32x4 v0 = acc[ai][bj][m][0] + bv[bj][0], v1 = acc[ai][bj][m][1] + bv[bj][1];
                    u32x4 w; w.x = cvt_pk_bf16(v0[0], v0[1]); w.y = cvt_pk_bf16(v0[2], v0[3]); w.z = cvt_pk_bf16(v1[0], v1[1]); w.w = cvt_pk_bf16(v1[2], v1[3]);
                    *(u32x4*)(rowp + bj * HALF) = w; } }
    }
};
struct EpiSwiglu {
    static constexpr bool PERM = true;
    bf16_t* O; const float* bias;
    __device__ __forceinline__ static float sw(float g, float l) { g = fminf(g, 7.f); l = fminf(fmaxf(l, -7.f), 7.f); const float sg = __builtin_amdgcn_rcpf(1.f + __builtin_amdgcn_exp2f(-1.702f * 1.4426950408889634f * g)); return g * sg * (l + 1.f); }
    __device__ __forceinline__ void operator()(const f32x4 (&acc)[2][2][4][2], const Unit& u, int wr, int wc, int fr, int fq) const {
        const int row0 = u.pm * BM + wr * 64 + fr, c0 = u.pn * HALF + wc * 32 + 8 * fq; const float* bs = bias + (size_t)u.e * 2048;
        f32x4 bg[2], bl[2];
#pragma unroll
        for (int n = 0; n < 2; ++n) { bg[n] = *(const f32x4*)(bs + c0 + 4 * n); bl[n] = *(const f32x4*)(bs + 1024 + c0 + 4 * n); }
#pragma unroll
        for (int ai = 0; ai < 2; ++ai)
#pragma unroll
            for (int m = 0; m < 4; ++m) { float o[8];
#pragma unroll
                for (int n = 0; n < 2; ++n) { const f32x4 g = acc[ai][0][m][n] + bg[n], l = acc[ai][1][m][n] + bl[n];
#pragma unroll
                    for (int i = 0; i < 4; ++i) o[4 * n + i] = sw(g[i], l[i]); }
                u32x4 w; w.x = cvt_pk_bf16(o[0], o[1]); w.y = cvt_pk_bf16(o[2], o[3]); w.z = cvt_pk_bf16(o[4], o[5]); w.w = cvt_pk_bf16(o[6], o[7]);
                *(u32x4*)(O + (size_t)(row0 + ai * HALF + m * 16) * 1024 + c0) = w; }
    }
};
struct EpiResid {
    static constexpr bool PERM = true;
    bf16_t* S; const bf16_t* R; int ldc; float alpha;
    __device__ __forceinline__ void operator()(const f32x4 (&acc)[2][2][4][2], const Unit& u, int wr, int wc, int fr, int fq) const {
        const int row0 = u.pm * BM + wr * 64 + fr, col0 = u.pn * BM + wc * 32 + 8 * fq;
#pragma unroll
        for (int ai = 0; ai < 2; ++ai)
#pragma unroll
            for (int m = 0; m < 4; ++m) { const size_t ro = (size_t)(row0 + ai * HALF + m * 16) * ldc + col0;
#pragma unroll
                for (int bj = 0; bj < 2; ++bj) { const u32x4 r = *(const u32x4*)(R + ro + bj * HALF);
                    const f32x4 x0 = {bflo(r.x), bfhi(r.x), bflo(r.y), bfhi(r.y)}, x1 = {bflo(r.z), bfhi(r.z), bflo(r.w), bfhi(r.w)};
                    const f32x4 v0 = x0 * alpha + acc[ai][bj][m][0], v1 = x1 * alpha + acc[ai][bj][m][1];
                    u32x4 w; w.x = cvt_pk_bf16(v0[0], v0[1]); w.y = cvt_pk_bf16(v0[2], v0[3]); w.z = cvt_pk_bf16(v1[0], v1[1]); w.w = cvt_pk_bf16(v1[2], v1[3]);
                    *(u32x4*)(S + ro + bj * HALF) = w; } }
    }
};

template <class Epi, class Sched, bool GATHER>
__device__ __forceinline__ void gemm_phase(LAS unsigned char* lds, const Gemm g, const Sched& S, const Epi& E, const int tid) {
    const int wid = __builtin_amdgcn_readfirstlane(tid >> 6), lane = tid & 63, wr = wid >> 2, wc = wid & 3, fr = lane & 15, fq = lane >> 4;
    const int K = g.K, nt = K / BK;
    int sR[2], sC[2]; unsigned voffB[2];
#pragma unroll
    for (int i = 0; i < 2; ++i) { stage_rc(tid * 16 + i * 8192, sR[i], sC[i]); const int Rb = Epi::PERM ? ((sR[i] & ~31) + perm32(sR[i] & 31)) : sR[i]; voffB[i] = (unsigned)(Rb * K + sC[i]) * 2u; }
    const size_t kstep = (size_t)(BK * 2);
    const size_t hstep = (size_t)HALF * K * 2;
    const size_t tstep = 2 * hstep;
    const unsigned ldsw = (unsigned)wid * 1024u;
    const int aoff = lds_byte(wr * 64 + fr, fq * 8), boff = lds_byte(wc * 32 + fr, fq * 8);
#define PG8_SA(b, h) (((b) * 2 + (h)) * HTB)
#define PG8_SB(b, h) ((4 + (b) * 2 + (h)) * HTB)
#define PG8_STAGE(bufoff, gbase, voff) do { _Pragma("unroll") for (int _i = 0; _i < 2; ++_i) \
        __builtin_amdgcn_global_load_lds((const unsigned*)((const char*)(gbase) + (voff)[_i]), (LAS unsigned*)(lds + (bufoff) + ldsw + _i * 8192), 16, 0, 0); } while (0)
#define PG8_LDA(dst, b, h) do { _Pragma("unroll") for (int m = 0; m < 4; ++m) _Pragma("unroll") for (int k = 0; k < 2; ++k) dst[m][k] = *(const LAS bf16x8*)(lds + PG8_SA(b, h) + aoff + m * 2048 + k * 1024); } while (0)
#define PG8_LDB(dst, b, h) do { _Pragma("unroll") for (int n = 0; n < 2; ++n) _Pragma("unroll") for (int k = 0; k < 2; ++k) dst[n][k] = *(const LAS bf16x8*)(lds + PG8_SB(b, h) + boff + n * 2048 + k * 1024); } while (0)
#define PG8_MMA(ai, bj, At, Bt) do { __builtin_amdgcn_s_setprio(1); _Pragma("unroll") for (int m = 0; m < 4; ++m) _Pragma("unroll") for (int n = 0; n < 2; ++n) _Pragma("unroll") for (int k = 0; k < 2; ++k) \
        acc[ai][bj][m][n] = __builtin_amdgcn_mfma_f32_16x16x32_bf16(Bt[n][k], At[m][k], acc[ai][bj][m][n], 0, 0, 0); __builtin_amdgcn_s_setprio(0); } while (0)
#define PG8_WAIT_V(n) asm volatile("s_waitcnt vmcnt(" #n ")" ::: "memory")
#define PG8_WAIT_L(n) asm volatile("s_waitcnt lgkmcnt(" #n ")" ::: "memory")
#define PG8_BAR __builtin_amdgcn_s_barrier()
#define PG8_SCHED __builtin_amdgcn_sched_barrier(0)
#define PG8_AOFFS(dst, u_) do { if (GATHER) { const int* _l; int _nv; S.rows(u_, _l, _nv); _Pragma("unroll") for (int _h = 0; _h < 2; ++_h) _Pragma("unroll") for (int _i = 0; _i < 2; ++_i) { \
            const int _r = sR[_i] + 128 * _h; const int _t = _r < _nv ? _l[_r] : FILL_ROW; dst[_h][_i] = (unsigned)(_t * K + sC[_i]) * 2u; } } \
        else { _Pragma("unroll") for (int _h = 0; _h < 2; ++_h) _Pragma("unroll") for (int _i = 0; _i < 2; ++_i) dst[_h][_i] = (unsigned)((sR[_i] + 128 * _h) * K + sC[_i]) * 2u; } } while (0)
#define PG8_ABASE(u_) (GATHER ? (const char*)g.A : (const char*)g.A + (size_t)(u_).pm * tstep)
#define PG8_BBASE(u_) ((const char*)g.Bt + ((size_t)(u_).e * g.bstride_e) * 2 + (size_t)(u_).pn * tstep)
    Unit cur, nxt; int ui = 0;
    if (!S.next(0, cur)) return;
    f32x4 acc[2][2][4][2];
#pragma unroll
    for (int a = 0; a < 2; ++a)
#pragma unroll
        for (int b = 0; b < 2; ++b)
#pragma unroll
            for (int m = 0; m < 4; ++m)
#pragma unroll
                for (int n = 0; n < 2; ++n) acc[a][b][m][n] = (f32x4){0.f, 0.f, 0.f, 0.f};
    bf16x8 At[4][2], B0[2][2], B1[2][2];
    unsigned cva[2][2], nva[2][2];
    PG8_AOFFS(cva, cur);
    const char* cA = PG8_ABASE(cur); const char* cB = PG8_BBASE(cur);
    PG8_STAGE(PG8_SB(0, 0), cB, voffB); PG8_STAGE(PG8_SB(0, 1), cB + hstep, voffB); PG8_STAGE(PG8_SA(0, 0), cA, cva[0]); PG8_STAGE(PG8_SA(0, 1), cA, cva[1]);
    if (wr == 1) PG8_BAR;
    PG8_WAIT_V(2); PG8_BAR;
    PG8_STAGE(PG8_SB(1, 0), cB + kstep, voffB); PG8_STAGE(PG8_SA(1, 0), cA + kstep, cva[0]); PG8_STAGE(PG8_SB(1, 1), cB + hstep + kstep, voffB);
    PG8_WAIT_V(6); PG8_BAR;
    for (;;) {
        const bool has_next = S.next(ui + 1, nxt);
        if (GATHER) { if (has_next) { PG8_AOFFS(nva, nxt); } else {
#pragma unroll
            for (int h = 0; h < 2; ++h)
#pragma unroll
                for (int i = 0; i < 2; ++i) nva[h][i] = cva[h][i]; } }
        const char* nA = has_next ? PG8_ABASE(nxt) : cA; const char* nB = has_next ? PG8_BBASE(nxt) : cB;
        for (int t = 0; t < nt; t += 2) {
            const bool last = (t == nt - 2);
            const char* a1 = cA + (size_t)(t + 1) * kstep;
            const char* a2 = last ? nA : cA + (size_t)(t + 2) * kstep; const char* b2 = last ? nB : cB + (size_t)(t + 2) * kstep;
            const char* a3 = a2 + kstep; const char* b3 = b2 + kstep;
            unsigned va[2][2];
#pragma unroll
            for (int h = 0; h < 2; ++h)
#pragma unroll
                for (int i = 0; i < 2; ++i) va[h][i] = (GATHER && last) ? nva[h][i] : cva[h][i];
            PG8_LDB(B0, 0, 0); PG8_LDB(B1, 0, 1); PG8_SCHED; PG8_LDA(At, 0, 0); PG8_STAGE(PG8_SA(1, 1), a1, cva[1]);
            PG8_WAIT_V(8); PG8_WAIT_L(0); PG8_BAR; PG8_MMA(0, 0, At, B0); PG8_MMA(0, 1, At, B1); PG8_BAR; PG8_SCHED;
            PG8_LDA(At, 0, 1); PG8_STAGE(PG8_SB(0, 0), b2, voffB); PG8_STAGE(PG8_SB(0, 1), b2 + hstep, voffB); PG8_STAGE(PG8_SA(0, 0), a2, va[0]);
            PG8_WAIT_V(8); PG8_WAIT_L(0); PG8_BAR; PG8_MMA(1, 0, At, B0); PG8_MMA(1, 1, At, B1); PG8_BAR; PG8_SCHED;
            PG8_LDB(B0, 1, 0); PG8_LDB(B1, 1, 1); PG8_SCHED; PG8_LDA(At, 1, 0); PG8_STAGE(PG8_SA(0, 1), a2, va[1]);
            PG8_WAIT_V(8); PG8_WAIT_L(0); PG8_BAR; PG8_MMA(0, 0, At, B0); PG8_MMA(0, 1, At, B1); PG8_BAR; PG8_SCHED;
            PG8_LDA(At, 1, 1); PG8_STAGE(PG8_SB(1, 0), b3, voffB); PG8_STAGE(PG8_SB(1, 1), b3 + hstep, voffB); PG8_STAGE(PG8_SA(1, 0), a3, va[0]);
            PG8_WAIT_V(8); PG8_WAIT_L(0); PG8_BAR; PG8_MMA(1, 0, At, B0); PG8_MMA(1, 1, At, B1); PG8_BAR; PG8_SCHED;
        }
        if (wr == 0) PG8_BAR;
        E(acc, cur, wr, wc, fr, fq);
        if (!has_next) break;
#pragma unroll
        for (int a = 0; a < 2; ++a)
#pragma unroll
            for (int b = 0; b < 2; ++b)
#pragma unroll
                for (int m = 0; m < 4; ++m)
#pragma unroll
                    for (int n = 0; n < 2; ++n) acc[a][b][m][n] = (f32x4){0.f, 0.f, 0.f, 0.f};
        cur = nxt; cA = nA; cB = nB; ++ui;
        if (GATHER) {
#pragma unroll
        for (int h = 0; h < 2; ++h)
#pragma unroll
            for (int i = 0; i < 2; ++i) cva[h][i] = nva[h][i]; }
        if (wr == 1) PG8_BAR;
    }
    PG8_WAIT_V(0);
    PG8_BAR;
#undef PG8_SA
#undef PG8_SB
#undef PG8_STAGE
#undef PG8_LDA
#undef PG8_LDB
#undef PG8_MMA
#undef PG8_WAIT_V
#undef PG8_WAIT_L
#undef PG8_BAR
#undef PG8_SCHED
#undef PG8_AOFFS
#undef PG8_ABASE
#undef PG8_BBASE
}
}
constexpr int LDS_RING = 131072;
constexpr int LDS_TAB = LDS_RING;
constexpr int LDS_MISC = LDS_RING + 2048;
constexpr int LDS_BYTES = 147456;

struct MKP {
    const float *x, *meta, *ln_in_g, *ln_in_b, *w_in, *diff_lambda, *diff_subln_g, *fox_forget_b, *gdn_conv_w, *gdn_a_log, *gdn_dt_bias, *gdn_norm_g, *w_out, *ln1_g, *ln1_b,
        *router_w, *router_b, *w1, *b1, *w2, *b2, *ln2_g, *ln2_b;
    float* out;
    bf16_t *Win_t, *Wout_t, *W1_t, *W2_t;
    float* stream;
    bf16_t* actb;
    bf16_t* proj;
    float* gates;
    bf16_t* mixcat;
    bf16_t* act;
    bf16_t* ybuf;
    int* cnt;
    int* etok;
    int* tok_e; int* tok_pos; float* tok_gate;
    unsigned* ctl;
    bf16_t* tmpO;
    unsigned long long* Gk;
    float* wgc;
    float* rwT;
    float* Gf;
    float *fox_loc, *fox_tot;
    unsigned char* gch; float* gcd;
    float *gq, *gk, *gv, *gsc, *gdn_o;
    int ph_lo, ph_hi;
};

#define LDS_WAIT() asm volatile("s_waitcnt lgkmcnt(0)" ::: "memory")
#define VM_WAIT() asm volatile("s_waitcnt vmcnt(0)" ::: "memory")

typedef GAS unsigned gu32;
#define XB_TMO      128
#define XB_XCNT(j)  (256  + 64 * (j))
#define XB_XSUB(j)  (1280 + 64 * (j))
#define XB_XGEN(j)  (2304 + 64 * (j))
#define XB_TOP      3328
#define XB_TOPGEN   3392
#define XCD_BAR_WORDS 3456
#define XB_SPIN_CAP (1u << 18)

__device__ __forceinline__ unsigned xb_ld(unsigned* p)              { return __hip_atomic_load(p, __ATOMIC_RELAXED, __HIP_MEMORY_SCOPE_AGENT); }
__device__ __forceinline__ unsigned xb_add(unsigned* p, unsigned v) { return __hip_atomic_fetch_add(p, v, __ATOMIC_RELAXED, __HIP_MEMORY_SCOPE_AGENT); }
__device__ __forceinline__ unsigned xb_xcc_id() { return (unsigned)__builtin_amdgcn_s_getreg((3 << 11) | 20) & 0xFu; }
#define XB_SPIN(cond, bar) do { unsigned _sp = 0; while (cond) { __builtin_amdgcn_s_sleep(1); \
    if ((++_sp & 255u) == 0u) { if (xb_ld(&(bar)[XB_TMO])) break; if (_sp > XB_SPIN_CAP) { atomicAdd(&(bar)[XB_TMO], 1u); break; } } } } while (0)

struct XcdBarrier {
    unsigned* bar; unsigned x;
    volatile LAS unsigned* st;
};

__device__ __forceinline__ XcdBarrier xcd_barrier_post(unsigned* bar, volatile LAS unsigned* st) {
    XcdBarrier b; b.bar = bar; b.x = xb_xcc_id(); b.st = st;
    if (threadIdx.x == 0) (void)xb_add(&bar[XB_XCNT(b.x)], 1u);
    return b;
}
__device__ __forceinline__ void xcd_barrier_complete(unsigned* bar, unsigned x, unsigned& nloc, unsigned& nx) {
    const unsigned G = gridDim.x * gridDim.y * gridDim.z;
    unsigned sum, cnt, mine, sp = 0u;
    for (;;) {
        sum = 0u; cnt = 0u; mine = 0u;
#pragma unroll
        for (unsigned j = 0; j < 16; ++j) { const unsigned c = xb_ld(&bar[XB_XCNT(j)]); sum += c; cnt += (c > 0u) ? 1u : 0u; mine = (j == x) ? c : mine; }
        if (sum == G) break;
        __builtin_amdgcn_s_sleep(1);
        if ((++sp & 255u) == 0u) { if (xb_ld(&bar[XB_TMO])) break; if (sp > XB_SPIN_CAP) { atomicAdd(&bar[XB_TMO], 1u); break; } }
    }
    nloc = mine > 0u ? mine : 1u; nx = cnt > 0u ? cnt : 1u;
}

__device__ __forceinline__ void xcd_barrier(const XcdBarrier& b) {
    asm volatile("s_waitcnt vmcnt(0)" ::: "memory");
    __syncthreads();
    if (threadIdx.x == 0) {
        unsigned* bar = b.bar;
        __builtin_amdgcn_s_waitcnt(0);
        unsigned nloc = b.st[0], nx = b.st[1];
        if (nloc == 0u) { xcd_barrier_complete(bar, b.x, nloc, nx); b.st[0] = nloc; b.st[1] = nx; }
        const unsigned old = xb_add(&bar[XB_XSUB(b.x)], 1u);
        const unsigned gen = old / nloc;
        if (old + 1u == (gen + 1u) * nloc) {
            __builtin_amdgcn_fence(__ATOMIC_RELEASE, "agent");
            asm volatile("s_waitcnt vmcnt(0)" ::: "memory");
            const unsigned og = xb_add(&bar[XB_TOP], 1u);
            const unsigned tg = og / nx;
            if (og + 1u == (tg + 1u) * nx) xb_add(&bar[XB_TOPGEN], 1u);
            else XB_SPIN(xb_ld(&bar[XB_TOPGEN]) == tg, bar);
            __builtin_amdgcn_fence(__ATOMIC_ACQUIRE, "agent");
            xb_add(&bar[XB_XGEN(b.x)], 1u);
            asm volatile("s_waitcnt vmcnt(0)" ::: "memory");
        } else {
            XB_SPIN(xb_ld(&bar[XB_XGEN(b.x)]) == gen, bar);
            __builtin_amdgcn_fence(__ATOMIC_ACQUIRE, "agent");
            asm volatile("s_waitcnt vmcnt(0)" ::: "memory");
        }
    }
    __syncthreads();
}


struct CvItem { const float* src; bf16_t* dst; int ldw, K; float scale; };
__device__ __forceinline__ void cv_load(const CvItem& it, f32x4 (&v)[16], int lane) {
    const float* s = it.src + (size_t)(lane >> 4) * it.ldw + (lane & 15) * 4;
#pragma unroll
    for (int i = 0; i < 16; ++i) v[i] = __builtin_nontemporal_load((const f32x4*)(s + (size_t)(4 * i) * it.ldw));
}
__device__ __forceinline__ void cv_store(const CvItem& it, const f32x4 (&v)[16], LAS float* scr, int lane) {
#pragma unroll
    for (int i = 0; i < 16; ++i) { const int kk = 4 * i + (lane >> 4); LAS float* d = scr + ((lane & 15) * 4) * 65 + kk;
        d[0] = v[i][0] * it.scale; d[65] = v[i][1] * it.scale; d[130] = v[i][2] * it.scale; d[195] = v[i][3] * it.scale; }
    LDS_WAIT();
    const int c = lane & 7;
#pragma unroll
    for (int j = 0; j < 8; ++j) { const int n = (lane >> 3) + 8 * j; const LAS float* s = scr + n * 65 + 8 * c;
        u32x4 o; o.x = cvt_pk_bf16(s[0], s[1]); o.y = cvt_pk_bf16(s[2], s[3]); o.z = cvt_pk_bf16(s[4], s[5]); o.w = cvt_pk_bf16(s[6], s[7]);
        *(u32x4*)(it.dst + (size_t)n * it.K + 8 * c) = o; }
    LDS_WAIT();
}
__device__ __forceinline__ CvItem cv_w1_item(const MKP& p, int layer, int r) {
    const int le = layer * NE + r / 512, q = r % 512, kb = q / 32, nb = q % 32, n0 = nb * 64;
    const int tile = n0 >> 8, w = n0 & 255; const int src = w < 128 ? tile * 128 + w : 1024 + tile * 128 + (w - 128);
    CvItem it; it.src = p.w1 + (size_t)le * DM * 2 * DE + (size_t)(kb * 64) * (2 * DE) + src; it.ldw = 2 * DE; it.dst = p.W1_t + (size_t)le * 2 * DE * DM + (size_t)n0 * DM + kb * 64; it.K = DM; it.scale = 1.f; return it;
}
constexpr int W1_Q = 3;
constexpr int W1_DEFER_A = (256 - 77) * NWAVES * W1_Q, W1_DEFER_B = (256 - 4) * NWAVES * W1_Q, W1_DEFER = W1_DEFER_A + W1_DEFER_B;
static_assert(W1_DEFER <= NE * 512, "deferred W1 blocks");
__device__ __forceinline__ void convert_w1_deferred(const MKP& p, LAS unsigned char* lds, int layer, int first, int wave, int lane) {
    LAS float* scr = (LAS float*)(lds + wave * 16640);
    f32x4 cur[16], nxt[16]; CvItem ci = cv_w1_item(p, layer, first); cv_load(ci, cur, lane);
    for (int i = 0; i < W1_Q; ++i) { CvItem ni = ci; if (i + 1 < W1_Q) { ni = cv_w1_item(p, layer, first + i + 1); cv_load(ni, nxt, lane); }
        cv_store(ci, cur, scr, lane); ci = ni;
#pragma unroll
        for (int k = 0; k < 16; ++k) cur[k] = nxt[k]; }
}
__device__ __forceinline__ CvItem cv_w2_item(const MKP& p, int r) {
    const int le = r / 256, q = r % 256, kb = q / 16, nb = q % 16; CvItem c;
    c.src = p.w2 + (size_t)le * DE * DM + (size_t)(kb * 64) * DM + nb * 64; c.ldw = DM; c.dst = p.W2_t + (size_t)le * DM * DE + (size_t)(nb * 64) * DE + kb * 64; c.K = DE; c.scale = 1.f; return c;
}
constexpr int W2_DEFER = 8192, W2_L1 = 32 * 256;
__device__ __forceinline__ void convert_w2_blocks(const MKP& p, LAS unsigned char* lds, int first, int step, int n, int wave, int lane) {
    LAS float* scr = (LAS float*)(lds + wave * 16640);
    f32x4 cur[16], nxt[16]; int r = first; if (r >= W2_DEFER || n <= 0) return;
    CvItem ci = cv_w2_item(p, W2_L1 + r); cv_load(ci, cur, lane);
    for (int i = 0; i < n; ++i) { CvItem ni = ci; const int rn = r + step; const bool more = i + 1 < n && rn < W2_DEFER;
        if (more) { ni = cv_w2_item(p, W2_L1 + rn); cv_load(ni, nxt, lane); }
        cv_store(ci, cur, scr, lane); if (!more) break; ci = ni; r = rn;
#pragma unroll
        for (int k = 0; k < 16; ++k) cur[k] = nxt[k]; }
}
__device__ __forceinline__ int moe_last_round_units(int nunits, int G) { return nunits - ((nunits + G - 1) / G - 1) * G; }
__device__ __forceinline__ CvItem cv_p0_item(const MKP& p, int it) {
    constexpr int I_IN = 16 * (NPJ / 64), I_OUT = 16 * 16, I_W1L = NE * 512 - W1_DEFER, I_W2 = 16 * 16;
    constexpr int T_IN = 2 * I_IN, T_OUT = 2 * I_OUT, T_W1 = 2 * I_W1L;
    int r = it; CvItem c;
    if (r < T_IN) { const int l = r / I_IN, q = r % I_IN, kb = q / (NPJ / 64), nb = q % (NPJ / 64), n0 = nb * 64;
        const int src = n0 < 2304 ? n0 : (n0 < 3072 ? n0 + 4 : n0 + 12);
        c.src = p.w_in + (size_t)l * DM * NPROJ + (size_t)(kb * 64) * NPROJ + src; c.ldw = NPROJ; c.dst = p.Win_t + (size_t)l * NPJ * DM + (size_t)n0 * DM + kb * 64; c.K = DM; c.scale = (n0 < 512 || (n0 >= P_FQ && n0 < P_FK)) ? QK_C2 : 1.f; return c; }
    r -= T_IN;
    if (r < T_OUT) { const int l = r / I_OUT, q = r % I_OUT, kb = q / 16, nb = q % 16;
        c.src = p.w_out + (size_t)l * DM * DM + (size_t)(kb * 64) * DM + nb * 64; c.ldw = DM; c.dst = p.Wout_t + (size_t)l * DM * DM + (size_t)(nb * 64) * DM + kb * 64; c.K = DM; c.scale = 1.f; return c; }
    r -= T_OUT;
    if (r < T_W1) return cv_w1_item(p, r / I_W1L, W1_DEFER + r % I_W1L);
    r -= T_W1;
    return cv_w2_item(p, r < W2_L1 ? r : r + W2_DEFER);
}
__device__ __forceinline__ void phase_convert_weights(const MKP& p, LAS unsigned char* lds, int gw, int ngw, int wave, int lane) {
    LAS float* scr = (LAS float*)(lds + wave * 16640);
    constexpr int NIT = 2 * 16 * (NPJ / 64) + 2 * 256 + 2 * (NE * 512 - W1_DEFER) + 64 * 256 - W2_DEFER;
    int it = gw; if (it >= NIT) return;
    f32x4 cur[16], nxt[16]; CvItem ci = cv_p0_item(p, it); cv_load(ci, cur, lane);
    for (; it < NIT; it += ngw) { CvItem ni = ci; const bool more = it + ngw < NIT;
        if (more) { ni = cv_p0_item(p, it + ngw); cv_load(ni, nxt, lane); }
        cv_store(ci, cur, scr, lane); ci = ni;
#pragma unroll
        for (int k = 0; k < 16; ++k) cur[k] = nxt[k]; }
}

__device__ __forceinline__ void ln_core(f32x4 (&v)[4], const float* __restrict__ g, const float* __restrict__ bta, int lane) {
    float s = 0.f;
#pragma unroll
    for (int j = 0; j < 4; ++j) s += (v[j][0] + v[j][1]) + (v[j][2] + v[j][3]);
    const float mean = wave_sum(s) * (1.f / DM); float q = 0.f;
#pragma unroll
    for (int j = 0; j < 4; ++j) { v[j] = v[j] - mean; q += (v[j][0] * v[j][0] + v[j][1] * v[j][1]) + (v[j][2] * v[j][2] + v[j][3] * v[j][3]); }
    const float rstd = rsqrtf(wave_sum(q) * (1.f / DM) + 1e-5f);
#pragma unroll
    for (int j = 0; j < 4; ++j) { const f32x4 gg = ((const f32x4*)g)[lane + 64 * j], bb = ((const f32x4*)bta)[lane + 64 * j]; v[j] = v[j] * rstd * gg + bb; }
}
__device__ __forceinline__ void store_row_bf16(bf16_t* dst, const f32x4 (&v)[4], int lane) {
#pragma unroll
    for (int j = 0; j < 4; ++j) { u32x2 w; w.x = cvt_pk_bf16(v[j][0], v[j][1]); w.y = cvt_pk_bf16(v[j][2], v[j][3]); ((u32x2*)dst)[lane + 64 * j] = w; }
}
__device__ __forceinline__ void zero_row_bf16(bf16_t* dst, int lane) {
#pragma unroll
    for (int j = 0; j < 4; ++j) ((u32x2*)dst)[lane + 64 * j] = (u32x2){0u, 0u};
}
__device__ __forceinline__ void gate_w_load(const float* __restrict__ w_in_l, float (&v)[24], int tid) {
#pragma unroll
    for (int q = 0; q < 24; ++q) { const int i = q * NTHR + tid, k = i / 12, c = i % 12; const int col = c < 4 ? C_FF + c : (c < 8 ? C_GB + (c - 4) : C_GA + (c - 8)); v[q] = w_in_l[(size_t)k * NPROJ + col]; }
}
__device__ __forceinline__ void gate_w_store(const float (&v)[24], LAS float* wg, int tid) {
#pragma unroll
    for (int q = 0; q < 24; ++q) { const int i = q * NTHR + tid, k = i / 12, c = i % 12; wg[c * DM + k] = v[q]; }
}
__device__ __forceinline__ void gates_row(const f32x4 (&v)[4], const LAS float* wg, float* __restrict__ grow, int lane) {
    float mine = 0.f;
#pragma unroll
    for (int cb = 0; cb < 12; cb += 4) { f32x4 w[4][4];
#pragma unroll
        for (int q = 0; q < 4; ++q)
#pragma unroll
            for (int j = 0; j < 4; ++j) w[q][j] = *(const LAS f32x4*)(wg + (cb + q) * DM + 4 * (lane + 64 * j));
        __builtin_amdgcn_sched_barrier(0);
#pragma unroll
        for (int q = 0; q < 4; ++q) { float a = 0.f;
#pragma unroll
            for (int j = 0; j < 4; ++j) a += (v[j][0] * w[q][j][0] + v[j][1] * w[q][j][1]) + (v[j][2] * w[q][j][2] + v[j][3] * w[q][j][3]);
            a = wave_sum(a); if (lane == cb + q) mine = a; } }
    if (lane < 16) grow[lane] = lane < 12 ? mine : 0.f;
}

__device__ __forceinline__ void phase_ln_in(const MKP& p, LAS unsigned char* lds, int gw, int ngw, int tid, int lane, const float (&gwv)[24]) {
    LAS float* wg = (LAS float*)lds;
    gate_w_store(gwv, wg, tid); __syncthreads();
    for (int r = gw; r < MP; r += ngw) { if ((r % LP) < NLEAD) { zero_row_bf16(p.actb + (size_t)r * DM, lane); if (lane < 16) p.gates[(size_t)r * 16 + lane] = 0.f; } }
#define LNIN_SRC(r_) (((r_) % LP) >= NLEAD + NMETA ? p.x + ((size_t)((r_) / LP) * SEQ + (((r_) % LP) - NLEAD - NMETA)) * DM : p.meta + (size_t)(((r_) % LP) - NLEAD) * DM)
    int r = gw; while (r < MP && (r % LP) < NLEAD) r += ngw;
    f32x4 nv[4];
    if (r < MP) { const float* src = LNIN_SRC(r);
#pragma unroll
        for (int j = 0; j < 4; ++j) nv[j] = ((const f32x4*)src)[lane + 64 * j]; }
    while (r < MP) {
        f32x4 v[4];
#pragma unroll
        for (int j = 0; j < 4; ++j) v[j] = nv[j];
        int rn = r + ngw; while (rn < MP && (rn % LP) < NLEAD) rn += ngw;
        if (rn < MP) { const float* src = LNIN_SRC(rn);
#pragma unroll
            for (int j = 0; j < 4; ++j) nv[j] = ((const f32x4*)src)[lane + 64 * j]; }
        ln_core(v, p.ln_in_g, p.ln_in_b, lane);
        store_row_bf16(p.actb + (size_t)r * DM, v, lane);
        gates_row(v, wg, p.gates + (size_t)r * 16, lane);
        r = rn;
    }
#undef LNIN_SRC
    __syncthreads();
}

constexpr int CNT_STRIDE = 32;
__device__ __forceinline__ void phase_ln1_route(const MKP& p, int layer, LAS unsigned char* lds, int gw, int ngw, int tid, int lane, int dump = 0) {
    float* stream_w = dump ? (float*)p.act : p.stream; bf16_t* actb_w = dump ? p.act + (size_t)40 * 1024 * 1024 : p.actb;
    int* tok_e_w = dump ? (int*)p.gch : p.tok_e; int* tok_pos_w = dump ? (int*)p.gch + (1 << 18) : p.tok_pos; float* tok_gate_w = dump ? (float*)p.gch + (2 << 18) : p.tok_gate; int* etok_w = dump ? (int*)p.gch + (4 << 18) : p.etok;
    constexpr int RS = DM + 4;
    constexpr int REC_OFF = 136192, LCNT_OFF = REC_OFF + 8192, BASE_OFF = LCNT_OFF + 128;
    LAS float* rwT = (LAS float*)lds; LAS int* rec = (LAS int*)(lds + REC_OFF); LAS int* lcnt = (LAS int*)(lds + LCNT_OFF); LAS int* lbase = (LAS int*)(lds + BASE_OFF);
    const int wave = tid >> 6;
    if (tid < 32) lcnt[tid] = 0;
    { const f32x4* src = (const f32x4*)(p.rwT + (size_t)layer * NE * RS);
      f32x4 t4[17];
#pragma unroll
      for (int q = 0; q < 17; ++q) { const int i = q * NTHR + tid; if (i < NE * RS / 4) t4[q] = src[i]; }
#pragma unroll
      for (int q = 0; q < 17; ++q) { const int i = q * NTHR + tid; if (i < NE * RS / 4) *(LAS f32x4*)(rwT + 4 * i) = t4[q]; } }
    __syncthreads();
    const float rbl = p.router_b[layer * NE + (lane & 31)]; int* cnt = p.cnt + layer * 2048 + (dump ? 1024 : 0);
    int r = gw; while (r < MP && (r % LP) < NLEAD) r += ngw;
    u32x2 nv[2][4]; int nrec = 0; const bf16_t* sumb = (const bf16_t*)p.stream;
    int rr[2]; rr[0] = r; { int x = r < MP ? r + ngw : MP; while (x < MP && (x % LP) < NLEAD) x += ngw; rr[1] = x < MP ? x : MP; }
#pragma unroll
    for (int k = 0; k < 2; ++k) if (rr[k] < MP) {
#pragma unroll
        for (int j = 0; j < 4; ++j) nv[k][j] = ((const u32x2*)(sumb + (size_t)rr[k] * DM))[lane + 64 * j]; }
    const float* lng = p.ln1_g + layer * DM; const float* lnb = p.ln1_b + layer * DM;
    const int ex_l = ((lane >> 5) << 4) | (((lane >> 4) & 1) << 3) | (((lane >> 3) & 1) << 2) | (((lane >> 2) & 1) << 1) | ((lane >> 1) & 1);
    const float rb_l = shfl_idx(rbl, ex_l);
    while (rr[0] < MP) {
        const bool hasB = rr[1] < MP;
        f32x4 v[2][4];
#pragma unroll
        for (int j = 0; j < 4; ++j) { v[0][j] = (f32x4){bflo(nv[0][j].x), bfhi(nv[0][j].x), bflo(nv[0][j].y), bfhi(nv[0][j].y)};
            const u32x2 wB = hasB ? nv[1][j] : nv[0][j]; v[1][j] = (f32x4){bflo(wB.x), bfhi(wB.x), bflo(wB.y), bfhi(wB.y)}; }
        int nr[2]; { int x = hasB ? rr[1] + ngw : MP; while (x < MP && (x % LP) < NLEAD) x += ngw; nr[0] = x < MP ? x : MP; x = nr[0] < MP ? nr[0] + ngw : MP; while (x < MP && (x % LP) < NLEAD) x += ngw; nr[1] = x < MP ? x : MP; }
#pragma unroll
        for (int k = 0; k < 2; ++k) if (nr[k] < MP) {
#pragma unroll
            for (int j = 0; j < 4; ++j) nv[k][j] = ((const u32x2*)(sumb + (size_t)nr[k] * DM))[lane + 64 * j]; }
        { float s0 = 0.f, s1 = 0.f;
#pragma unroll
          for (int j = 0; j < 4; ++j) { s0 += (v[0][j][0] + v[0][j][1]) + (v[0][j][2] + v[0][j][3]); s1 += (v[1][j][0] + v[1][j][1]) + (v[1][j][2] + v[1][j][3]); }
          const float m0 = wave_sum(s0) * (1.f / DM), m1 = wave_sum(s1) * (1.f / DM); float q0 = 0.f, q1 = 0.f;
#pragma unroll
          for (int j = 0; j < 4; ++j) { v[0][j] = v[0][j] - m0; v[1][j] = v[1][j] - m1;
              q0 += (v[0][j][0] * v[0][j][0] + v[0][j][1] * v[0][j][1]) + (v[0][j][2] * v[0][j][2] + v[0][j][3] * v[0][j][3]); q1 += (v[1][j][0] * v[1][j][0] + v[1][j][1] * v[1][j][1]) + (v[1][j][2] * v[1][j][2] + v[1][j][3] * v[1][j][3]); }
          const float r0 = rsqrtf(wave_sum(q0) * (1.f / DM) + 1e-5f), r1 = rsqrtf(wave_sum(q1) * (1.f / DM) + 1e-5f);
#pragma unroll
          for (int j = 0; j < 4; ++j) { const f32x4 gg = ((const f32x4*)lng)[lane + 64 * j], bb = ((const f32x4*)lnb)[lane + 64 * j]; v[0][j] = v[0][j] * r0 * gg + bb; v[1][j] = v[1][j] * r1 * gg + bb; } }
        store_row_bf16(actb_w + (size_t)rr[0] * DM, v[0], lane);
        if (hasB) store_row_bf16(actb_w + (size_t)rr[1] * DM, v[1], lane);
        float lg[2][32];
#pragma unroll
        for (int eb = 0; eb < 32; eb += 3) { f32x4 w[3][4];
#pragma unroll
            for (int q = 0; q < 3; ++q) if (eb + q < 32) {
#pragma unroll
                for (int j = 0; j < 4; ++j) w[q][j] = *(const LAS f32x4*)(rwT + (eb + q) * RS + 4 * (lane + 64 * j)); }
            __builtin_amdgcn_sched_barrier(0);
#pragma unroll
            for (int q = 0; q < 3; ++q) if (eb + q < 32) { f32x2 a0 = {0.f, 0.f}, a1 = {0.f, 0.f};
#pragma unroll
                for (int j = 0; j < 4; ++j) { const f32x2 wl = {w[q][j][0], w[q][j][1]}, wh = {w[q][j][2], w[q][j][3]};
                    a0 = __builtin_elementwise_fma((f32x2){v[0][j][0], v[0][j][1]}, wl, a0); a0 = __builtin_elementwise_fma((f32x2){v[0][j][2], v[0][j][3]}, wh, a0);
                    a1 = __builtin_elementwise_fma((f32x2){v[1][j][0], v[1][j][1]}, wl, a1); a1 = __builtin_elementwise_fma((f32x2){v[1][j][2], v[1][j][3]}, wh, a1); }
                lg[0][eb + q] = a0[0] + a0[1]; lg[1][eb + q] = a1[0] + a1[1]; }
            __builtin_amdgcn_sched_barrier(0); }
        float h1[2];
#define XSWZ(v_, m_) __int_as_float(__builtin_amdgcn_ds_swizzle(__float_as_int(v_), (((m_) << 10) | 0x1F)))
        { float h16[2][16], h8[2][8], h4[2][4], h2[2][2];
#pragma unroll
          for (int e = 0; e < 16; ++e)
#pragma unroll
              for (int k = 0; k < 2; ++k) { auto sw = __builtin_amdgcn_permlane32_swap(__float_as_uint(lg[k][e]), __float_as_uint(lg[k][16 + e]), false, false);
                  h16[k][e] = __uint_as_float(sw[0]) + __uint_as_float(sw[1]); }
          { const bool up = (lane & 16) != 0;
#pragma unroll
            for (int e = 0; e < 8; ++e)
#pragma unroll
                for (int k = 0; k < 2; ++k) { const float keep = up ? h16[k][8 + e] : h16[k][e], give = up ? h16[k][e] : h16[k][8 + e]; h8[k][e] = keep + XSWZ(give, 16); } }
          { const bool up = (lane & 8) != 0;
#pragma unroll
            for (int e = 0; e < 4; ++e)
#pragma unroll
                for (int k = 0; k < 2; ++k) { const float keep = up ? h8[k][4 + e] : h8[k][e], give = up ? h8[k][e] : h8[k][4 + e]; h4[k][e] = keep + XSWZ(give, 8); } }
          { const bool up = (lane & 4) != 0;
#pragma unroll
            for (int e = 0; e < 2; ++e)
#pragma unroll
                for (int k = 0; k < 2; ++k) { const float keep = up ? h4[k][2 + e] : h4[k][e], give = up ? h4[k][e] : h4[k][2 + e]; h2[k][e] = keep + XSWZ(give, 4); } }
          { const bool up = (lane & 2) != 0;
#pragma unroll
            for (int k = 0; k < 2; ++k) { const float keep = up ? h2[k][1] : h2[k][0], give = up ? h2[k][0] : h2[k][1]; h1[k] = keep + XSWZ(give, 2); } }
#pragma unroll
          for (int k = 0; k < 2; ++k) h1[k] += XSWZ(h1[k], 1); }
#undef XSWZ
        float val[2] = {h1[0] + rb_l, h1[1] + rb_l};
        float tv[2][4]; int ti[2][4];
#pragma unroll
        for (int t4 = 0; t4 < 4; ++t4) { const float mx0 = wave_max(val[0]), mx1 = wave_max(val[1]);
            const int c0 = (int)__builtin_ctzll(__ballot(val[0] == mx0)) >> 1, c1 = (int)__builtin_ctzll(__ballot(val[1] == mx1)) >> 1;
            tv[0][t4] = mx0; ti[0][t4] = c0; if (ex_l == c0) val[0] = -INFINITY; tv[1][t4] = mx1; ti[1][t4] = c1; if (ex_l == c1) val[1] = -INFINITY; }
#pragma unroll
        for (int k = 0; k < 2; ++k) if (k == 0 || hasB) {
            const float e1 = __expf(tv[k][1] - tv[k][0]), e2 = __expf(tv[k][2] - tv[k][0]), e3 = __expf(tv[k][3] - tv[k][0]); const float inv = 1.f / (1.f + e1 + e2 + e3);
            if (lane < 4) { const float gt = (lane == 0 ? 1.f : lane == 1 ? e1 : lane == 2 ? e2 : e3) * inv; const int ex = lane == 0 ? ti[k][0] : lane == 1 ? ti[k][1] : lane == 2 ? ti[k][2] : ti[k][3];
                const int rank = __hip_atomic_fetch_add(lcnt + ex, 1, __ATOMIC_RELAXED, __HIP_MEMORY_SCOPE_WORKGROUP);
                LAS int* rc = rec + ((wave * 16 + nrec) * 4 + lane) * 4; rc[0] = ex; rc[1] = rank; rc[2] = __float_as_int(gt); rc[3] = rr[k]; }
            ++nrec; }
        rr[0] = nr[0]; rr[1] = nr[1];
    }
    __syncthreads();
    if (tid < 32) lbase[tid] = atomicAdd(&cnt[tid * CNT_STRIDE], lcnt[tid]);
    __syncthreads();
    for (int i = lane; i < nrec * 4; i += 64) { const LAS int* rc = rec + ((wave * 16) * 4 + i) * 4; const int ex = rc[0], pos = lbase[ex] + rc[1], rr_ = rc[3], k = i & 3;
        tok_e_w[(size_t)rr_ * 4 + k] = ex; tok_pos_w[(size_t)rr_ * 4 + k] = pos; tok_gate_w[(size_t)rr_ * 4 + k] = __int_as_float(rc[2]); etok_w[(size_t)ex * MP + pos] = rr_; }
    __syncthreads();
}

__device__ __forceinline__ void build_expert_tab(const int* cnt, volatile LAS int* tab, int tid) {
    __syncthreads();
    if (tid < 64) { const int e = tid & 31; int np = 0; if (tid < 32) np = (__hip_atomic_load(cnt + e * CNT_STRIDE, __ATOMIC_RELAXED, __HIP_MEMORY_SCOPE_AGENT) + 255) >> 8;
        int incl = np;
#pragma unroll
        for (int o = 1; o < 32; o <<= 1) { const int u = shfl_up_li(incl, o, tid); if (tid >= o) incl += u; }
        const int base = incl - np;
        if (tid < 32) { tab[1 + e] = base; for (int q = 0; q < np; ++q) tab[40 + base + q] = e; if (e == 31) { tab[33] = incl; tab[0] = incl; } } }
    __syncthreads();
}

__device__ __forceinline__ void phase_combine_ln2(const MKP& p, int layer, LAS unsigned char* lds, int gw, int ngw, int tid, int lane, int dump = 0) {
    float* stream_w = dump ? (float*)p.act : p.stream; bf16_t* actb_w = dump ? p.act + (size_t)40 * 1024 * 1024 : p.actb; float* gates_w = dump ? (float*)p.gch : p.gates; float* out_w = dump ? (float*)p.act : p.out;
    volatile LAS int* tab = (volatile LAS int*)(lds + LDS_TAB);
    LAS float* wg = (LAS float*)lds;
    build_expert_tab(p.cnt + layer * 2048, tab, tid);
    if (layer == 0) { for (int i = tid; i < 12 * DM / 4; i += NTHR) *(LAS f32x4*)(wg + 4 * i) = *(const f32x4*)(p.wgc + 4 * i); __syncthreads(); }
    if (layer == 0) for (int r = gw; r < MP; r += ngw) { if ((r % LP) < NLEAD) { zero_row_bf16(actb_w + (size_t)r * DM, lane); if (lane < 16) gates_w[(size_t)r * 16 + lane] = 0.f; } }
    int r = gw; while (r < MP && (r % LP) < NLEAD) r += ngw;
    int te = 0, tp = 0; float tg = 0.f;
    if (r < MP && lane < 4) { te = p.tok_e[(size_t)r * 4 + lane]; tp = p.tok_pos[(size_t)r * 4 + lane]; tg = p.tok_gate[(size_t)r * 4 + lane]; }
    while (r < MP) { const int b = r / LP, t = r % LP;
        const bf16_t* yr[4]; float gt[4];
#pragma unroll
        for (int k = 0; k < 4; ++k) { const int e = __builtin_amdgcn_readlane(te, k), pos = __builtin_amdgcn_readlane(tp, k); gt[k] = __int_as_float(__builtin_amdgcn_readlane(__float_as_int(tg), k));
            yr[k] = p.ybuf + ((size_t)tab[1 + e] * 256 + pos) * DM; }
        f32x4 v[4]; u32x2 yw[4][4];
#pragma unroll
        for (int j = 0; j < 4; ++j) { const u32x2 w = ((const u32x2*)(p.actb + (size_t)r * DM))[lane + 64 * j]; v[j] = (f32x4){bflo(w.x), bfhi(w.x), bflo(w.y), bfhi(w.y)}; }
#pragma unroll
        for (int k = 0; k < 4; ++k)
#pragma unroll
            for (int j = 0; j < 4; ++j) yw[k][j] = ((const u32x2*)yr[k])[lane + 64 * j];
        int rn = r + ngw; while (rn < MP && (rn % LP) < NLEAD) rn += ngw;
        if (rn < MP && lane < 4) { te = p.tok_e[(size_t)rn * 4 + lane]; tp = p.tok_pos[(size_t)rn * 4 + lane]; tg = p.tok_gate[(size_t)rn * 4 + lane]; }
#pragma unroll
        for (int j = 0; j < 4; ++j) { v[j] = v[j] * DN_ALPHA;
#pragma unroll
            for (int k = 0; k < 4; ++k) { const u32x2 w = yw[k][j]; v[j][0] += gt[k] * bflo(w.x); v[j][1] += gt[k] * bfhi(w.x); v[j][2] += gt[k] * bflo(w.y); v[j][3] += gt[k] * bfhi(w.y); } }
        ln_core(v, p.ln2_g + layer * DM, p.ln2_b + layer * DM, lane);
        if (layer == 0) {
            store_row_bf16(actb_w + (size_t)r * DM, v, lane);
            gates_row(v, wg, gates_w + (size_t)r * 16, lane);
        } else if (t >= NLEAD + NMETA) {
#pragma unroll
            for (int j = 0; j < 4; ++j) ((f32x4*)(out_w + ((size_t)b * SEQ + (t - NLEAD - NMETA)) * DM))[lane + 64 * j] = v[j];
        }
        r = rn;
    }
    __syncthreads();
}
namespace attn_body {
using bf16=unsigned short;
using bf16x8=__attribute__((ext_vector_type(8)))short;
using s16x4=__attribute__((ext_vector_type(4)))short;
using f32x16=__attribute__((ext_vector_type(16)))float;
using u32x4=__attribute__((ext_vector_type(4)))unsigned;
constexpr int D=64,PQ=NPJ;
constexpr int NW=8,QBLK=32,QB=QBLK*NW,KVBLK=64;
__device__ __forceinline__ int crow(int r,int hi){return (r&3)+8*(r>>2)+4*hi;}
#define SBAR() __builtin_amdgcn_sched_barrier(0)
template<int MODE> __device__ __forceinline__ void cmask(f32x16&p0,f32x16&p1,int jb,int qrel,int hi){
  const float NEG=-INFINITY;
  if(MODE==0||MODE==2){ if(jb>(qrel>>6)){
      #pragma unroll
      for(int r=0;r<16;++r){p0[r]=NEG;p1[r]=NEG;} } }
  else{ int kb=64*jb+4*hi;
    #pragma unroll
    for(int r=0;r<16;++r){int kv=kb+(r&3)+8*(r>>2); if(kv>qrel)p0[r]=NEG; if(kv+32>qrel)p1[r]=NEG;} }
}

constexpr int NSLOT=3, SLOTB=8192;
constexpr int LDS_K=0, LDS_V=NSLOT*SLOTB, LDS_WS=2*NSLOT*SLOTB, LDS_OST=LDS_WS+NW*64*4, LDS_BYTES=LDS_OST+NW*4096+NSLOT*SLOTB;
constexpr float C2=0.125f*1.4426950408889634f;
__device__ __forceinline__ void glds16(const void*gsrc,unsigned lds_dst){unsigned keep;
  asm volatile("s_mov_b32 %0, m0\n\ts_mov_b32 m0, %2\n\ts_nop 0\n\tglobal_load_lds_dwordx4 %1, off\n\ts_mov_b32 m0, %0":"=&s"(keep):"v"(gsrc),"s"(lds_dst):"memory");}
__device__ __forceinline__ float max3f(float a,float b,float c){float r;asm("v_max3_f32 %0, %1, %2, %3":"=v"(r):"v"(a),"v"(b),"v"(c));return r;}
__device__ __forceinline__ float max2f(float a,float b){float r;asm("v_max_f32_e32 %0, %1, %2":"=v"(r):"v"(a),"v"(b));return r;}
__device__ __forceinline__ float fadd_s(float a,float b){float r;asm("v_add_f32_e32 %0, %1, %2":"=v"(r):"v"(a),"v"(b));return r;}
__device__ __forceinline__ float fsub_s(float a,float b){float r;asm("v_sub_f32_e32 %0, %1, %2":"=v"(r):"v"(a),"v"(b));return r;}
typedef float f32x2_t __attribute__((ext_vector_type(2))); typedef __bf16 bf16x2_t __attribute__((ext_vector_type(2)));
__device__ __forceinline__ unsigned cvtpk_s(float lo,float hi){f32x2_t v={lo,hi};bf16x2_t b=__builtin_convertvector(v,bf16x2_t);return __builtin_bit_cast(unsigned,b);}
#define WAIT_BAR(N) asm volatile("s_waitcnt vmcnt(" #N ") lgkmcnt(0)\n\ts_barrier":::"memory")

__device__ __forceinline__ void qkt(f32x16&p0,f32x16&p1,const char*Kslot,const bf16x8*qr,const f32x16&ci0,const f32x16&ci1,int r32,int hi){
  const char*kb=Kslot+hi*1024+r32*16;
  #pragma unroll
  for(int d0=0;d0<4;++d0){
    const bf16x8 b0=*reinterpret_cast<const bf16x8*>(kb+d0*2048);
    const bf16x8 b1=*reinterpret_cast<const bf16x8*>(kb+d0*2048+512);
    if(d0==0){p0=__builtin_amdgcn_mfma_f32_32x32x16_bf16(b0,qr[0],ci0,0,0,0);p1=__builtin_amdgcn_mfma_f32_32x32x16_bf16(b1,qr[0],ci1,0,0,0);}
    else{p0=__builtin_amdgcn_mfma_f32_32x32x16_bf16(b0,qr[d0],p0,0,0,0);p1=__builtin_amdgcn_mfma_f32_32x32x16_bf16(b1,qr[d0],p1,0,0,0);}}
}
typedef __attribute__((address_space(3))) const char* lds_cptr;
typedef short v4i16_t __attribute__((ext_vector_type(4)));
__device__ __forceinline__ void kload8(bf16x8*kf,lds_cptr kp){
  kf[0]=*(const __attribute__((address_space(3))) bf16x8*)(kp);      kf[1]=*(const __attribute__((address_space(3))) bf16x8*)(kp+512);
  kf[2]=*(const __attribute__((address_space(3))) bf16x8*)(kp+2048); kf[3]=*(const __attribute__((address_space(3))) bf16x8*)(kp+2560);
  kf[4]=*(const __attribute__((address_space(3))) bf16x8*)(kp+4096); kf[5]=*(const __attribute__((address_space(3))) bf16x8*)(kp+4608);
  kf[6]=*(const __attribute__((address_space(3))) bf16x8*)(kp+6144); kf[7]=*(const __attribute__((address_space(3))) bf16x8*)(kp+6656);
}
__device__ __forceinline__ void kload2(bf16x8*kf,lds_cptr kp,int j){ kf[2*j]=*(const __attribute__((address_space(3))) bf16x8*)(kp+j*2048); kf[2*j+1]=*(const __attribute__((address_space(3))) bf16x8*)(kp+j*2048+512); }
__device__ __forceinline__ s16x4 vtr(lds_cptr p){ return __builtin_bit_cast(s16x4,__builtin_amdgcn_ds_read_tr16_b64_v4i16((__attribute__((address_space(3))) v4i16_t*)p)); }
__device__ __forceinline__ float rowmax(const f32x16&p0,const f32x16&p1){
  float a=max3f(p0[0],p0[1],p1[0]),b=max3f(p0[2],p0[3],p1[1]);a=max3f(a,p1[2],p1[3]);
  #pragma unroll
  for(int r=4;r<16;r+=4){a=max3f(a,p0[r],p0[r+1]);b=max3f(b,p0[r+2],p0[r+3]);a=max3f(a,p1[r],p1[r+1]);b=max3f(b,p1[r+2],p1[r+3]);}
  const float m=max2f(a,b);
  auto rr=__builtin_amdgcn_permlane32_swap(__float_as_uint(m),__float_as_uint(m),false,false);
  return max2f(__uint_as_float(rr[0]),__uint_as_float(rr[1]));
}
template<int NDB_> __device__ __forceinline__ void pv(f32x16*o,int vb,bf16x8 pa0,bf16x8 pa1,bf16x8 pa2,bf16x8 pa3){
  #pragma unroll
  for(int d0=0;d0<NDB_;++d0){s16x4 lo[4],hi[4];
    #pragma unroll
    for(int ks=0;ks<4;++ks){
      asm volatile("ds_read_b64_tr_b16 %0,%1 offset:%c2":"=&v"(lo[ks]):"v"(vb),"i"(d0*4096+ks*1024):"memory");
      asm volatile("ds_read_b64_tr_b16 %0,%1 offset:%c2":"=&v"(hi[ks]):"v"(vb),"i"(d0*4096+ks*1024+512):"memory");}
    asm volatile("s_waitcnt lgkmcnt(0)":::"memory");SBAR();
    #define PK(k) (bf16x8){lo[k][0],lo[k][1],lo[k][2],lo[k][3],hi[k][0],hi[k][1],hi[k][2],hi[k][3]}
    o[d0]=__builtin_amdgcn_mfma_f32_32x32x16_bf16(pa0,PK(0),o[d0],0,0,0);
    o[d0]=__builtin_amdgcn_mfma_f32_32x32x16_bf16(pa1,PK(1),o[d0],0,0,0);
    o[d0]=__builtin_amdgcn_mfma_f32_32x32x16_bf16(pa2,PK(2),o[d0],0,0,0);
    o[d0]=__builtin_amdgcn_mfma_f32_32x32x16_bf16(pa3,PK(3),o[d0],0,0,0);
    #undef PK
  }
}

__device__ __forceinline__ bf16x8 make_qx(float nm){
  const unsigned p1=cvtpk_s(nm,0.f)&0xffffu; const float r1=nm-__uint_as_float(p1<<16);
  const unsigned p2=cvtpk_s(r1,0.f)&0xffffu; const float r2=r1-__uint_as_float(p2<<16);
  const unsigned p3=cvtpk_s(r2,0.f)&0xffffu;
  u32x4 w; w.x=0x3F803F80u; w.y=0x3F80u|(p1<<16); w.z=p2|(p3<<16); w.w=0u; return __builtin_bit_cast(bf16x8,w);
}
__device__ __forceinline__ bf16x8 make_gf(unsigned long long g,unsigned msk){
  u32x4 w; w.x=(unsigned)g&msk; w.y=(unsigned)(g>>32)&msk; w.z=0x3F803F80u&msk; w.w=0u; return __builtin_bit_cast(bf16x8,w);
}
__device__ __forceinline__ void gload(unsigned long long&d,const unsigned long long*sbase,unsigned voff){ asm volatile("global_load_dwordx2 %0, %1, %2":"=&v"(d):"v"(voff),"s"(sbase):"memory"); }
#ifndef ATTN_STORE16
#define ATTN_STORE16(p,v) (*(u32x4*)(p)=(v))
#endif
template<int MODE,int THRL,int DUP=0> __device__ __forceinline__ void attn_unit(int qb,const bf16*Qh,const bf16*__restrict__ Kh,const bf16*__restrict__ Vh,bf16*Oh,int po,const unsigned long long*__restrict__ Gk0,float lcorr,char*shm,const int tid,const long ohalf=0,const int tile0=0){
  constexpr int VM=(MODE==2?2:1),NDB=(MODE==2?4:2),LWS=LDS_V+NSLOT*SLOTB*VM,LOST=LWS+NW*64*4;
  const int lane=tid&63,r32=lane&31,hi=lane>>5; const int wid=__builtin_amdgcn_readfirstlane(tid>>6);
  const int q0=qb*QB;
  const bf16*Qw=Qh+(long)(q0+wid*QBLK)*PQ;
  Kh+=(long)tile0*KVBLK*PQ; Vh+=(long)tile0*KVBLK*PQ; const unsigned long long*__restrict__ Gk=Gk0+tile0*KVBLK;
  const unsigned lds0=(unsigned)(uintptr_t)shm;
  float*wsf=(float*)(shm+LWS)+wid*64;
  const bf16*ksrc=Kh+(long)lane*PQ+wid*8;
  const bf16*vsrc=Vh+(long)(16*(wid&3)+(lane>>2))*PQ+(wid>>2)*32+(lane&3)*8;
  const unsigned kdst=lds0+LDS_K+wid*1024, vdst=lds0+LDS_V+wid*1024;
  #define DMA_K(t,slot) glds16(ksrc+(long)(t)*KVBLK*PQ,(unsigned)__builtin_amdgcn_readfirstlane(kdst+(slot)))
  #define DMA_V(t,slot) do{ glds16(vsrc+(long)(t)*KVBLK*PQ,(unsigned)__builtin_amdgcn_readfirstlane(vdst+(slot)*VM)); if(MODE==2) glds16(vsrc+64+(long)(t)*KVBLK*PQ,(unsigned)__builtin_amdgcn_readfirstlane(vdst+(slot)*VM+8192)); }while(0)
  const int vb0=(int)(lds0+LDS_V)+((lane>>4)&1)*32+(lane&3)*8+(4*hi+((lane&15)>>2))*64;
  const char*Kbase=shm+LDS_K; bf16x8 kf[8];
  const lds_cptr shm3=(lds_cptr)shm; const lds_cptr kp0=shm3+LDS_K+hi*1024+r32*16; const lds_cptr vp0=shm3+LDS_V+((lane>>4)&1)*32+(lane&3)*8+(4*hi+((lane&15)>>2))*64;
  const int NT=(q0+QB)/KVBLK-tile0;
  unsigned long long gc0=0,gc1=0; const unsigned goff=(unsigned)r32*8u;
  #define GMSK (hi?0u:0xffffffffu)
  #define QX make_qx(-mhat)
  if(MODE==1){ gload(gc0,Gk,goff); gload(gc1,Gk+32,goff); }
  DMA_K(0,0);DMA_V(0,0);DMA_K(1,SLOTB);
  bf16x8 qr[4];
  #pragma unroll
  for(int d0=0;d0<4;++d0)qr[d0]=*reinterpret_cast<const bf16x8*>(&Qw[(long)r32*PQ+d0*16+hi*8]);
  float mhat=0.f,l_reg=0.f;f32x16 o[NDB];
  #pragma unroll
  for(int d_=0;d_<NDB;++d_)o[d_]=f32x16{};
  f32x16 negm=f32x16{};if(MODE==0)asm volatile("":"+v"(negm));
  const int qrel=wid*QBLK+r32;
  #define CMASK(P0,P1,t) do{int jb_=(t)-(NT-4); if(jb_>=0)cmask<MODE>(P0,P1,jb_,qrel,hi);}while(0)
  #define NEGM_UPD() do{ if(MODE==1){ } else { _Pragma("unroll") for(int r=0;r<16;++r)negm[r]=-mhat; asm volatile("":"+v"(negm)); } }while(0)
  bool resc=false;
  #define START(P0,P1) do{ const float rm=rowmax(P0,P1); resc=false; \
    { const float dl=rm; mhat=fadd_s(mhat,dl); \
      _Pragma("unroll") for(int r=0;r<16;++r){P0[r]=fsub_s(P0[r],dl);P1[r]=fsub_s(P1[r],dl);} \
      NEGM_UPD(); } \
    _Pragma("unroll") for(int r=0;r<16;++r)P0[r]=__builtin_amdgcn_exp2f(P0[r]); }while(0)
  #define RESC() do{ if(resc){ asm volatile("s_waitcnt lgkmcnt(0)":::"memory"); \
      _Pragma("unroll") for(int d_=0;d_<NDB;++d_) _Pragma("unroll") for(int r=0;r<16;++r)o[d_][r]*=wsf[crow(r,hi)]; } }while(0)
  f32x16 pA0,pA1,pB0,pB1;
  int sl_prev=0,sl_cur=0,sl_next=SLOTB;
  #define ROT() do{sl_prev=sl_cur;sl_cur=sl_next;sl_next=(sl_next==(NSLOT-1)*SLOTB)?0:sl_next+SLOTB;}while(0)
  DMA_K(2,2*SLOTB);
  #define GPIN() asm volatile("":"+v"(gc0),"+v"(gc1))
  #define WB_A() do{ if(MODE==2){WAIT_BAR(3);}else{WAIT_BAR(2);} }while(0)
  #define WB_B() do{ if(MODE==2){WAIT_BAR(2);}else{WAIT_BAR(1);} }while(0)
  if(MODE==2){WAIT_BAR(4);}else{WAIT_BAR(3);} GPIN();
  const f32x16 zero16=f32x16{};
  if(MODE==1){ const bf16x8 qx0=make_qx(0.f); const f32x16 cb0=__builtin_amdgcn_mfma_f32_32x32x16_bf16(make_gf(gc0,GMSK),qx0,zero16,0,0,0),cb1=__builtin_amdgcn_mfma_f32_32x32x16_bf16(make_gf(gc1,GMSK),qx0,zero16,0,0,0);
    qkt(pA0,pA1,Kbase,qr,cb0,cb1,r32,hi); gload(gc0,Gk+64,goff); gload(gc1,Gk+96,goff); }
  else qkt(pA0,pA1,Kbase,qr,negm,negm,r32,hi);
  asm volatile("s_nop 15\n\ts_nop 7":"+v"(pA0),"+v"(pA1));CMASK(pA0,pA1,0);
  START(pA0,pA1);
  _Pragma("unroll") for(int r=0;r<16;++r)pA1[r]=__builtin_amdgcn_exp2f(pA1[r]);
  #define GADV() do{ if(MODE==1){ GPIN(); } }while(0)
  WAIT_BAR(0); GADV();
  DMA_K(3,0);DMA_V(1,SLOTB);
  ROT();
  kload8(kf,kp0+sl_cur);
  WB_A();
  s16x4 vlo[8],vhi[8]; u32x4 pw0,pw1,pw2,pw3;
  #define PKW(P,B) cvtpk_s(P[B],P[B+1])
  #define PAF(k) __builtin_bit_cast(bf16x8,pw##k)
  #define VFR(i) (bf16x8){vlo[i][0],vlo[i][1],vlo[i][2],vlo[i][3],vhi[i][0],vhi[i][1],vhi[i][2],vhi[i][3]}
  #define PIN(x) asm volatile("":"+v"(x))
  #define MX3(a,b,c) __builtin_fmaxf(__builtin_fmaxf((a),(b)),(c))
  #define GAPA(MF,A0,A1,A2,A3,W0,W1,PW) do{ MF; sacc+=A0; sacc+=A1; sacc+=A2; sacc+=A3; PIN(sacc); W0; W1; PIN(PW); SBAR(); }while(0)
  #define EX(v) __builtin_amdgcn_exp2f(v)
  #define GAPB(MF,X,B) do{ MF; if(DUP){ MF; } X[B]=EX(X[B]); X[B+1]=EX(X[B+1]); X[B+2]=EX(X[B+2]); X[B+3]=EX(X[B+3]); PIN(X); SBAR(); }while(0)
  #define VRD(i) do{ vlo[i]=vtr(vp_+(((i)>>2)*4096+((i)&3)*1024)); vhi[i]=vtr(vp_+(((i)>>2)*4096+((i)&3)*1024+512)); }while(0)
  #define KRD(G,j) do{ if(G){ kload2(kf,kp0+sl_next,j); SBAR(); } }while(0)
  #define STEP(C0,C1,P0,P1,t,GK,GV,GL) do{ SBAR(); \
    if(MODE==1){ const bf16x8 qx_=QX; { const bf16x8 gf0_=make_gf(gc0,GMSK); C0=__builtin_amdgcn_mfma_f32_32x32x16_bf16(gf0_,qx_,zero16,0,0,0); } SBAR(); \
      { const bf16x8 gf1_=make_gf(gc1,GMSK); C1=__builtin_amdgcn_mfma_f32_32x32x16_bf16(gf1_,qx_,zero16,0,0,0); } SBAR(); \
      if((t)+1<NT){ gload(gc0,Gk+((t)+1)*64,goff); gload(gc1,Gk+((t)+1)*64+32,goff); } } \
    const lds_cptr vp_=vp0+sl_prev; \
    VRD(0); SBAR(); float sacc=(P0[0]+P0[1]); \
    GAPA(C0=__builtin_amdgcn_mfma_f32_32x32x16_bf16(kf[0],qr[0],(MODE==1?C0:negm),0,0,0), P0[2],P0[3],P0[4],P0[5],     pw0[0]=PKW(P0,0), pw0[1]=PKW(P0,2), pw0); \
    VRD(4); SBAR(); GAPA(C1=__builtin_amdgcn_mfma_f32_32x32x16_bf16(kf[1],qr[0],(MODE==1?C1:negm),0,0,0), P0[6],P0[7],P0[8],P0[9],     pw0[2]=PKW(P0,4), pw0[3]=PKW(P0,6), pw0); \
    VRD(1); SBAR(); GAPA(C0=__builtin_amdgcn_mfma_f32_32x32x16_bf16(kf[2],qr[1],C0,0,0,0),   P0[10],P0[11],P0[12],P0[13], pw1[0]=PKW(P0,8), pw1[1]=PKW(P0,10), pw1); \
    VRD(5); SBAR(); GAPA(C1=__builtin_amdgcn_mfma_f32_32x32x16_bf16(kf[3],qr[1],C1,0,0,0),   P0[14],P0[15],P1[0],P1[1],   pw1[2]=PKW(P0,12),pw1[3]=PKW(P0,14), pw1); \
    if(MODE==0){VRD(2);} SBAR(); GAPA(C0=__builtin_amdgcn_mfma_f32_32x32x16_bf16(kf[4],qr[2],C0,0,0,0),   P1[2],P1[3],P1[4],P1[5],     pw2[0]=PKW(P1,0), pw2[1]=PKW(P1,2), pw2); \
    if(MODE==0){VRD(6);} SBAR(); GAPA(C1=__builtin_amdgcn_mfma_f32_32x32x16_bf16(kf[5],qr[2],C1,0,0,0),   P1[6],P1[7],P1[8],P1[9],     pw2[2]=PKW(P1,4), pw2[3]=PKW(P1,6), pw2); \
    if(MODE==0){VRD(3);} SBAR(); GAPA(C0=__builtin_amdgcn_mfma_f32_32x32x16_bf16(kf[6],qr[3],C0,0,0,0),   P1[10],P1[11],P1[12],P1[13], pw3[0]=PKW(P1,8), pw3[1]=PKW(P1,10), pw3); \
    if(MODE==0){VRD(7);} SBAR(); GAPA(C1=__builtin_amdgcn_mfma_f32_32x32x16_bf16(kf[7],qr[3],C1,0,0,0),   P1[14],P1[15],0.f,0.f,       pw3[2]=PKW(P1,12),pw3[3]=PKW(P1,14), pw3); \
    l_reg+=sacc; \
    if(GK){DMA_K((t)+3,sl_cur);} if(GV){DMA_V((t)+1,sl_next);} \
    CMASK(C0,C1,t); \
    { float a=MX3(C0[0],C0[1],C1[0]),b=MX3(C0[2],C0[3],C1[1]); a=MX3(a,C1[2],C1[3]); \
      _Pragma("unroll") for(int r=4;r<16;r+=4){a=MX3(a,C0[r],C0[r+1]);b=MX3(b,C0[r+2],C0[r+3]);a=MX3(a,C1[r],C1[r+1]);b=MX3(b,C1[r+2],C1[r+3]);} \
      float rm=__builtin_fmaxf(a,b); { auto rr=__builtin_amdgcn_permlane32_swap(__float_as_uint(rm),__float_as_uint(rm),false,false); rm=__builtin_fmaxf(__uint_as_float(rr[0]),__uint_as_float(rr[1])); } \
      resc=false; \
      if(__builtin_expect(__any(rm>(float)THRL),0)){ const float dl=__builtin_fmaxf(rm,0.f); mhat+=dl; \
        _Pragma("unroll") for(int r=0;r<16;++r){C0[r]-=dl;C1[r]-=dl;} \
        NEGM_UPD(); \
        const float f=__builtin_amdgcn_exp2f(-dl); l_reg*=f; if(hi==0)wsf[r32]=f; resc=true; } } \
    SBAR(); \
    if(MODE==1){VRD(2);VRD(6);SBAR();} GAPB(o[0]=__builtin_amdgcn_mfma_f32_32x32x16_bf16(PAF(0),VFR(0),o[0],0,0,0), C0,0); \
    GAPB(o[1]=__builtin_amdgcn_mfma_f32_32x32x16_bf16(PAF(0),VFR(4),o[1],0,0,0), C0,4); \
    if(MODE==1){VRD(3);VRD(7);SBAR();} KRD(GL,0); GAPB(o[0]=__builtin_amdgcn_mfma_f32_32x32x16_bf16(PAF(1),VFR(1),o[0],0,0,0), C0,8); \
    KRD(GL,1); GAPB(o[1]=__builtin_amdgcn_mfma_f32_32x32x16_bf16(PAF(1),VFR(5),o[1],0,0,0), C0,12); \
    KRD(GL,2); GAPB(o[0]=__builtin_amdgcn_mfma_f32_32x32x16_bf16(PAF(2),VFR(2),o[0],0,0,0), C1,0); \
    KRD(GL,3); GAPB(o[1]=__builtin_amdgcn_mfma_f32_32x32x16_bf16(PAF(2),VFR(6),o[1],0,0,0), C1,4); \
    GAPB(o[0]=__builtin_amdgcn_mfma_f32_32x32x16_bf16(PAF(3),VFR(3),o[0],0,0,0), C1,8); \
    GAPB(o[1]=__builtin_amdgcn_mfma_f32_32x32x16_bf16(PAF(3),VFR(7),o[1],0,0,0), C1,12); \
    }while(0)
  #define GAPB2(MF,X,B) do{ MF; if(DUP){ MF; } X[B]=EX(X[B]); X[B+1]=EX(X[B+1]); PIN(X); SBAR(); }while(0)
  #define VRD2(sl_,i) do{ vlo[sl_]=vtr(vp_+(((i)>>2)*4096+((i)&3)*1024)); vhi[sl_]=vtr(vp_+(((i)>>2)*4096+((i)&3)*1024+512)); }while(0)
  #define FI(j) ((((j)&3)<<2)|((j)>>2))
  #define PVJ(j,X,B) GAPB2(o[(j)&3]=__builtin_amdgcn_mfma_f32_32x32x16_bf16(PAFS((j)>>2),VFR((j)&3),o[(j)&3],0,0,0), X,B)
  #define PAFS(k) ((k)==0?PAF(0):(k)==1?PAF(1):(k)==2?PAF(2):PAF(3))
  #define STEP2(C0,C1,P0,P1,t,GK,GV,GL) do{ SBAR(); \
    const lds_cptr vp_=vp0+sl_prev*VM; \
    float sacc=(P0[0]+P0[1]); \
    GAPA(C0=__builtin_amdgcn_mfma_f32_32x32x16_bf16(kf[0],qr[0],negm,0,0,0), P0[2],P0[3],P0[4],P0[5],     pw0[0]=PKW(P0,0), pw0[1]=PKW(P0,2), pw0); \
    GAPA(C1=__builtin_amdgcn_mfma_f32_32x32x16_bf16(kf[1],qr[0],negm,0,0,0), P0[6],P0[7],P0[8],P0[9],     pw0[2]=PKW(P0,4), pw0[3]=PKW(P0,6), pw0); \
    GAPA(C0=__builtin_amdgcn_mfma_f32_32x32x16_bf16(kf[2],qr[1],C0,0,0,0),   P0[10],P0[11],P0[12],P0[13], pw1[0]=PKW(P0,8), pw1[1]=PKW(P0,10), pw1); \
    GAPA(C1=__builtin_amdgcn_mfma_f32_32x32x16_bf16(kf[3],qr[1],C1,0,0,0),   P0[14],P0[15],P1[0],P1[1],   pw1[2]=PKW(P0,12),pw1[3]=PKW(P0,14), pw1); \
    VRD2(0,FI(0)); SBAR(); GAPA(C0=__builtin_amdgcn_mfma_f32_32x32x16_bf16(kf[4],qr[2],C0,0,0,0),   P1[2],P1[3],P1[4],P1[5],     pw2[0]=PKW(P1,0), pw2[1]=PKW(P1,2), pw2); \
    VRD2(1,FI(1)); SBAR(); GAPA(C1=__builtin_amdgcn_mfma_f32_32x32x16_bf16(kf[5],qr[2],C1,0,0,0),   P1[6],P1[7],P1[8],P1[9],     pw2[2]=PKW(P1,4), pw2[3]=PKW(P1,6), pw2); \
    VRD2(2,FI(2)); SBAR(); GAPA(C0=__builtin_amdgcn_mfma_f32_32x32x16_bf16(kf[6],qr[3],C0,0,0,0),   P1[10],P1[11],P1[12],P1[13], pw3[0]=PKW(P1,8), pw3[1]=PKW(P1,10), pw3); \
    VRD2(3,FI(3)); SBAR(); GAPA(C1=__builtin_amdgcn_mfma_f32_32x32x16_bf16(kf[7],qr[3],C1,0,0,0),   P1[14],P1[15],0.f,0.f,       pw3[2]=PKW(P1,12),pw3[3]=PKW(P1,14), pw3); \
    l_reg+=sacc; \
    if(GK){DMA_K((t)+3,sl_cur);} if(GV){DMA_V((t)+1,sl_next);} \
    CMASK(C0,C1,t); \
    { float a=MX3(C0[0],C0[1],C1[0]),b=MX3(C0[2],C0[3],C1[1]); a=MX3(a,C1[2],C1[3]); \
      _Pragma("unroll") for(int r=4;r<16;r+=4){a=MX3(a,C0[r],C0[r+1]);b=MX3(b,C0[r+2],C0[r+3]);a=MX3(a,C1[r],C1[r+1]);b=MX3(b,C1[r+2],C1[r+3]);} \
      float rm=__builtin_fmaxf(a,b); { auto rr=__builtin_amdgcn_permlane32_swap(__float_as_uint(rm),__float_as_uint(rm),false,false); rm=__builtin_fmaxf(__uint_as_float(rr[0]),__uint_as_float(rr[1])); } \
      resc=false; \
      if(__builtin_expect(__any(rm>(float)THRL),0)){ const float dl=__builtin_fmaxf(rm,0.f); mhat+=dl; \
        _Pragma("unroll") for(int r=0;r<16;++r){C0[r]-=dl;C1[r]-=dl;} \
        NEGM_UPD(); \
        const float f=__builtin_amdgcn_exp2f(-dl); l_reg*=f; if(hi==0)wsf[r32]=f; resc=true; } } \
    SBAR(); \
    PVJ(0,C0,0);  VRD2(0,FI(4));  SBAR(); \
    PVJ(1,C0,2);  VRD2(1,FI(5));  SBAR(); \
    PVJ(2,C0,4);  VRD2(2,FI(6));  SBAR(); \
    PVJ(3,C0,6);  VRD2(3,FI(7));  SBAR(); \
    KRD(GL,0); PVJ(4,C0,8);  VRD2(0,FI(8));  SBAR(); \
    KRD(GL,1); PVJ(5,C0,10); VRD2(1,FI(9));  SBAR(); \
    KRD(GL,2); PVJ(6,C0,12); VRD2(2,FI(10)); SBAR(); \
    KRD(GL,3); PVJ(7,C0,14); VRD2(3,FI(11)); SBAR(); \
    PVJ(8,C1,0);  VRD2(0,FI(12)); SBAR(); \
    PVJ(9,C1,2);  VRD2(1,FI(13)); SBAR(); \
    PVJ(10,C1,4); VRD2(2,FI(14)); SBAR(); \
    PVJ(11,C1,6); VRD2(3,FI(15)); SBAR(); \
    PVJ(12,C1,8); PVJ(13,C1,10); PVJ(14,C1,12); PVJ(15,C1,14); \
    }while(0)
  #define STEPX(C0,C1,P0,P1,t,GK,GV,GL) do{ if(MODE==2){ STEP2(C0,C1,P0,P1,t,GK,GV,GL); } else { STEP(C0,C1,P0,P1,t,GK,GV,GL); } }while(0)
  int t=1;
  #undef CMASK
  #define CMASK(P0,P1,t) do{}while(0)
  for(;t+5<NT;t+=2){
    STEPX(pB0,pB1,pA0,pA1,t,true,true,true);     WB_A(); GADV(); RESC(); ROT();
    STEPX(pA0,pA1,pB0,pB1,t+1,true,true,true);   WB_A(); GADV(); RESC(); ROT();
  }
  #undef CMASK
  #define CMASK(P0,P1,t) do{int jb_=(t)-(NT-4); if(jb_>=0)cmask<MODE>(P0,P1,jb_,qrel,hi);}while(0)
  #define ENDW(tt) do{ if((tt)+3<NT){WB_A();} else if((tt)+2<NT){WB_B();} else {WAIT_BAR(0);} }while(0)
  for(;t+1<NT;t+=2){
    STEPX(pB0,pB1,pA0,pA1,t,(t+3<NT),(t+1<NT),(t+1<NT));       ENDW(t);   GADV(); RESC(); ROT();
    STEPX(pA0,pA1,pB0,pB1,t+1,(t+4<NT),(t+2<NT),(t+2<NT));     ENDW(t+1); GADV(); RESC(); ROT();
  }
  STEPX(pB0,pB1,pA0,pA1,NT-1,false,false,false); RESC();
  { float sacc=pB0[0]+pB0[1]; _Pragma("unroll") for(int r=2;r<16;++r)sacc+=pB0[r]; _Pragma("unroll") for(int r=0;r<16;++r)sacc+=pB1[r]; l_reg+=sacc;
    pw0=(u32x4){PKW(pB0,0),PKW(pB0,2),PKW(pB0,4),PKW(pB0,6)};pw1=(u32x4){PKW(pB0,8),PKW(pB0,10),PKW(pB0,12),PKW(pB0,14)};pw2=(u32x4){PKW(pB1,0),PKW(pB1,2),PKW(pB1,4),PKW(pB1,6)};pw3=(u32x4){PKW(pB1,8),PKW(pB1,10),PKW(pB1,12),PKW(pB1,14)};
    SBAR(); pv<NDB>(o,vb0+sl_cur*VM,PAF(0),PAF(1),PAF(2),PAF(3)); }
  #undef PKW
  #undef PAF
  #undef VFR
  #undef PIN
  #undef MX3
  #undef GAPA
  #undef GAPB
  #undef EX
  #undef VRD
  #undef KRD
  #undef STEP
  #undef STEP2
  #undef STEPX
  #undef GAPB2
  #undef VRD2
  #undef FI
  #undef PVJ
  #undef PAFS
  #undef ENDW
  {auto rr=__builtin_amdgcn_permlane32_swap(__float_as_uint(l_reg),__float_as_uint(l_reg),false,false);l_reg=__uint_as_float(rr[0])+__uint_as_float(rr[1]);}
  if(MODE!=1) l_reg=__builtin_fmaxf(l_reg-lcorr*__builtin_amdgcn_exp2f(-mhat),1e-30f);
  if(hi==0)wsf[32+r32]=l_reg;asm volatile("s_waitcnt lgkmcnt(0)":::"memory");
  float rli[16];
  #pragma unroll
  for(int r=0;r<16;++r)rli[r]=__builtin_amdgcn_rcpf(wsf[32+crow(r,hi)]);
  bf16*Ow=Oh+(long)(q0+wid*QBLK)*po; const int rlim=LL-(q0+wid*QBLK);
  #pragma unroll
  for(int pp=0;pp<NDB/2;++pp){ bf16*stg=(bf16*)(shm+LOST)+wid*2048;
    #pragma unroll
    for(int r=0;r<16;++r){const int orow=crow(r,hi);
      #pragma unroll
      for(int d0=0;d0<2;++d0)stg[orow*64+d0*32+r32]=(bf16)(cvtpk_s(o[2*pp+d0][r]*rli[r],0.f)&0xffffu);}
    asm volatile("s_waitcnt lgkmcnt(0)":::"memory");
    #pragma unroll
    for(int i=0;i<4;++i){const int row=i*8+(lane>>3),ch=lane&7; const u32x4 v=*(const u32x4*)(stg+row*64+ch*8); if(row<rlim) ATTN_STORE16(Ow+pp*ohalf+(long)row*po+ch*8,v);}
    asm volatile("s_waitcnt lgkmcnt(0)":::"memory"); }
  asm volatile("s_waitcnt lgkmcnt(0)\n\ts_barrier":::"memory");
  #undef GADV
  #undef WB_A
  #undef WB_B
  #undef GMSK
  #undef QX
  #undef GPIN
  #undef NEGM_UPD
  #undef DMA_K
  #undef DMA_V
  #undef CMASK
  #undef START
  #undef RESC
  #undef ROT
}
constexpr int ATTN_LDS_BYTES=LDS_BYTES;
#undef SBAR
#undef WAIT_BAR
}
constexpr int GCH_BYTES = 49152, GCH_UNITS = NB * 4 * (LL / 64);
__device__ __forceinline__ int gch_unit(int b, int h, int n) { return (b * 4 + h) * (LL / 64) + n; }

template <int J> struct FwdRow {
    static constexpr int I0 = J + 1, IA = ((I0 + 3) & ~3) < 64 ? ((I0 + 3) & ~3) : 64, NH = IA - I0, NG = (64 - IA) / 4;
};
template <int J> __device__ __forceinline__ void fwd_load(const LAS float* AT, f32x4 (&v)[16], float (&hd)[3]) {
    using R = FwdRow<J>;
#pragma unroll
    for (int q = 0; q < R::NH; ++q) hd[q] = AT[J * 64 + R::I0 + q];
#pragma unroll
    for (int g = 0; g < R::NG; ++g) v[g] = *(const LAS f32x4*)(AT + J * 64 + R::IA + 4 * g);
}
template <int J> struct FwdSubPK {
    static __device__ __forceinline__ void run(f32x2 (&x)[32], const LAS float* AT) {
        using R = FwdRow<J>;
        f32x4 cur[16]; float curh[3];
        fwd_load<J>(AT, cur, curh);
        __builtin_amdgcn_sched_barrier(0);
        const float xj = x[J >> 1][J & 1]; const f32x2 nxj = {-xj, -xj};
#pragma unroll
        for (int q = 0; q < R::NH; ++q) x[(R::I0 + q) >> 1][(R::I0 + q) & 1] -= curh[q] * xj;
#pragma unroll
        for (int g = 0; g < R::NG; ++g) { x[(R::IA + 4 * g) >> 1] = __builtin_elementwise_fma((f32x2){cur[g][0], cur[g][1]}, nxj, x[(R::IA + 4 * g) >> 1]);
            x[((R::IA + 4 * g) >> 1) + 1] = __builtin_elementwise_fma((f32x2){cur[g][2], cur[g][3]}, nxj, x[((R::IA + 4 * g) >> 1) + 1]); }
        __builtin_amdgcn_sched_barrier(0);
        FwdSubPK<J + 1>::run(x, AT);
    }
};
template <> struct FwdSubPK<63> { static __device__ __forceinline__ void run(f32x2 (&)[32], const LAS float*) {} };
template <int J> struct FwdSubRL {
    static __device__ __forceinline__ void run(float (&x)[64], const LAS float* AT) {
        using R = FwdRow<J>;
        f32x4 cur[16]; float curh[3];
        fwd_load<J>(AT, cur, curh);
        __builtin_amdgcn_sched_barrier(0);
        const float xj = x[J];
#pragma unroll
        for (int q = 0; q < R::NH; ++q) x[R::I0 + q] -= curh[q] * xj;
#pragma unroll
        for (int g = 0; g < R::NG; ++g) { x[R::IA + 4 * g] -= cur[g][0] * xj; x[R::IA + 4 * g + 1] -= cur[g][1] * xj; x[R::IA + 4 * g + 2] -= cur[g][2] * xj; x[R::IA + 4 * g + 3] -= cur[g][3] * xj; }
        __builtin_amdgcn_sched_barrier(0);
        FwdSubRL<J + 1>::run(x, AT);
    }
};
template <> struct FwdSubRL<63> { static __device__ __forceinline__ void run(float (&)[64], const LAS float*) {} };

#define LDS_BAR() asm volatile("s_waitcnt lgkmcnt(0)\n\ts_barrier" ::: "memory")
constexpr int GCU_LDS = (3 * 64 * 68 + 128 + 768) * 4;
#ifndef PREP_ABL
#define PREP_ABL 0
#endif
template <bool PK>
__device__ __forceinline__ void gdn_chunk_unit(const MKP& p, int layer, int b, int h, int n, bool active, LAS unsigned char* ldsU, int t_in, int lane_in, int dump = 0, int shi = 0) {
    int t = t_in, lane = lane_in; asm volatile("" : "+v"(t), "+v"(lane));
    constexpr int KS = 68;
    LAS float* Kt = (LAS float*)ldsU;
    LAS float* Qt = Kt + 64 * KS;
    LAS float* Vt = Qt + 64 * KS;
    LAS float* At = Qt;
    LAS float* sc = Vt + 64 * KS;
    LAS float* cwl = sc + 128;
    const float* cw = p.gdn_conv_w + layer * 4 * 768;
    const size_t r0 = (size_t)b * LP + n * 64;
    unsigned char* ub = (dump ? (unsigned char*)p.act : (unsigned char*)p.gch) + (size_t)gch_unit(b, h, n) * GCH_BYTES;
    bf16_t* gW = (bf16_t*)ub; bf16_t* gQd = gW + 4096; bf16_t* gQK = gQd + 4096; bf16_t* gKdT = gQK + 4096; float* gU = (float*)(ub + 32768);
    LDS_BAR();
    if (active) { for (int q = t; q < 768; q += 256) { const int tp = q / 192, c = q % 192; cwl[q] = cw[tp * 768 + (c >> 6) * 256 + h * 64 + (c & 63)]; } }
    LDS_BAR();
    if (active && !(dump && (PREP_ABL & 1))) {
        float bl = 0.f, al = 0.f;
        if (t < 64) { bl = p.gates[(r0 + t) * 16 + 4 + h]; al = p.gates[(r0 + t) * 16 + 8 + h] + p.gdn_dt_bias[layer * 4 + h]; }
        if constexpr (PK) { u32x4 raw2[2][3][4];
#pragma unroll
        for (int bt = 0; bt < 2; ++bt) {
#pragma unroll
            for (int it = 0; it < 3; ++it) { const int item = (bt * 3 + it) * 256 + t, row = item / 24, vec = item % 24, ch = (vec >> 3) * 256 + h * 64 + (vec & 7) * 8; const bf16_t* pr = p.proj + (r0 + row) * NPJ + P_GQKV + ch;
#pragma unroll
                for (int tp = 0; tp < 4; ++tp) raw2[bt][it][tp] = *(const u32x4*)(pr - (size_t)(3 - tp) * NPJ); }
        }
#pragma unroll
        for (int bt = 0; bt < 2; ++bt) {
#pragma unroll
            for (int it = 0; it < 3; ++it) { const int item = (bt * 3 + it) * 256 + t, row = item / 24, vec = item % 24, part = vec >> 3, d0 = (vec & 7) * 8, ch = part * 256 + h * 64 + d0; float a[8];
#pragma unroll
                for (int e = 0; e < 8; ++e) a[e] = 0.f;
#pragma unroll
                for (int tp = 0; tp < 4; ++tp) { const f32x4 w0 = *(const LAS f32x4*)(cwl + tp * 192 + part * 64 + d0), w1 = *(const LAS f32x4*)(cwl + tp * 192 + part * 64 + d0 + 4); const u32x4 r = raw2[bt][it][tp];
                    a[0] += w0[0] * bflo(r.x); a[1] += w0[1] * bfhi(r.x); a[2] += w0[2] * bflo(r.y); a[3] += w0[3] * bfhi(r.y); a[4] += w1[0] * bflo(r.z); a[5] += w1[1] * bfhi(r.z); a[6] += w1[2] * bflo(r.w); a[7] += w1[3] * bfhi(r.w); }
                float ss = 0.f;
#pragma unroll
                for (int e = 0; e < 8; ++e) { a[e] = a[e] * __builtin_amdgcn_rcpf(1.f + __expf(-a[e])); ss += a[e] * a[e]; }
                ss += __int_as_float(__builtin_amdgcn_update_dpp(0, __float_as_int(ss), 0xB1, 0xf, 0xf, true)); ss += __int_as_float(__builtin_amdgcn_update_dpp(0, __float_as_int(ss), 0x4E, 0xf, 0xf, true));
                ss += __int_as_float(__builtin_amdgcn_update_dpp(0, __float_as_int(ss), 0x141, 0xf, 0xf, true));
                const float rn = part == 2 ? 1.f : rsqrtf(ss + 1e-6f) * (part == 0 ? 0.125f : 1.f);
                LAS float* dst = (part == 0 ? Qt : part == 1 ? Kt : Vt) + row * KS + d0;
                *(LAS f32x4*)dst = (f32x4){a[0] * rn, a[1] * rn, a[2] * rn, a[3] * rn}; *(LAS f32x4*)(dst + 4) = (f32x4){a[4] * rn, a[5] * rn, a[6] * rn, a[7] * rn}; }
        } } else {
#pragma unroll 1
        for (int bt = 0; bt < 2; ++bt) { u32x4 raw[3][4];
#pragma unroll
            for (int it = 0; it < 3; ++it) { const int item = (bt * 3 + it) * 256 + t, row = item / 24, vec = item % 24, ch = (vec >> 3) * 256 + h * 64 + (vec & 7) * 8; const bf16_t* pr = p.proj + (r0 + row) * NPJ + P_GQKV + ch;
#pragma unroll
                for (int tp = 0; tp < 4; ++tp) raw[it][tp] = *(const u32x4*)(pr - (size_t)(3 - tp) * NPJ); }
#pragma unroll
            for (int it = 0; it < 3; ++it) { const int item = (bt * 3 + it) * 256 + t, row = item / 24, vec = item % 24, part = vec >> 3, d0 = (vec & 7) * 8, ch = part * 256 + h * 64 + d0; float a[8];
#pragma unroll
                for (int e = 0; e < 8; ++e) a[e] = 0.f;
#pragma unroll
                for (int tp = 0; tp < 4; ++tp) { const f32x4 w0 = *(const LAS f32x4*)(cwl + tp * 192 + part * 64 + d0), w1 = *(const LAS f32x4*)(cwl + tp * 192 + part * 64 + d0 + 4); const u32x4 r = raw[it][tp];
                    a[0] += w0[0] * bflo(r.x); a[1] += w0[1] * bfhi(r.x); a[2] += w0[2] * bflo(r.y); a[3] += w0[3] * bfhi(r.y); a[4] += w1[0] * bflo(r.z); a[5] += w1[1] * bfhi(r.z); a[6] += w1[2] * bflo(r.w); a[7] += w1[3] * bfhi(r.w); }
                float ss = 0.f;
#pragma unroll
                for (int e = 0; e < 8; ++e) { a[e] = a[e] * __builtin_amdgcn_rcpf(1.f + __expf(-a[e])); ss += a[e] * a[e]; }
                ss += __int_as_float(__builtin_amdgcn_update_dpp(0, __float_as_int(ss), 0xB1, 0xf, 0xf, true)); ss += __int_as_float(__builtin_amdgcn_update_dpp(0, __float_as_int(ss), 0x4E, 0xf, 0xf, true));
                ss += __int_as_float(__builtin_amdgcn_update_dpp(0, __float_as_int(ss), 0x141, 0xf, 0xf, true));
                const float rn = part == 2 ? 1.f : rsqrtf(ss + 1e-6f) * (part == 0 ? 0.125f : 1.f);
                LAS float* dst = (part == 0 ? Qt : part == 1 ? Kt : Vt) + row * KS + d0;
                *(LAS f32x4*)dst = (f32x4){a[0] * rn, a[1] * rn, a[2] * rn, a[3] * rn}; *(LAS f32x4*)(dst + 4) = (f32x4){a[4] * rn, a[5] * rn, a[6] * rn, a[7] * rn}; } }
        }
        if (t < 64) { const float sp = fmaxf(al, 0.f) + __logf(1.f + __expf(-fabsf(al)));
            float gv = -__expf(p.gdn_a_log[layer * 4 + h]) * sp;
            int ll_ = lane; asm volatile("" : "+v"(ll_));
#pragma unroll
            for (int o = 1; o < 64; o <<= 1) { const float t_ = shfl_up_l(gv, o, ll_); if (ll_ >= o) gv += t_; }
            sc[t] = 1.f / (1.f + __expf(-bl)); sc[64 + t] = gv; }
    }
    LDS_BAR();
    float kk[16]; const int gi_ = t & 63, gj0 = (t >> 6) * 16;
    if (active) {
        const float gl = sc[64 + 63];
        if (!(dump && (PREP_ABL & 2))) { const int i = gi_, j0 = gj0; float qk[16]; int zg_ = 0; asm volatile("" : "+v"(zg_));
            if constexpr (PK) {
            f32x2 kk2[16], qk2[16];
#pragma unroll
            for (int jj = 0; jj < 16; ++jj) { kk2[jj] = (f32x2){0.f, 0.f}; qk2[jj] = (f32x2){0.f, 0.f}; }
#pragma unroll 1
            for (int d = 0; d < 64; d += 4) { const f32x4 ki = *(const LAS f32x4*)(Kt + i * KS + d), qi = *(const LAS f32x4*)(Qt + i * KS + d);
                const f32x2 kil = {ki[0], ki[1]}, kih = {ki[2], ki[3]}, qil = {qi[0], qi[1]}, qih = {qi[2], qi[3]};
#pragma unroll
                for (int hb = 0; hb < 2; ++hb) { f32x4 kj[8];
#pragma unroll
                    for (int jj = 0; jj < 8; ++jj) kj[jj] = *(const LAS f32x4*)(Kt + zg_ + (j0 + hb * 8 + jj) * KS + d);
                    __builtin_amdgcn_sched_barrier(0);
#pragma unroll
                    for (int jj = 0; jj < 8; ++jj) { const f32x2 jl = {kj[jj][0], kj[jj][1]}, jh = {kj[jj][2], kj[jj][3]};
                        kk2[hb * 8 + jj] = __builtin_elementwise_fma(kil, jl, kk2[hb * 8 + jj]); kk2[hb * 8 + jj] = __builtin_elementwise_fma(kih, jh, kk2[hb * 8 + jj]);
                        qk2[hb * 8 + jj] = __builtin_elementwise_fma(qil, jl, qk2[hb * 8 + jj]); qk2[hb * 8 + jj] = __builtin_elementwise_fma(qih, jh, qk2[hb * 8 + jj]); }
                    __builtin_amdgcn_sched_barrier(0); } }
#pragma unroll
            for (int jj = 0; jj < 16; ++jj) { kk[jj] = kk2[jj][0] + kk2[jj][1]; qk[jj] = qk2[jj][0] + qk2[jj][1]; }
            } else {
#pragma unroll
            for (int jj = 0; jj < 16; ++jj) { kk[jj] = 0.f; qk[jj] = 0.f; }
#pragma unroll 1
            for (int d = 0; d < 64; d += 4) { const f32x4 ki = *(const LAS f32x4*)(Kt + i * KS + d), qi = *(const LAS f32x4*)(Qt + i * KS + d);
#pragma unroll
                for (int hb = 0; hb < 2; ++hb) { f32x4 kj[8];
#pragma unroll
                    for (int jj = 0; jj < 8; ++jj) kj[jj] = *(const LAS f32x4*)(Kt + zg_ + (j0 + hb * 8 + jj) * KS + d);
                    __builtin_amdgcn_sched_barrier(0);
#pragma unroll
                    for (int jj = 0; jj < 8; ++jj) { kk[hb * 8 + jj] += (ki[0] * kj[jj][0] + ki[1] * kj[jj][1]) + (ki[2] * kj[jj][2] + ki[3] * kj[jj][3]); qk[hb * 8 + jj] += (qi[0] * kj[jj][0] + qi[1] * kj[jj][1]) + (qi[2] * kj[jj][2] + qi[3] * kj[jj][3]); }
                    __builtin_amdgcn_sched_barrier(0); } }
            }
            const float gi = sc[64 + i], bi = sc[i]; unsigned w[8];
#pragma unroll
            for (int jj = 0; jj < 16; ++jj) { const int j = j0 + jj; const float dec = __expf(fminf(gi - sc[64 + j], 0.f));
                kk[jj] = j < i ? bi * kk[jj] * dec : 0.f; qk[jj] = j <= i ? qk[jj] * dec : 0.f; }
#pragma unroll
            for (int jj = 0; jj < 8; ++jj) w[jj] = cvt_pk_bf16(qk[2 * jj], qk[2 * jj + 1]);
            *(u32x4*)(gQK + i * 64 + j0) = (u32x4){w[0], w[1], w[2], w[3]}; *(u32x4*)(gQK + i * 64 + j0 + 8) = (u32x4){w[4], w[5], w[6], w[7]}; }
        if (!(dump && (PREP_ABL & 4))) for (int idx = t; idx < 64 * 32; idx += 256) { const int row = idx >> 5, d = (idx & 31) * 2; const float eg = __expf(sc[64 + row]);
            *(unsigned*)(gQd + row * 64 + d) = cvt_pk_bf16(Qt[row * KS + d] * eg, Qt[row * KS + d + 1] * eg); }
        if (!(dump && (PREP_ABL & 4))) for (int idx = t; idx < 64 * 32; idx += 256) { const int d = idx >> 5, i = (idx & 31) * 2;
            *(unsigned*)(gKdT + d * 64 + i) = cvt_pk_bf16(Kt[i * KS + d] * __expf(gl - sc[64 + i]), Kt[(i + 1) * KS + d] * __expf(gl - sc[64 + i + 1])); }
        if (t == 0) (dump ? (float*)((unsigned char*)p.act + (64u << 20)) : p.gcd)[gch_unit(b, h, n)] = __expf(gl);
    }
    LDS_BAR();
    if (active) {
#pragma unroll
        for (int jj = 0; jj < 16; ++jj) At[(gj0 + jj) * 64 + gi_] = kk[jj];
        if (t < 64) cwl[t] = sc[t] * __expf(sc[64 + t]); }
    LDS_BAR();
    const int ts = shi ? t - 128 : t;
    if (active && ts >= 0 && ts < 128 && !(dump && (PREP_ABL & 8))) { const int c = ts & 63;
        if constexpr (PK) { f32x2 x[32];
            { int zi_ = 0; asm volatile("" : "+v"(zi_));
              const LAS float* src = (ts < 64 ? Vt : Kt) + c; const LAS float* fac = (ts < 64 ? sc : cwl) + zi_;
#pragma unroll
              for (int hh = 0; hh < 2; ++hh) { float xv[32], fv[32];
#pragma unroll
                  for (int i = 0; i < 32; ++i) { xv[i] = src[(32 * hh + i) * KS]; fv[i] = fac[32 * hh + i]; }
                  __builtin_amdgcn_sched_barrier(0);
#pragma unroll
                  for (int i = 0; i < 32; ++i) x[(32 * hh + i) >> 1][i & 1] = xv[i] * fv[i];
                  __builtin_amdgcn_sched_barrier(0); } }
            if (!(dump && (PREP_ABL & 16))) { int z_ = 0; asm volatile("" : "+v"(z_)); FwdSubPK<0>::run(x, At + z_); }
            if (ts < 64) {
#pragma unroll
                for (int i = 0; i < 64; ++i) gU[i * 64 + c] = x[i >> 1][i & 1]; }
            else {
#pragma unroll
                for (int i = 0; i < 64; ++i) gW[i * 64 + c] = (bf16_t)(cvt_pk_bf16(x[i >> 1][i & 1], 0.f) & 0xffffu); }
        } else { float x[64];
#pragma unroll
            for (int i = 0; i < 64; ++i) x[i] = ts < 64 ? sc[i] * Vt[i * KS + c] : sc[i] * __expf(sc[64 + i]) * Kt[i * KS + c];
            { int z_ = 0; asm volatile("" : "+v"(z_)); FwdSubRL<0>::run(x, At + z_); }
            if (ts < 64) {
#pragma unroll
                for (int i = 0; i < 64; ++i) gU[i * 64 + c] = x[i]; }
            else {
#pragma unroll
                for (int i = 0; i < 64; ++i) gW[i * 64 + c] = (bf16_t)(cvt_pk_bf16(x[i], 0.f) & 0xffffu); } } }
}
__device__ __forceinline__ void phase_gdn_chunk_prep(const MKP& p, int layer, int vcu, int G, LAS unsigned char* lds, int tid, int lane, int dump = 0) {
    const int hf = tid >> 8, t = tid & 255; constexpr int NU = NB * 4 * (LL / 64 - 2);
    for (int u0 = vcu * 2; u0 < NU; u0 += G * 2) { const int u = u0 + hf; const bool active = u < NU; const int uu = active ? u : 0;
        const int bh = uu / (LL / 64 - 2), n = 2 + uu % (LL / 64 - 2);
        gdn_chunk_unit<true>(p, layer, bh >> 2, bh & 3, n, active, lds + hf * GCU_LDS, t, lane, dump, hf); }
    __syncthreads();
}

struct ScanG { static constexpr int AMAT = 8192, UOFF = 4 * AMAT, UROW = 272, CDOFF = UOFF + 64 * UROW, STG = CDOFF + 16, PRIV = 2 * STG, SMAT = 2048, NCH = LL / 64; };
__device__ __forceinline__ void gdn_scan_step(const MKP& p, int b, int h, int n, const LAS unsigned char* st, f32x4 (&S)[4], LAS unsigned char* StT, LAS unsigned char* VnT, int wave, int c16, int kg, int a0, int a1, int wb) {
    constexpr int AMAT = ScanG::AMAT, UOFF = ScanG::UOFF, UROW = ScanG::UROW;
    bf16x8 sb[2], wf[4][2], qdf[4][2], qkf[4][2], kdf[4][2]; float uu[16];
    sb[0] = *(const LAS bf16x8*)(StT + a0); sb[1] = *(const LAS bf16x8*)(StT + a1);
#pragma unroll
    for (int rt = 0; rt < 4; ++rt) { wf[rt][0] = *(const LAS bf16x8*)(st + rt * 2048 + a0); wf[rt][1] = *(const LAS bf16x8*)(st + rt * 2048 + a1); }
#pragma unroll
    for (int rt = 0; rt < 4; ++rt)
#pragma unroll
        for (int i = 0; i < 4; ++i) uu[4 * rt + i] = *(const LAS float*)(st + UOFF + (16 * rt + 4 * kg + i) * UROW + (16 * wave + c16) * 4);
    const float cd = *(const LAS float*)(st + ScanG::CDOFF);
#pragma unroll
    for (int rt = 0; rt < 4; ++rt) { qdf[rt][0] = *(const LAS bf16x8*)(st + AMAT + rt * 2048 + a0); qdf[rt][1] = *(const LAS bf16x8*)(st + AMAT + rt * 2048 + a1); }
#pragma unroll
    for (int rt = 0; rt < 4; ++rt) { kdf[rt][0] = *(const LAS bf16x8*)(st + 3 * AMAT + rt * 2048 + a0); kdf[rt][1] = *(const LAS bf16x8*)(st + 3 * AMAT + rt * 2048 + a1); }
#pragma unroll
    for (int rt = 0; rt < 4; ++rt) { qkf[rt][0] = *(const LAS bf16x8*)(st + 2 * AMAT + rt * 2048 + a0); qkf[rt][1] = *(const LAS bf16x8*)(st + 2 * AMAT + rt * 2048 + a1); }
    __builtin_amdgcn_sched_barrier(0);
#pragma unroll
    for (int rt = 0; rt < 4; ++rt) { f32x4 acc = f32x4{0.f, 0.f, 0.f, 0.f};
        acc = __builtin_amdgcn_mfma_f32_16x16x32_bf16(wf[rt][0], sb[0], acc, 0, 0, 0); acc = __builtin_amdgcn_mfma_f32_16x16x32_bf16(wf[rt][1], sb[1], acc, 0, 0, 0);
        *(LAS u32x2*)(VnT + (wb ^ (rt << 5))) = (u32x2){cvt_pk_bf16_m(uu[4 * rt] - acc[0], uu[4 * rt + 1] - acc[1]), cvt_pk_bf16_m(uu[4 * rt + 2] - acc[2], uu[4 * rt + 3] - acc[3])}; }
    asm volatile("s_waitcnt lgkmcnt(0)" ::: "memory");
    bf16x8 vb[2]; vb[0] = *(const LAS bf16x8*)(VnT + a0); vb[1] = *(const LAS bf16x8*)(VnT + a1);
#pragma unroll
    for (int kt = 0; kt < 4; ++kt) { f32x4 acc = S[kt] * cd;
        acc = __builtin_amdgcn_mfma_f32_16x16x32_bf16(kdf[kt][0], vb[0], acc, 0, 0, 0); acc = __builtin_amdgcn_mfma_f32_16x16x32_bf16(kdf[kt][1], vb[1], acc, 0, 0, 0);
        S[kt] = acc;
        *(LAS u32x2*)(StT + (wb ^ (kt << 5))) = (u32x2){cvt_pk_bf16_m(acc[0], acc[1]), cvt_pk_bf16_m(acc[2], acc[3])}; }
    float* og = p.gdn_o + ((size_t)b * LP + (size_t)n * 64) * 256 + h * 64 + 16 * wave + c16;
#pragma unroll
    for (int rt = 0; rt < 4; ++rt) { f32x4 acc = f32x4{0.f, 0.f, 0.f, 0.f};
        acc = __builtin_amdgcn_mfma_f32_16x16x32_bf16(qdf[rt][0], sb[0], acc, 0, 0, 0); acc = __builtin_amdgcn_mfma_f32_16x16x32_bf16(qdf[rt][1], sb[1], acc, 0, 0, 0);
        acc = __builtin_amdgcn_mfma_f32_16x16x32_bf16(qkf[rt][0], vb[0], acc, 0, 0, 0); acc = __builtin_amdgcn_mfma_f32_16x16x32_bf16(qkf[rt][1], vb[1], acc, 0, 0, 0);
#pragma unroll
        for (int i = 0; i < 4; ++i) og[(size_t)(16 * rt + 4 * kg + i) * 256] = acc[i]; }
}
__device__ __forceinline__ void gdn_scan_chunked(const MKP& p, int layer, int b, int h, LAS unsigned char* lds, int tid) {
    gdn_chunk_unit<false>(p, layer, b, h, 1, tid < 256, lds + (tid >> 8) * GCU_LDS, tid & 255, tid & 63);
    asm volatile("s_waitcnt vmcnt(0)" ::: "memory"); __syncthreads();
    constexpr int AMAT = ScanG::AMAT, UOFF = ScanG::UOFF, UROW = ScanG::UROW, STG = ScanG::STG, PRIV = ScanG::PRIV, SMAT = ScanG::SMAT, NCH = ScanG::NCH;
    const int lane = tid & 63, wave = __builtin_amdgcn_readfirstlane(tid >> 6);
    const int unit0 = gch_unit(b, h, 0);
    if (wave < 4) {
        const int c16 = lane & 15, kg = lane >> 4, x7 = c16 & 7;
        const int a0 = c16 * 128 + ((kg ^ x7) << 4), a1 = a0 ^ 64;
        const int wb = c16 * 128 + ((((kg >> 1) ^ x7)) << 4) + (kg & 1) * 8;
        f32x4 S[4];
#pragma unroll
        for (int i = 0; i < 4; ++i) S[i] = f32x4{0.f, 0.f, 0.f, 0.f};
        LAS unsigned char* StT = lds + PRIV + wave * 2 * SMAT; LAS unsigned char* VnT = StT + SMAT;
#pragma unroll
        for (int i = 0; i < 2; ++i) *(LAS u32x4*)(StT + c16 * 128 + kg * 32 + i * 16) = (u32x4){0u, 0u, 0u, 0u};
        __syncthreads();
        for (int n = 1; n < NCH; ++n) {
            gdn_scan_step(p, b, h, n, lds + (n & 1) * STG, S, StT, VnT, wave, c16, kg, a0, a1, wb);
            __syncthreads(); }
    } else {
        const int t2 = tid - 256;
        f32x4 ldA[12], ldB[12]; float cdA = 0.f, cdB = 0.f;
#define SC_LOADX(L_, C_, n_) do { const unsigned char* src_ = (const unsigned char*)p.gch + (size_t)(unit0 + (n_)) * GCH_BYTES; _Pragma("unroll") for (int i = 0; i < 12; ++i) L_[i] = *(const f32x4*)(src_ + (size_t)(i * 256 + t2) * 16); C_ = p.gcd[unit0 + (n_)]; } while (0)
#define SC_STOREX(L_, C_, st_) do { LAS unsigned char* dst_ = lds + (st_) * STG; \
        _Pragma("unroll") for (int i = 0; i < 8; ++i) { const int o16 = i * 256 + t2, row = (o16 >> 3) & 63; *(LAS f32x4*)(dst_ + (o16 >> 9) * AMAT + row * 128 + (((o16 & 7) ^ (row & 7)) << 4)) = L_[i]; } \
        _Pragma("unroll") for (int i = 0; i < 4; ++i) { const int u16 = i * 256 + t2; *(LAS f32x4*)(dst_ + UOFF + (u16 >> 4) * UROW + (u16 & 15) * 16) = L_[8 + i]; } \
        if (t2 == 0) *(LAS float*)(dst_ + ScanG::CDOFF) = C_; } while (0)
        SC_LOADX(ldA, cdA, 1); SC_STOREX(ldA, cdA, 1);
        SC_LOADX(ldA, cdA, 2); SC_LOADX(ldB, cdB, 3);
        __syncthreads();
        for (int n = 1; n < NCH; n += 2) {
            if (n + 1 < NCH) { SC_STOREX(ldA, cdA, 0); if (n + 3 < NCH) SC_LOADX(ldA, cdA, n + 3); }
            __syncthreads();
            if (n + 1 >= NCH) break;
            if (n + 2 < NCH) { SC_STOREX(ldB, cdB, 1); if (n + 4 < NCH) SC_LOADX(ldB, cdB, n + 4); }
            __syncthreads();
        }
#undef SC_LOADX
#undef SC_STOREX
    }
}

__device__ __forceinline__ void gdn_scan_chunked_g(const MKP& p, int b, int h, LAS unsigned char* lds, int tid) {
    typedef float f32x16 __attribute__((ext_vector_type(16)));
    constexpr int AROW = 144, AMAT = 64 * AROW, STG = 4 * AMAT + 16384, PRIV = 2 * STG, SROW = 144, SMAT = 32 * SROW;
    const int lane = tid & 63, wave = __builtin_amdgcn_readfirstlane(tid >> 6), r32 = lane & 31, hi = lane >> 5;
    const int unit0 = gch_unit(b, h, 0);
    f32x4 ld[6]; float cdn = 0.f;
#define SC_LOAD(n_) do { const unsigned char* src_ = (const unsigned char*)p.gch + (size_t)(unit0 + (n_)) * GCH_BYTES; _Pragma("unroll") for (int i = 0; i < 6; ++i) ld[i] = *(const f32x4*)(src_ + (size_t)(i * 512 + tid) * 16); cdn = p.gcd[unit0 + (n_)]; } while (0)
#define SC_STORE(st_) do { LAS unsigned char* dst_ = lds + (st_) * STG; _Pragma("unroll") for (int i = 0; i < 6; ++i) { const int off = (i * 512 + tid) * 16; \
        if (off < 32768) { const int m = off >> 13, wi = off & 8191; *(LAS f32x4*)(dst_ + m * AMAT + (wi >> 7) * AROW + (wi & 127)) = ld[i]; } else *(LAS f32x4*)(dst_ + 4 * AMAT + (off - 32768)) = ld[i]; } } while (0)
    f32x16 S[2]; S[0] = f32x16{}; S[1] = f32x16{};
    LAS unsigned char* StT = lds + PRIV + wave * 2 * SMAT; LAS unsigned char* VnT = StT + SMAT;
    if (wave < 2) {
#pragma unroll
        for (int i = 0; i < 4; ++i) *(LAS u32x4*)(StT + r32 * SROW + hi * 64 + i * 16) = (u32x4){0u, 0u, 0u, 0u};
    }
    __syncthreads();
    for (int n = 1; n < LL / 64; ++n) {
        const int cur = n & 1;
        if (wave < 2) {
            const unsigned char* st = (const unsigned char*)p.gch + (size_t)(unit0 + n) * GCH_BYTES; const unsigned char* Wm = st, *Qdm = st + 8192, *QKm = st + 16384, *KdTm = st + 24576; const float* Um = (const float*)(st + 32768); const float cd = p.gcd[unit0 + n];
            bf16x8 sb[4], vb[4];
#pragma unroll
            for (int s = 0; s < 4; ++s) sb[s] = *(const LAS bf16x8*)(StT + r32 * SROW + (16 * s + 8 * hi) * 2);
#pragma unroll
            for (int ct = 0; ct < 2; ++ct) { f32x16 acc = f32x16{};
#pragma unroll
                for (int s = 0; s < 4; ++s) acc = __builtin_amdgcn_mfma_f32_32x32x16_bf16(*(const bf16x8*)(Wm + (32 * ct + r32) * 128 + (16 * s + 8 * hi) * 2), sb[s], acc, 0, 0, 0);
#pragma unroll
                for (int g4 = 0; g4 < 4; ++g4) { float v4[4];
#pragma unroll
                    for (int i = 0; i < 4; ++i) v4[i] = Um[(32 * ct + 8 * g4 + 4 * hi + i) * 64 + 32 * wave + r32] - acc[4 * g4 + i];
                    *(LAS u32x2*)(VnT + r32 * SROW + (32 * ct + 8 * g4 + 4 * hi) * 2) = (u32x2){cvt_pk_bf16_m(v4[0], v4[1]), cvt_pk_bf16_m(v4[2], v4[3])}; } }
            asm volatile("s_waitcnt lgkmcnt(0)" ::: "memory");
#pragma unroll
            for (int s = 0; s < 4; ++s) vb[s] = *(const LAS bf16x8*)(VnT + r32 * SROW + (16 * s + 8 * hi) * 2);
            float* og = p.gdn_o + ((size_t)b * LP + (size_t)n * 64) * 256 + h * 64 + 32 * wave + r32;
#pragma unroll
            for (int ct = 0; ct < 2; ++ct) { f32x16 acc = f32x16{};
#pragma unroll
                for (int s = 0; s < 4; ++s) acc = __builtin_amdgcn_mfma_f32_32x32x16_bf16(*(const bf16x8*)(Qdm + (32 * ct + r32) * 128 + (16 * s + 8 * hi) * 2), sb[s], acc, 0, 0, 0);
#pragma unroll
                for (int s = 0; s < 4; ++s) acc = __builtin_amdgcn_mfma_f32_32x32x16_bf16(*(const bf16x8*)(QKm + (32 * ct + r32) * 128 + (16 * s + 8 * hi) * 2), vb[s], acc, 0, 0, 0);
#pragma unroll
                for (int r = 0; r < 16; ++r) og[(size_t)(32 * ct + (r & 3) + 8 * (r >> 2) + 4 * hi) * 256] = acc[r]; }
#pragma unroll
            for (int kt = 0; kt < 2; ++kt) { f32x16 acc = S[kt] * cd;
#pragma unroll
                for (int s = 0; s < 4; ++s) acc = __builtin_amdgcn_mfma_f32_32x32x16_bf16(*(const bf16x8*)(KdTm + (32 * kt + r32) * 128 + (16 * s + 8 * hi) * 2), vb[s], acc, 0, 0, 0);
                S[kt] = acc;
#pragma unroll
                for (int g4 = 0; g4 < 4; ++g4) *(LAS u32x2*)(StT + r32 * SROW + (32 * kt + 8 * g4 + 4 * hi) * 2) = (u32x2){cvt_pk_bf16_m(acc[4 * g4], acc[4 * g4 + 1]), cvt_pk_bf16_m(acc[4 * g4 + 2], acc[4 * g4 + 3])}; }
        }
        __syncthreads();
    }
#undef SC_LOAD
#undef SC_STORE
}

#define RB(x) bflo(cvt_pk_bf16((x), 0.f) & 0xffffu)
__device__ __forceinline__ void gdn_scan_simple(const MKP& p, int b, int h, LAS unsigned char* lds, int tid) {
    LAS float* S = (LAS float*)lds;
    LAS float* Vn = S + 4096;
    LAS float* Sn = Vn + 4096;
    for (int i = tid; i < 4096; i += NTHR) S[i] = 0.f;
    __syncthreads();
    for (int n = 1; n < LL / 64; ++n) {
        const unsigned char* ub = (const unsigned char*)p.gch + (size_t)gch_unit(b, h, n) * GCH_BYTES;
        const bf16_t* gW = (const bf16_t*)ub; const bf16_t* gQd = gW + 4096; const bf16_t* gQK = gQd + 4096; const bf16_t* gKdT = gQK + 4096; const float* gU = (const float*)(ub + 32768);
        const float cd = p.gcd[gch_unit(b, h, n)];
        for (int e = tid; e < 4096; e += NTHR) { const int c = e >> 6, v = e & 63; float a = gU[e];
            for (int k = 0; k < 64; ++k) a -= bf2f(gW[c * 64 + k]) * RB(S[k * 64 + v]);
            Vn[e] = RB(a); }
        __syncthreads();
        for (int e = tid; e < 4096; e += NTHR) { const int c = e >> 6, v = e & 63; float a = 0.f;
            for (int k = 0; k < 64; ++k) a += bf2f(gQd[c * 64 + k]) * RB(S[k * 64 + v]) + bf2f(gQK[c * 64 + k]) * Vn[k * 64 + v];
            p.gdn_o[((size_t)b * LP + (size_t)n * 64 + c) * 256 + h * 64 + v] = a;
            float s = cd * S[e];
            for (int cc = 0; cc < 64; ++cc) s += bf2f(gKdT[c * 64 + cc]) * Vn[cc * 64 + v];
            Sn[e] = s; }
        __syncthreads();
        for (int e = tid; e < 4096; e += NTHR) S[e] = Sn[e];
        __syncthreads();
    }
}

constexpr int GSTRIDE = LL + 256;
constexpr int N_ATT_ITEMS = 33 * 24;
constexpr float LOG2E = 1.4426950408889634f;

constexpr int FOX_SEGS = (GSTRIDE + 511) / 512, FOX_WGS = NB * 4 * FOX_SEGS;
__device__ __forceinline__ void fox_seg_scan(const MKP& p, int layer, int bx, LAS unsigned char* lds, int tid, int lane, int wave) {
    if (bx >= FOX_WGS) return;
    const int bh = bx / FOX_SEGS, seg = bx % FOX_SEGS, b = bh >> 2, h = bh & 3, t = seg * 512 + tid; const float fb = p.fox_forget_b[layer * 4 + h];
    volatile LAS float* wt = (volatile LAS float*)(lds + LDS_MISC + 128);
    float ls = 0.f;
    if (t >= NLEAD && t < LL) { const float z = p.gates[((size_t)b * LP + t) * 16 + h] + fb; ls = fminf(z, 0.f) - __logf(1.f + __expf(-fabsf(z))); }
#pragma unroll
    for (int o = 1; o < 64; o <<= 1) { const float u = shfl_up_l(ls, o, lane); if (lane >= o) ls += u; }
    if (lane == 63) wt[wave] = ls;
    __syncthreads();
    float pre = 0.f;
    for (int w = 0; w < wave; ++w) pre += wt[w];
    ls += pre;
    p.fox_loc[(size_t)bh * (FOX_SEGS * 512) + t] = ls;
    if (tid == 511) p.fox_tot[bh * 32 + seg] = ls;
    __syncthreads();
}
__device__ __forceinline__ void fox_finalize(const MKP& p, int layer, int bx, int tid, int lane) {
    if (bx >= FOX_WGS) return;
    const int bh = bx / FOX_SEGS, seg = bx % FOX_SEGS, b = bh >> 2, h = bh & 3, t = seg * 512 + tid;
    float nq = 0.f, nk = 0.f;
    { const int t0 = seg * 512 + (tid & ~63), c = lane & 7; u32x4 wq[8], wk[8];
#pragma unroll
      for (int i = 0; i < 8; ++i) { int row = t0 + 8 * i + (lane >> 3); row = row < LL ? row : LL - 1; const bf16_t* pr = p.proj + ((size_t)b * LP + row) * NPJ + h * 64 + 8 * c;
          wq[i] = *(const u32x4*)(pr + P_FQ); wk[i] = *(const u32x4*)(pr + P_FK); }
      float tot[FOX_SEGS];
#pragma unroll
      for (int s2 = 0; s2 < FOX_SEGS; ++s2) tot[s2] = p.fox_tot[bh * 32 + s2];
      double base = 0.0;
#pragma unroll
      for (int s2 = 0; s2 < FOX_SEGS; ++s2) base += s2 < seg ? (double)tot[s2] : 0.0;
      if (t < GSTRIDE) {
          const float loc = p.fox_loc[(size_t)bh * (FOX_SEGS * 512) + t];
          const float gv = t < NLEAD ? -30000.f : (t < LL ? (float)(-(base + (double)loc) * (double)LOG2E) : 0.f);
          const unsigned p1 = cvt_pk_bf16(gv, 0.f) & 0xffffu; const float r1 = gv - __uint_as_float(p1 << 16);
          const unsigned p2 = cvt_pk_bf16(r1, 0.f) & 0xffffu; const float r2 = r1 - __uint_as_float(p2 << 16);
          const unsigned p3 = cvt_pk_bf16(r2, 0.f) & 0xffffu;
          p.Gk[(size_t)bh * GSTRIDE + t] = (unsigned long long)(p1 | (p2 << 16)) | ((unsigned long long)(p3 | (0x3F80u << 16)) << 32);
          p.Gf[(size_t)bh * GSTRIDE + t] = gv; }
#pragma unroll
      for (int i = 0; i < 8; ++i) { const int row = t0 + 8 * i + (lane >> 3); const u32x4 q4 = wq[i], k4 = wk[i];
          float sq = (bflo(q4.x) * bflo(q4.x) + bfhi(q4.x) * bfhi(q4.x)) + (bflo(q4.y) * bflo(q4.y) + bfhi(q4.y) * bfhi(q4.y)) + (bflo(q4.z) * bflo(q4.z) + bfhi(q4.z) * bfhi(q4.z)) + (bflo(q4.w) * bflo(q4.w) + bfhi(q4.w) * bfhi(q4.w));
          float sk = (bflo(k4.x) * bflo(k4.x) + bfhi(k4.x) * bfhi(k4.x)) + (bflo(k4.y) * bflo(k4.y) + bfhi(k4.y) * bfhi(k4.y)) + (bflo(k4.z) * bflo(k4.z) + bfhi(k4.z) * bfhi(k4.z)) + (bflo(k4.w) * bflo(k4.w) + bfhi(k4.w) * bfhi(k4.w));
          sq += __int_as_float(__builtin_amdgcn_update_dpp(0, __float_as_int(sq), 0xB1, 0xf, 0xf, true)); sk += __int_as_float(__builtin_amdgcn_update_dpp(0, __float_as_int(sk), 0xB1, 0xf, 0xf, true));
          sq += __int_as_float(__builtin_amdgcn_update_dpp(0, __float_as_int(sq), 0x4E, 0xf, 0xf, true)); sk += __int_as_float(__builtin_amdgcn_update_dpp(0, __float_as_int(sk), 0x4E, 0xf, 0xf, true));
          sq += __int_as_float(__builtin_amdgcn_update_dpp(0, __float_as_int(sq), 0x141, 0xf, 0xf, true)); sk += __int_as_float(__builtin_amdgcn_update_dpp(0, __float_as_int(sk), 0x141, 0xf, 0xf, true));
          if (row >= NLEAD && row < LL) { nq = fmaxf(nq, sq); nk = fmaxf(nk, sk); } } }
    nq = wave_max(nq); nk = wave_max(nk);
    if (lane == 0) { unsigned* mx = p.ctl + 3072 + layer * 64 + bh * 2; atomicMax(mx, __float_as_uint(nq)); atomicMax(mx + 1, __float_as_uint(nk)); }
}

__device__ __forceinline__ void phase_mixer_attn(const MKP& p, int layer, int qslot, char* lds_gen, LAS unsigned char* lds, int tid, int bx) {
    if (bx < NB * 4 && qslot < 2) {
        gdn_scan_chunked(p, layer, bx >> 2, bx & 3, lds, tid);
        __syncthreads();
#if PROBE_SUB == 103
        gdn_scan_chunked(p, layer, bx >> 2, bx & 3, lds, tid);
        __syncthreads();
#endif
        }
    volatile LAS int* misc = (volatile LAS int*)(lds + LDS_MISC);
    unsigned* qctr = p.ctl + 1024 + qslot * 64;
    for (;;) {
        if (tid == 0) misc[0] = (int)atomicAdd(qctr, 1u);
        __syncthreads(); const int item = __builtin_amdgcn_readfirstlane(misc[0]); __syncthreads();
        if (item >= N_ATT_ITEMS) break;
        int tid_u = tid; asm volatile("" : "+v"(tid_u));
        const int qb = 32 - item / 24, sub = item % 24;
#ifdef ATT_ABL
        if (qslot >= 2 && ((ATT_ABL & 1) ? sub < 16 : sub >= 16)) continue;
#endif
        if (sub < 16) { const int b = sub >> 3, h = (sub >> 1) & 3, s = sub & 1; const bf16_t* base = p.proj + (size_t)b * LP * NPJ;
            attn_body::attn_unit<2, 8>(qb, base + P_DQ + h * 128 + s * 64, base + P_DK + h * 128 + s * 64, base + P_DV + h * 128,
                                       (qslot >= 2 ? p.act : p.tmpO) + ((size_t)(h * 4 + s * 2) * MP + (size_t)b * LP) * 64, 64, nullptr, (float)NLEAD, lds_gen, tid_u, (long)MP * 64);
        } else { const int f = sub - 16, b = f >> 2, h = f & 3; const bf16_t* base = p.proj + (size_t)b * LP * NPJ;
            int tile0 = 0;
            if (qb > 0) { const unsigned* mx = p.ctl + 3072 + layer * 64 + (b * 4 + h) * 2; const float* gf = p.Gf + (size_t)(b * 4 + h) * GSTRIDE;
                const float thr = gf[qb * 256] - (2.f * sqrtf(__uint_as_float(mx[0]) * __uint_as_float(mx[1])) + 230.f); const int ntf = 4 * qb + 4, ln = tid & 63; int c = 0;
#pragma unroll
                for (int q3 = 0; q3 < 3; ++q3) { const int tt = ln + 64 * q3; const bool sk = tt < ntf - 4 && gf[tt * 64 + 63] < thr; c += __builtin_popcountll(__ballot(sk)); }
                tile0 = c & ~1; }
            attn_body::attn_unit<1, 60>(qb, base + P_FQ + h * 64, base + P_FK + h * 64, base + P_FV + h * 64,
                                        (qslot >= 2 ? p.act + (size_t)32 * MP * 64 : p.mixcat) + (size_t)b * LP * DM + 512 + h * 64, DM, p.Gk + (size_t)(b * 4 + h) * GSTRIDE, 0.f, lds_gen, tid_u, 0, tile0);
        }
    }
}

__device__ __forceinline__ void phase_diff_combine(const MKP& p, int layer, int gw, int ngw, int lane) {
    const float* lv = p.diff_lambda + layer * 256; const float* sg = p.diff_subln_g + layer * 128;
    const float lam_init = 0.8f - 0.6f * __expf(-0.3f * (float)layer);
    const float lam = __expf(wave_sum(lv[lane] * lv[64 + lane])) - __expf(wave_sum(lv[128 + lane] * lv[192 + lane])) + lam_init;
    const float g0 = sg[lane] * (1.f - lam_init), g1 = sg[64 + lane] * (1.f - lam_init); const float ng = p.gdn_norm_g[layer * 64 + lane];
    for (int row = gw; row < MP; row += ngw) { if ((row % LP) < NLEAD) { bf16_t* o = p.mixcat + (size_t)row * DM;
#pragma unroll
            for (int h = 0; h < 4; ++h) { o[h * 128 + lane] = 0; o[h * 128 + 64 + lane] = 0; o[768 + h * 64 + lane] = 0; } } }
    unsigned short a[4][4], na[4][4]; float ov[4], nov[4]; unsigned short zz[4], nzz[4];
#define D2_LOAD(row_, A_, O_, Z_) do { _Pragma("unroll") for (int h = 0; h < 4; ++h) { \
            _Pragma("unroll") for (int k = 0; k < 4; ++k) A_[h][k] = p.tmpO[((size_t)(h * 4 + k) * MP + (row_)) * 64 + lane]; \
            O_[h] = p.gdn_o[(size_t)(row_) * 256 + h * 64 + lane]; Z_[h] = p.proj[(size_t)(row_) * NPJ + P_GZ + h * 64 + lane]; } } while (0)
    int row = gw; while (row < MP && (row % LP) < NLEAD) row += ngw;
    if (row < MP) D2_LOAD(row, a, ov, zz);
    while (row < MP) { bf16_t* o = p.mixcat + (size_t)row * DM;
        int rn = row + ngw; while (rn < MP && (rn % LP) < NLEAD) rn += ngw;
        if (rn < MP) D2_LOAD(rn, na, nov, nzz);
#pragma unroll
        for (int h = 0; h < 4; ++h) { const float o0 = bf2f(a[h][0]) - lam * bf2f(a[h][2]), o1 = bf2f(a[h][1]) - lam * bf2f(a[h][3]);
            const float r = rsqrtf(wave_sum(o0 * o0 + o1 * o1) * (1.f / 128.f) + 1e-5f);
            o[h * 128 + lane] = (bf16_t)(cvt_pk_bf16(o0 * r * g0, 0.f) & 0xffffu); o[h * 128 + 64 + lane] = (bf16_t)(cvt_pk_bf16(o1 * r * g1, 0.f) & 0xffffu);
            const float rr = rsqrtf(wave_sum(ov[h] * ov[h]) * (1.f / 64.f) + 1e-6f); const float z = bf2f(zz[h]);
            o[768 + h * 64 + lane] = (bf16_t)(cvt_pk_bf16(ov[h] * rr * ng * z * __builtin_amdgcn_rcpf(1.f + __expf(-z)), 0.f) & 0xffffu); }
        row = rn;
#pragma unroll
        for (int h = 0; h < 4; ++h) { ov[h] = nov[h]; zz[h] = nzz[h];
#pragma unroll
            for (int k = 0; k < 4; ++k) a[h][k] = na[h][k]; }
    }
#undef D2_LOAD
}

#ifndef PROBE_SUB
#define PROBE_SUB -1
#endif
#ifndef PROBE_NREP
#define PROBE_NREP 1
#endif
constexpr int PH_PER_LAYER = 9, N_PHASES = PROBE_SUB == 100 ? 2 + 2 * PH_PER_LAYER : (PROBE_SUB >= 0 ? 1 + 2 * (PH_PER_LAYER + PROBE_NREP) : 1 + 2 * PH_PER_LAYER);

template <class T> __device__ __forceinline__ T* lnd_global(T* x) { __attribute__((address_space(1))) T* g = (__attribute__((address_space(1))) T*)x; asm volatile("" : "+s"(g)); return (T*)g; }
#define LND(x) x = lnd_global(x)
__global__ void __launch_bounds__(NTHR, 2) mk_fwd(MKP p) {
    extern __shared__ __attribute__((aligned(16))) unsigned char lds_raw[];
    LAS unsigned char* lds0 = (LAS unsigned char*)lds_raw;
    { volatile LAS unsigned* st0 = (volatile LAS unsigned*)(lds0 + LDS_MISC + 64); if (threadIdx.x < 2) st0[threadIdx.x] = 0u; __syncthreads(); }
    XcdBarrier bar = xcd_barrier_post(p.ctl + 4096, (volatile LAS unsigned*)(lds0 + LDS_MISC + 64));
    const int lo = p.ph_lo, hi = p.ph_hi;
    const int wave_s = __builtin_amdgcn_readfirstlane((int)threadIdx.x >> 6);
#ifndef PROBE_SUB
#define PROBE_SUB -1
#endif
    for (int ph = lo; ph < hi; ++ph) {
        bool phase_is0; int layer = 0, sub = 0, rep = 0;
        if (PROBE_SUB == 100) { phase_is0 = ph < 2; if (!phase_is0) { layer = (ph - 2) / PH_PER_LAYER; sub = (ph - 2) % PH_PER_LAYER; } }
        else if (PROBE_SUB >= 0) { phase_is0 = ph == 0; if (!phase_is0) { layer = (ph - 1) / (PH_PER_LAYER + PROBE_NREP); const int s = (ph - 1) % (PH_PER_LAYER + PROBE_NREP); sub = s <= PROBE_SUB ? s : (s <= PROBE_SUB + PROBE_NREP ? PROBE_SUB : s - PROBE_NREP); rep = s > PROBE_SUB && s <= PROBE_SUB + PROBE_NREP; } }
        else { phase_is0 = ph == 0; if (!phase_is0) { layer = (ph - 1) / PH_PER_LAYER; sub = (ph - 1) % PH_PER_LAYER; } }
        int tid, G = gridDim.x, bx = blockIdx.x; asm volatile("v_mbcnt_lo_u32_b32 %0, -1, 0\n\tv_mbcnt_hi_u32_b32 %0, -1, %0" : "=v"(tid)); tid += wave_s * 64; asm volatile("" : "+v"(tid), "+s"(G), "+s"(bx));
        const int vcu = (G % 8 == 0) ? (bx % 8) * (G / 8) + bx / 8 : bx;
        const int ngw = G * NWAVES;
        const int lane = tid & 63, wave = __builtin_amdgcn_readfirstlane(tid >> 6), gw = vcu * NWAVES + wave;
        LAS unsigned char* lds = lds0; asm volatile("" : "+s"(lds));
        MKP q = p;
        if (phase_is0) {
#ifndef NO_P0
            LND(q.w_in); LND(q.w_out); LND(q.w1); LND(q.w2); LND(q.Win_t); LND(q.Wout_t); LND(q.W1_t); LND(q.W2_t); LND(q.wgc);
            float gwv[24]; gate_w_load(q.w_in, gwv, tid);
            if (bx >= 12 && bx < 14) { LND(q.router_w); LND(q.rwT); const int l = bx - 12; const float* rw = q.router_w + (size_t)l * DM * NE; float* dst = q.rwT + (size_t)l * NE * (DM + 4);
                for (int i = tid; i < DM * NE; i += NTHR) { const int k = i >> 5, e = i & 31; dst[e * (DM + 4) + k] = rw[i]; }
                for (int i = tid; i < NE * 4; i += NTHR) dst[(i >> 2) * (DM + 4) + DM + (i & 3)] = 0.f; }
            if (bx < 12) { const float* wl = q.w_in + (size_t)DM * NPROJ; const int col = bx < 4 ? C_FF + bx : (bx < 8 ? C_GB + (bx - 4) : C_GA + (bx - 8)); for (int k = tid; k < DM; k += NTHR) q.wgc[bx * DM + k] = wl[(size_t)k * NPROJ + col]; }
            phase_convert_weights(q, lds, gw, ngw, wave, lane);
#if PROBE_SUB == 101
            __syncthreads(); phase_convert_weights(q, lds, gw, ngw, wave, lane);
#endif
            __syncthreads();
            LND(q.x); LND(q.meta); LND(q.ln_in_g); LND(q.ln_in_b); LND(q.stream); LND(q.actb); LND(q.gates);
            phase_ln_in(q, lds, gw, ngw, tid, lane, gwv);
#endif
        } else {
            if (sub == 0) {
#ifndef NO_S0
                LND(q.fox_forget_b); LND(q.gates); LND(q.fox_loc); LND(q.fox_tot); fox_seg_scan(q, layer, bx, lds, tid, lane, wave);
                LND(q.actb); LND(q.Win_t); LND(q.proj);
                pg8::Gemm g{q.actb, q.Win_t + (size_t)layer * NPJ * DM, DM, 0}; pg8::DenseOrder S; S.init(MP / 256, NPJ / 256, G, bx);
                pg8::EpiStoreBf16 E{q.proj, NPJ, nullptr, 0};
                pg8::gemm_phase<pg8::EpiStoreBf16, pg8::DenseOrder, false>(lds, g, S, E, tid);
                if (bx >= 77) { LND(q.w1); LND(q.W1_t); convert_w1_deferred(q, lds, layer, ((bx - 77) * NWAVES + wave) * W1_Q, wave, lane); }
#endif
            } else if (sub == 1) { LND(q.fox_loc); LND(q.fox_tot); LND(q.Gk); LND(q.Gf); LND(q.proj); LND(q.ctl); if (!rep) fox_finalize(q, layer, bx, tid, lane);
                LND(q.gdn_conv_w); LND(q.gdn_a_log); LND(q.gdn_dt_bias); LND(q.proj); LND(q.gch); LND(q.gcd); LND(q.act); phase_gdn_chunk_prep(q, layer, vcu, G, lds, tid, lane, rep);
            } else if (sub == 2) { LND(q.proj); LND(q.tmpO); LND(q.mixcat); LND(q.Gk); LND(q.Gf); LND(q.ctl); LND(q.act); LND(q.gch); LND(q.gcd); LND(q.gdn_o); LND(q.gdn_conv_w); LND(q.gdn_a_log); LND(q.gdn_dt_bias); LND(q.gates); phase_mixer_attn(q, layer, layer + 2 * rep, (char*)lds_raw, lds, tid, bx);
            } else if (sub == 3) { LND(q.diff_lambda); LND(q.diff_subln_g); LND(q.tmpO); LND(q.mixcat); LND(q.gdn_o); LND(q.gdn_norm_g); LND(q.proj); phase_diff_combine(q, layer, gw, ngw, lane);
            } else if (sub == 4) {
#ifndef NO_S4
                LND(q.mixcat); LND(q.Wout_t); LND(q.stream);
                pg8::Gemm g{q.mixcat, q.Wout_t + (size_t)layer * DM * DM, DM, 0}; pg8::DenseOrder S; S.init(MP / 256, DM / 256, G, bx);
                LND(q.actb); pg8::EpiResid E{(bf16_t*)q.stream, q.actb, DM, DN_ALPHA};
                pg8::gemm_phase<pg8::EpiResid, pg8::DenseOrder, false>(lds, g, S, E, tid);
                if (bx >= 4) { LND(q.w1); LND(q.W1_t); convert_w1_deferred(q, lds, layer, W1_DEFER_A + ((bx - 4) * NWAVES + wave) * W1_Q, wave, lane); }
#endif
            } else if (sub == 5) {
#ifndef NO_S5
                LND(q.rwT); LND(q.router_b); LND(q.cnt); LND(q.stream); LND(q.ln1_g); LND(q.ln1_b); LND(q.actb); LND(q.tok_e); LND(q.tok_pos); LND(q.tok_gate); LND(q.etok);
                LND(q.act); LND(q.gch); phase_ln1_route(q, layer, lds, gw, ngw, tid, lane, rep);
#endif
            } else if (sub == 6) {
#ifndef NO_S6
                LND(q.actb); LND(q.W1_t); LND(q.cnt); LND(q.etok); LND(q.act); LND(q.b1);
                if (layer == 1) {
                    int np = 0; if (lane < NE) np = (q.cnt[lane * CNT_STRIDE] + 255) >> 8; const int P0 = (int)(wave_sum((float)np) + 0.5f);
                    const int idle = (G - moe_last_round_units(8 * P0, G)) + (G - moe_last_round_units(4 * P0, G)), covered = idle * NWAVES * W1_Q;
                    LND(q.w2); LND(q.W2_t); convert_w2_blocks(q, lds, covered + gw, ngw, 1 << 20, wave, lane); __syncthreads(); }
                volatile LAS int* tab = (volatile LAS int*)(lds + LDS_TAB); build_expert_tab(q.cnt + layer * 2048, tab, tid);
                pg8::Gemm g{q.actb, q.W1_t + (size_t)layer * NE * 2 * DE * DM, DM, (size_t)2 * DE * DM};
                pg8::ExpertOrder S{tab, q.cnt + layer * 2048, q.etok, 8, G, bx};
                pg8::EpiSwiglu E{q.act, q.b1 + (size_t)layer * NE * 2 * DE};
                const int P_ = __builtin_amdgcn_readfirstlane(tab[0]);
                pg8::gemm_phase<pg8::EpiSwiglu, pg8::ExpertOrder, true>(lds, g, S, E, tid);
                if (layer == 0) { const int rem = moe_last_round_units(8 * P_, G);
                    if (bx >= rem) { LND(q.w2); LND(q.W2_t); convert_w2_blocks(q, lds, ((bx - rem) * NWAVES + wave) * W1_Q, 1, W1_Q, wave, lane); } }
#endif
            } else if (sub == 7) {
#ifndef NO_S7
                LND(q.act); LND(q.W2_t); LND(q.cnt); LND(q.etok); LND(q.ybuf); LND(q.b2);
                volatile LAS int* tab = (volatile LAS int*)(lds + LDS_TAB); build_expert_tab(q.cnt + layer * 2048, tab, tid);
                pg8::Gemm g{q.act, q.W2_t + (size_t)layer * NE * DM * DE, DE, (size_t)DM * DE};
                pg8::ExpertOrder S{tab, q.cnt + layer * 2048, q.etok, 4, G, bx};
                pg8::EpiStoreBf16 E{q.ybuf, DM, q.b2 + (size_t)layer * NE * DM, DM};
                const int P_ = __builtin_amdgcn_readfirstlane(tab[0]);
                pg8::gemm_phase<pg8::EpiStoreBf16, pg8::ExpertOrder, false>(lds, g, S, E, tid);
                if (layer == 0) { const int idle1 = G - moe_last_round_units(8 * P_, G), rem = moe_last_round_units(4 * P_, G);
                    if (bx >= rem) { LND(q.w2); LND(q.W2_t); convert_w2_blocks(q, lds, ((idle1 + bx - rem) * NWAVES + wave) * W1_Q, 1, W1_Q, wave, lane); } }
#endif
            } else if (sub == 8) {
#ifndef NO_S8
                LND(q.cnt); LND(q.wgc); LND(q.stream); LND(q.tok_e); LND(q.tok_pos); LND(q.tok_gate); LND(q.ybuf); LND(q.ln2_g); LND(q.ln2_b); LND(q.actb); LND(q.gates); LND(q.out);
                LND(q.act); LND(q.gch); phase_combine_ln2(q, layer, lds, gw, ngw, tid, lane, rep);
#endif
            }
        }
        if (ph + 1 < hi) xcd_barrier(bar);
    }
}

__global__ __launch_bounds__(256) void k_proj_to_naive(const bf16_t* __restrict__ proj, const float* __restrict__ gates, float* __restrict__ nproj) {
    const int row = blockIdx.x;
    for (int c = threadIdx.x; c < NPROJ; c += 256) { float v;
        if (c < 2304) { v = bf2f(proj[(size_t)row * NPJ + c]); if (c < 512 || (c >= C_FQ && c < C_FK)) v *= (1.f / QK_C2); }
        else if (c < 2308) v = gates[(size_t)row * 16 + (c - 2304)];
        else if (c < 3076) v = bf2f(proj[(size_t)row * NPJ + P_GQKV + (c - 2308)]);
        else if (c < 3084) v = gates[(size_t)row * 16 + 4 + (c - 3076)];
        else v = bf2f(proj[(size_t)row * NPJ + P_GZ + (c - 3084)]);
        nproj[(size_t)row * NPROJ + c] = v; }
}
__global__ __launch_bounds__(256) void k_gdn_to_fast(const float* __restrict__ nm, bf16_t* __restrict__ m) {
    const int row = blockIdx.x, c = threadIdx.x, t = row % LP; const float v = (t >= 64 && t < LL) ? nm[(size_t)row * DM + 768 + c] : 0.f; m[(size_t)row * DM + 768 + c] = (bf16_t)(cvt_pk_bf16(v, 0.f) & 0xffffu);
}
__global__ __launch_bounds__(256) void k_mixcat_to_fast(const float* __restrict__ nm, bf16_t* __restrict__ m) {
    const size_t i = ((size_t)blockIdx.x * 256 + threadIdx.x) * 2; if (i >= (size_t)MP * DM) return; *(unsigned*)(m + i) = cvt_pk_bf16(nm[i], nm[i + 1]);
}


#ifdef GDN_DEBUG
__global__ __launch_bounds__(256) void k_dbg_cmp(const float* __restrict__ ref, const bf16_t* __restrict__ fast, float* __restrict__ stats) {
    const int row = blockIdx.x, c = threadIdx.x, t = row % LP; if (t < NLEAD) return;
    const int h = c >> 6, tm = t & 63, cls = 3 * h + (tm == 0 ? 0 : tm == 63 ? 1 : 2);
    const float r = ref[(size_t)row * DM + 768 + c], f = bf2f(fast[(size_t)row * DM + 768 + c]);
    float e = wave_sum((r - f) * (r - f)), q = wave_sum(r * r);
    if ((c & 63) == 0) { atomicAdd(&stats[2 * cls], e); atomicAdd(&stats[2 * cls + 1], q); }
}
__global__ void k_dbg_scale(const float* __restrict__ stats, float* __restrict__ out, int n) {
    float worst = 0.f; int wc = -1;
    for (int c = 0; c < 12; ++c) { const float rel = stats[2 * c] / fmaxf(stats[2 * c + 1], 1e-30f); if (rel > worst) { worst = rel; wc = c; } }
    float scale = 1.f;
#if GDN_DEBUG == 1
    if (worst > 1e-3f) scale = 1.f + 0.1f * (float)(wc + 1);
#else
    { const int c = GDN_DEBUG % 100; scale = 1.f + sqrtf(stats[2 * c] / fmaxf(stats[2 * c + 1], 1e-30f)); }
#endif
    for (size_t i = (size_t)blockIdx.x * blockDim.x + threadIdx.x; i < (size_t)n; i += (size_t)gridDim.x * blockDim.x) out[i] *= scale;
}
#endif
struct Bump { char* base; size_t off, cap; void* get(size_t bytes) { off = (off + 255) & ~(size_t)255; void* p = base + off; off += bytes; return p; } };
struct NaiveBufs { float *stream, *proj, *mixcat, *mix, *x1, *tmpA, *cum, *gq, *gk, *gv, *gbeta, *gg, *gate, *act, *y; int *rowmask, *topidx, *pos, *tokslot, *cnt, *offs, *slot_tok; };

static void launch_mk(MKP p, int lo, int hi, int grid, hipStream_t st) {
    p.ph_lo = lo; p.ph_hi = hi; void* args[] = {&p};
    hipError_t e = hipLaunchCooperativeKernel((const void*)mk_fwd, dim3(grid), dim3(NTHR), args, LDS_BYTES, st);
    if (e != hipSuccess) fprintf(stderr, "cooperative launch failed: %s (grid %d)\n", hipGetErrorString(e), grid);
}
static void naive_mixer(void* const* d_in, int layer, NaiveBufs& nb, hipStream_t st) {
    const float* diff_lambda = (const float*)d_in[5]; const float* diff_subln_g = (const float*)d_in[6]; const float* fox_forget_b = (const float*)d_in[7];
    const float* gdn_conv_w = (const float*)d_in[8]; const float* gdn_a_log = (const float*)d_in[9]; const float* gdn_dt_bias = (const float*)d_in[10]; const float* gdn_norm_g = (const float*)d_in[11];
    const float lam_init = 0.8f - 0.6f * expf(-0.3f * (float)layer);
    k_fox_cum<<<NB * 4, 64, 0, st>>>(nb.proj, fox_forget_b + layer * 4, nb.cum);
    k_nattn<<<dim3(LL / 64, 20, NB), 64, 0, st>>>(nb.proj, nb.cum, nb.tmpA, nb.mixcat);
    k_diff_combine<<<(MP * 4 * 64 + 255) / 256, 256, 0, st>>>(nb.tmpA, diff_lambda + layer * 256, diff_subln_g + layer * 128, lam_init, nb.mixcat);
    k_gdn_prep<<<MP, 256, 0, st>>>(nb.proj, gdn_conv_w + layer * 4 * 768, gdn_a_log + layer * 4, gdn_dt_bias + layer * 4, nb.gq, nb.gk, nb.gv, nb.gbeta, nb.gg);
    k_gdn_seq<<<NB * 4, 64, 0, st>>>(nb.gq, nb.gk, nb.gv, nb.gbeta, nb.gg, nb.proj, gdn_norm_g + layer * 64, nb.mixcat);
    k_gdn_gate<<<MP, 256, 0, st>>>(nb.proj, nb.mixcat);
    k_zero_pad_rows<<<(MP * 64 + 255) / 256, 256, 0, st>>>(nb.mixcat);
}

extern "C" void kernel_launch(void* const* d_in, const int* in_sizes, int n_in, void* d_out, int out_size, void* d_ws, size_t ws_size, hipStream_t stream) {
    static int grid = 0;
    if (grid == 0) {
        int dev = 0, cus = 0, per_cu = 0; hipGetDevice(&dev); hipDeviceGetAttribute(&cus, hipDeviceAttributeMultiprocessorCount, dev);
        if (hipFuncSetAttribute((const void*)mk_fwd, hipFuncAttributeMaxDynamicSharedMemorySize, LDS_BYTES) != hipSuccess) fprintf(stderr, "hipFuncSetAttribute failed\n");
        if (hipOccupancyMaxActiveBlocksPerMultiprocessor(&per_cu, (const void*)mk_fwd, NTHR, LDS_BYTES) != hipSuccess || per_cu < 1) { fprintf(stderr, "occupancy query: %d\n", per_cu); per_cu = 1; }
        (void)hipGetLastError();
        grid = cus * 1;
    }
    Bump bp{(char*)d_ws, 0, ws_size};
    MKP p{};
    p.x = (const float*)d_in[0]; p.meta = (const float*)d_in[1]; p.ln_in_g = (const float*)d_in[2]; p.ln_in_b = (const float*)d_in[3]; p.w_in = (const float*)d_in[4];
    p.diff_lambda = (const float*)d_in[5]; p.diff_subln_g = (const float*)d_in[6]; p.fox_forget_b = (const float*)d_in[7]; p.gdn_conv_w = (const float*)d_in[8]; p.gdn_a_log = (const float*)d_in[9];
    p.gdn_dt_bias = (const float*)d_in[10]; p.gdn_norm_g = (const float*)d_in[11]; p.w_out = (const float*)d_in[12]; p.ln1_g = (const float*)d_in[13]; p.ln1_b = (const float*)d_in[14];
    p.router_w = (const float*)d_in[15]; p.router_b = (const float*)d_in[16]; p.w1 = (const float*)d_in[17]; p.b1 = (const float*)d_in[18]; p.w2 = (const float*)d_in[19]; p.b2 = (const float*)d_in[20];
    p.ln2_g = (const float*)d_in[21]; p.ln2_b = (const float*)d_in[22]; p.out = (float*)d_out;
    p.ctl = (unsigned*)bp.get(1 << 20); p.cnt = (int*)(p.ctl + 65536);
    p.Win_t = (bf16_t*)bp.get((size_t)2 * NPJ * DM * 2); p.Wout_t = (bf16_t*)bp.get((size_t)2 * DM * DM * 2);
    p.W1_t = (bf16_t*)bp.get((size_t)2 * NE * 2 * DE * DM * 2); p.W2_t = (bf16_t*)bp.get((size_t)2 * NE * DM * DE * 2);
    p.stream = (float*)bp.get((size_t)MP * DM * 4); p.actb = (bf16_t*)bp.get((size_t)MP * DM * 2); p.proj = (bf16_t*)bp.get((size_t)(MP + 256) * NPJ * 2);
    p.gates = (float*)bp.get((size_t)MP * 16 * 4); p.mixcat = (bf16_t*)bp.get((size_t)MP * DM * 2);
    p.act = (bf16_t*)bp.get((size_t)PMAX * 256 * DE * 2); p.ybuf = (bf16_t*)bp.get((size_t)PMAX * 256 * DM * 2);
    p.tmpO = (bf16_t*)bp.get((size_t)16 * MP * 64 * 2 + 65536); p.Gk = (unsigned long long*)bp.get((size_t)8 * GSTRIDE * 8);
    p.wgc = (float*)bp.get(12 * DM * 4); p.rwT = (float*)bp.get((size_t)2 * NE * (DM + 4) * 4);
    p.Gf = (float*)bp.get((size_t)8 * GSTRIDE * 4);
    p.fox_loc = (float*)bp.get((size_t)8 * 17 * 512 * 4); p.fox_tot = (float*)bp.get(8 * 32 * 4);
    p.gch = (unsigned char*)bp.get((size_t)GCH_UNITS * GCH_BYTES); p.gcd = (float*)bp.get((size_t)GCH_UNITS * 4);
    p.gq = (float*)bp.get((size_t)MP * 256 * 4); p.gk = (float*)bp.get((size_t)MP * 256 * 4); p.gv = (float*)bp.get((size_t)MP * 256 * 4); p.gsc = (float*)bp.get((size_t)MP * 16 * 4); p.gdn_o = (float*)bp.get((size_t)MP * 256 * 4);
    p.etok = (int*)bp.get((size_t)NE * MP * 4); p.tok_e = (int*)bp.get((size_t)MP * 4 * 4); p.tok_pos = (int*)bp.get((size_t)MP * 4 * 4); p.tok_gate = (float*)bp.get((size_t)MP * 4 * 4);
    if (bp.off > ws_size) { fprintf(stderr, "kernel_launch: workspace too small: need %zu have %zu\n", bp.off, ws_size); return; }
    (void)hipMemsetAsync(p.ctl, 0, 1 << 20, stream);
    launch_mk(p, 0, N_PHASES, grid, stream);
#ifdef GDN_DEBUG
    { NaiveBufs nb{}; nb.proj = (float*)bp.get((size_t)MP * NPROJ * 4); nb.mixcat = (float*)bp.get((size_t)MP * DM * 4);
      nb.gq = (float*)bp.get((size_t)MP * 256 * 4); nb.gk = (float*)bp.get((size_t)MP * 256 * 4); nb.gv = (float*)bp.get((size_t)MP * 256 * 4); nb.gbeta = (float*)bp.get((size_t)MP * 4 * 4); nb.gg = (float*)bp.get((size_t)MP * 4 * 4);
      float* stats = (float*)bp.get(256); (void)hipMemsetAsync(stats, 0, 256, stream); const int layer = 1;
      k_proj_to_naive<<<MP, 256, 0, stream>>>(p.proj, p.gates, nb.proj);
      k_gdn_prep<<<MP, 256, 0, stream>>>(nb.proj, (const float*)d_in[8] + layer * 4 * 768, (const float*)d_in[9] + layer * 4, (const float*)d_in[10] + layer * 4, nb.gq, nb.gk, nb.gv, nb.gbeta, nb.gg);
      k_gdn_seq<<<NB * 4, 64, 0, stream>>>(nb.gq, nb.gk, nb.gv, nb.gbeta, nb.gg, nb.proj, (const float*)d_in[11] + layer * 64, nb.mixcat);
      k_gdn_gate<<<MP, 256, 0, stream>>>(nb.proj, nb.mixcat);
      k_dbg_cmp<<<MP, 256, 0, stream>>>(nb.mixcat, p.mixcat, stats);
      k_dbg_scale<<<256, 256, 0, stream>>>(stats, (float*)d_out, out_size); }
#endif
}
```

```cpp
#include <hip/hip_runtime.h>
#include <cstdio>
#include <cstdint>
#include <cmath>

constexpr int NB = 2, SEQ = 8192, DM = 1024, NLEAD = 112, NMETA = 16, LL = 8320;
constexpr int LP = 8320, MP = NB * LP;
constexpr int NPROJ = 3340;
constexpr int C_DQ = 0, C_DK = 512, C_DV = 1024, C_FQ = 1536, C_FK = 1792, C_FV = 2048, C_FF = 2304, C_GQKV = 2308, C_GB = 3076, C_GA = 3080, C_GZ = 3084;
constexpr int NE = 32, TOPK = 4, DE = 1024;
constexpr float DN_ALPHA = 1.4142135623730951f;
constexpr int NSLOT = TOPK * MP;

#define WAVE_RED(OP) \
    v = OP(v, __int_as_float(__builtin_amdgcn_update_dpp(0, __float_as_int(v), 0xB1, 0xf, 0xf, true)));     \
    v = OP(v, __int_as_float(__builtin_amdgcn_update_dpp(0, __float_as_int(v), 0x4E, 0xf, 0xf, true)));     \
    v = OP(v, __int_as_float(__builtin_amdgcn_update_dpp(0, __float_as_int(v), 0x141, 0xf, 0xf, true)));    \
    v = OP(v, __int_as_float(__builtin_amdgcn_update_dpp(0, __float_as_int(v), 0x140, 0xf, 0xf, true)));    \
    v = OP(v, __int_as_float(__builtin_amdgcn_ds_swizzle(__float_as_int(v), 0x401F)));                      \
    { auto rr = __builtin_amdgcn_permlane32_swap(__float_as_uint(v), __float_as_uint(v), false, false); v = OP(__uint_as_float(rr[0]), __uint_as_float(rr[1])); }
__device__ __forceinline__ float wave_sum(float v) {
#define OPADD(a, b) ((a) + (b))
    WAVE_RED(OPADD)
#undef OPADD
    return v;
}
__device__ __forceinline__ float wave_max(float v) {
    WAVE_RED(fmaxf)
    return v;
}
__device__ __forceinline__ float shfl_up_l(float v, int o, int lane) { const float u = __int_as_float(__builtin_amdgcn_ds_bpermute(((lane - o) & 63) << 2, __float_as_int(v))); return u; }
__device__ __forceinline__ int shfl_up_li(int v, int o, int lane) { return __builtin_amdgcn_ds_bpermute(((lane - o) & 63) << 2, v); }
__device__ __forceinline__ float shfl_idx(float v, int idx) { return __int_as_float(__builtin_amdgcn_ds_bpermute(idx << 2, __float_as_int(v))); }
__device__ __forceinline__ bool row_valid(int t) { return t >= NLEAD && t < LL; }

__global__ __launch_bounds__(256) void k_ln_in(const float* __restrict__ x, const float* __restrict__ meta, const float* __restrict__ g, const float* __restrict__ bta, float* __restrict__ stream) {
    const int w = (blockIdx.x * 256 + threadIdx.x) >> 6, lane = threadIdx.x & 63;
    if (w >= NB * LL) return;
    const int b = w / LL, t = w % LL;
    const float* src = nullptr;
    if (t >= NLEAD + NMETA) src = x + ((size_t)b * SEQ + (t - NLEAD - NMETA)) * DM;
    else if (t >= NLEAD) src = meta + (size_t)(t - NLEAD) * DM;
    float4 v[4]; float s = 0.f;
#pragma unroll
    for (int j = 0; j < 4; ++j) { v[j] = src ? ((const float4*)src)[lane + 64 * j] : make_float4(0.f, 0.f, 0.f, 0.f); s += (v[j].x + v[j].y) + (v[j].z + v[j].w); }
    const float mean = wave_sum(s) * (1.f / DM); float q = 0.f;
#pragma unroll
    for (int j = 0; j < 4; ++j) { v[j].x -= mean; v[j].y -= mean; v[j].z -= mean; v[j].w -= mean; q += (v[j].x * v[j].x + v[j].y * v[j].y) + (v[j].z * v[j].z + v[j].w * v[j].w); }
    const float rstd = rsqrtf(wave_sum(q) * (1.f / DM) + 1e-5f);
    float4* o = (float4*)(stream + ((size_t)b * LP + t) * DM);
#pragma unroll
    for (int j = 0; j < 4; ++j) { const float4 gg = ((const float4*)g)[lane + 64 * j], bb = ((const float4*)bta)[lane + 64 * j];
        o[lane + 64 * j] = make_float4(v[j].x * rstd * gg.x + bb.x, v[j].y * rstd * gg.y + bb.y, v[j].z * rstd * gg.z + bb.z, v[j].w * rstd * gg.w + bb.w); }
}

struct NG {
    const float* A; int lda; const int* arow;
    const float* B; int ldb; size_t strideB;
    float* C; int ldc; int M, N, K;
    const int* Mdev; const int* offs;
    const float* bias; int strideBias;
};
template <int MODE> __global__ __launch_bounds__(256) void k_ngemm(NG p) {
    __shared__ float As[16][68]; __shared__ float Bs[16][64]; __shared__ float Bs2[MODE == 1 ? 16 : 1][64];
    const int z = blockIdx.z; const int M = p.Mdev ? p.Mdev[z] : p.M;
    const int m0 = blockIdx.y * 64, n0 = blockIdx.x * 64; if (m0 >= M) return;
    const int rowbase = p.offs ? p.offs[z] : 0;
    const float* B = p.B + (size_t)z * p.strideB;
    const int tid = threadIdx.x, lr = tid >> 2, lk = (tid & 3) * 4;
    const float* ap = nullptr;
    { const int r = m0 + lr; if (r < M) { int idx; if (MODE == 1) idx = p.arow[rowbase + r]; else if (MODE == 2) idx = rowbase + r; else idx = p.arow ? p.arow[r] : r; if (idx >= 0) ap = p.A + (size_t)idx * p.lda; } }
    const int bk = tid >> 4, bn = (tid & 15) * 4; const bool bok = (n0 + bn) < p.N;
    const int tx = tid & 15, ty = tid >> 4;
    float acc[4][4], acc2[4][4];
#pragma unroll
    for (int i = 0; i < 4; ++i)
#pragma unroll
        for (int j = 0; j < 4; ++j) { acc[i][j] = 0.f; acc2[i][j] = 0.f; }
    float4 av = ap ? *(const float4*)(ap + lk) : make_float4(0.f, 0.f, 0.f, 0.f);
    float4 bv = bok ? *(const float4*)(B + (size_t)bk * p.ldb + n0 + bn) : make_float4(0.f, 0.f, 0.f, 0.f);
    float4 bv2 = make_float4(0.f, 0.f, 0.f, 0.f);
    if (MODE == 1) bv2 = *(const float4*)(B + (size_t)bk * p.ldb + DE + n0 + bn);
    for (int k0 = 0; k0 < p.K; k0 += 16) {
        __syncthreads();
        As[lk + 0][lr] = av.x; As[lk + 1][lr] = av.y; As[lk + 2][lr] = av.z; As[lk + 3][lr] = av.w;
        *(float4*)&Bs[bk][bn] = bv; if (MODE == 1) *(float4*)&Bs2[bk][bn] = bv2;
        __syncthreads();
        if (k0 + 16 < p.K) {
            av = ap ? *(const float4*)(ap + k0 + 16 + lk) : make_float4(0.f, 0.f, 0.f, 0.f);
            bv = bok ? *(const float4*)(B + (size_t)(k0 + 16 + bk) * p.ldb + n0 + bn) : make_float4(0.f, 0.f, 0.f, 0.f);
            if (MODE == 1) bv2 = *(const float4*)(B + (size_t)(k0 + 16 + bk) * p.ldb + DE + n0 + bn);
        }
#pragma unroll
        for (int kk = 0; kk < 16; ++kk) {
            const float4 a = *(const float4*)&As[kk][ty * 4]; const float4 b = *(const float4*)&Bs[kk][tx * 4];
            const float aa[4] = {a.x, a.y, a.z, a.w}, bb[4] = {b.x, b.y, b.z, b.w};
#pragma unroll
            for (int i = 0; i < 4; ++i)
#pragma unroll
                for (int j = 0; j < 4; ++j) acc[i][j] += aa[i] * bb[j];
            if (MODE == 1) { const float4 b2 = *(const float4*)&Bs2[kk][tx * 4]; const float b2b[4] = {b2.x, b2.y, b2.z, b2.w};
#pragma unroll
                for (int i = 0; i < 4; ++i)
#pragma unroll
                    for (int j = 0; j < 4; ++j) acc2[i][j] += aa[i] * b2b[j]; }
        }
    }
#pragma unroll
    for (int i = 0; i < 4; ++i) { const int r = m0 + ty * 4 + i; if (r >= M) continue;
#pragma unroll
        for (int j = 0; j < 4; ++j) { const int n = n0 + tx * 4 + j; if (n >= p.N) continue;
            if (MODE == 0) p.C[(size_t)r * p.ldc + n] = acc[i][j];
            else if (MODE == 1) { const float* bs = p.bias + (size_t)z * p.strideBias; float glu = acc[i][j] + bs[n], lin = acc2[i][j] + bs[DE + n];
                glu = fminf(glu, 7.f); lin = fminf(fmaxf(lin, -7.f), 7.f); const float sg = 1.f / (1.f + expf(-1.702f * glu));
                p.C[(size_t)(rowbase + r) * p.ldc + n] = glu * sg * (lin + 1.f); }
            else { const float* bs = p.bias + (size_t)z * p.strideBias; p.C[(size_t)(rowbase + r) * p.ldc + n] = acc[i][j] + bs[n]; } }
    }
}

__global__ void k_rowmask(int* rm) { const int r = blockIdx.x * 256 + threadIdx.x; if (r < MP) rm[r] = row_valid(r % LP) ? r : -1; }

__global__ __launch_bounds__(64) void k_fox_cum(const float* __restrict__ proj, const float* __restrict__ fbias, float* __restrict__ cum) {
    const int b = blockIdx.x >> 2, h = blockIdx.x & 3, lane = threadIdx.x; double base = 0.0; const float fb = fbias[h];
    for (int t0 = 0; t0 < LL; t0 += 64) { const int t = t0 + lane; const float z = proj[((size_t)b * LP + t) * NPROJ + C_FF + h] + fb;
        float ls = fminf(z, 0.f) - log1pf(expf(-fabsf(z)));
#pragma unroll
        for (int o = 1; o < 64; o <<= 1) { const float u = __shfl_up(ls, o); if (lane >= o) ls += u; }
        cum[((size_t)b * 4 + h) * LP + t] = (float)(base + (double)ls); base += (double)__shfl(ls, 63); }
}

__global__ __launch_bounds__(64) void k_nattn(const float* __restrict__ proj, const float* __restrict__ cum, float* __restrict__ tmpA, float* __restrict__ mixcat) {
    __shared__ float Ks[64][64]; __shared__ float Vs[64][64];
    const int c = blockIdx.x, job = blockIdx.y, b = blockIdx.z, lane = threadIdx.x;
    int qcol, kcol, vcol, mode; float* out; int old; const float* cm = nullptr;
    if (job < 16) { const int h = job >> 2, s = (job >> 1) & 1, half = job & 1; qcol = C_DQ + h * 128 + s * 64; kcol = C_DK + h * 128 + s * 64; vcol = C_DV + h * 128 + half * 64; mode = 0;
        out = tmpA + (size_t)job * MP * 64; old = 64; }
    else { const int h = job - 16; qcol = C_FQ + h * 64; kcol = C_FK + h * 64; vcol = C_FV + h * 64; mode = 1; out = mixcat + 512 + h * 64; old = DM; cm = cum + ((size_t)b * 4 + h) * LP; }
    const int t = c * 64 + lane; const size_t row = (size_t)b * LP + t;
    float q[64], o[64];
#pragma unroll
    for (int d = 0; d < 64; d += 4) { const float4 v = *(const float4*)(proj + row * NPROJ + qcol + d); q[d] = v.x * 0.125f; q[d + 1] = v.y * 0.125f; q[d + 2] = v.z * 0.125f; q[d + 3] = v.w * 0.125f; }
#pragma unroll
    for (int d = 0; d < 64; ++d) o[d] = 0.f;
    float m = -1e30f, l = 0.f; const float cq = cm ? cm[t] : 0.f;
    for (int j = 1; j <= c; ++j) {
        __syncthreads();
        for (int it = 0; it < 16; ++it) { const int rr = it * 4 + (lane >> 4), cc = (lane & 15) * 4; const size_t kr = ((size_t)b * LP + j * 64 + rr) * NPROJ;
            *(float4*)&Ks[rr][cc] = *(const float4*)(proj + kr + kcol + cc); *(float4*)&Vs[rr][cc] = *(const float4*)(proj + kr + vcol + cc); }
        __syncthreads();
        for (int kk = 0; kk < 64; ++kk) { const int kt = j * 64 + kk; if (kt < NLEAD) continue; if (mode == 1 && kt > t) continue;
            float s = 0.f;
#pragma unroll
            for (int d = 0; d < 64; d += 4) { const float4 kv = *(const float4*)&Ks[kk][d]; s += q[d] * kv.x + q[d + 1] * kv.y + q[d + 2] * kv.z + q[d + 3] * kv.w; }
            if (mode == 1) s += cq - cm[kt];
            if (s > m) { const float corr = expf(m - s); l *= corr;
#pragma unroll
                for (int d = 0; d < 64; ++d) o[d] *= corr;
                m = s; }
            const float pp = expf(s - m); l += pp;
#pragma unroll
            for (int d = 0; d < 64; d += 4) { const float4 vv = *(const float4*)&Vs[kk][d]; o[d] += pp * vv.x; o[d + 1] += pp * vv.y; o[d + 2] += pp * vv.z; o[d + 3] += pp * vv.w; }
        }
    }
    const float inv = (l > 0.f && t >= NLEAD) ? 1.f / l : 0.f;
#pragma unroll
    for (int d = 0; d < 64; d += 4) *(float4*)(out + row * old + d) = make_float4(o[d] * inv, o[d + 1] * inv, o[d + 2] * inv, o[d + 3] * inv);
}

__global__ __launch_bounds__(256) void k_diff_combine(const float* __restrict__ tmpA, const float* __restrict__ lamv, const float* __restrict__ subg, float lam_init, float* __restrict__ mixcat) {
    const int w = (blockIdx.x * 256 + threadIdx.x) >> 6, lane = threadIdx.x & 63; if (w >= MP * 4) return;
    const int row = w >> 2, h = w & 3; const int t = row % LP;
    float d01 = lamv[lane] * lamv[64 + lane], d23 = lamv[128 + lane] * lamv[192 + lane];
    const float lam = expf(wave_sum(d01)) - expf(wave_sum(d23)) + lam_init;
    float o0 = 0.f, o1 = 0.f;
    if (t < LL) {
        const float a1lo = tmpA[((size_t)(h * 4 + 0) * MP + row) * 64 + lane], a1hi = tmpA[((size_t)(h * 4 + 1) * MP + row) * 64 + lane];
        const float a2lo = tmpA[((size_t)(h * 4 + 2) * MP + row) * 64 + lane], a2hi = tmpA[((size_t)(h * 4 + 3) * MP + row) * 64 + lane];
        o0 = a1lo - lam * a2lo; o1 = a1hi - lam * a2hi;
    }
    const float ms = wave_sum(o0 * o0 + o1 * o1) * (1.f / 128.f); const float r = rsqrtf(ms + 1e-5f) * (1.f - lam_init);
    mixcat[(size_t)row * DM + h * 128 + lane] = o0 * r * subg[lane]; mixcat[(size_t)row * DM + h * 128 + 64 + lane] = o1 * r * subg[64 + lane];
}

__global__ __launch_bounds__(256) void k_gdn_prep(const float* __restrict__ proj, const float* __restrict__ convw, const float* __restrict__ a_log, const float* __restrict__ dt_bias,
                                                  float* __restrict__ gq, float* __restrict__ gk, float* __restrict__ gv, float* __restrict__ gbeta, float* __restrict__ gg) {
    const int row = blockIdx.x, b = row / LP, t = row % LP, tid = threadIdx.x, h = tid >> 6;
    float val[3];
#pragma unroll
    for (int part = 0; part < 3; ++part) { const int ch = part * 256 + tid; float a = 0.f;
#pragma unroll
        for (int i = 0; i < 4; ++i) { const int tt = t - 3 + i; if (tt >= 0 && tt < LL) a += convw[i * 768 + ch] * proj[((size_t)b * LP + tt) * NPROJ + C_GQKV + ch]; }
        val[part] = a / (1.f + expf(-a)); }
    const float qn = rsqrtf(wave_sum(val[0] * val[0]) + 1e-6f) * 0.125f, kn = rsqrtf(wave_sum(val[1] * val[1]) + 1e-6f);
    gq[(size_t)row * 256 + tid] = val[0] * qn; gk[(size_t)row * 256 + tid] = val[1] * kn; gv[(size_t)row * 256 + tid] = val[2];
    if ((tid & 63) == 0) { const float bl = proj[(size_t)row * NPROJ + C_GB + h], al = proj[(size_t)row * NPROJ + C_GA + h] + dt_bias[h];
        const float sp = fmaxf(al, 0.f) + log1pf(expf(-fabsf(al)));
        gbeta[(size_t)row * 4 + h] = 1.f / (1.f + expf(-bl)); gg[(size_t)row * 4 + h] = -expf(a_log[h]) * sp; }
}
__global__ __launch_bounds__(64) void k_gdn_seq(const float* __restrict__ gq, const float* __restrict__ gk, const float* __restrict__ gv, const float* __restrict__ gbeta, const float* __restrict__ gg,
                                                const float* __restrict__ proj, const float* __restrict__ normg, float* __restrict__ mixcat) {
    __shared__ float Kt[64][64]; __shared__ float Qt[64][64]; __shared__ float Vt[64][64]; __shared__ float bg[64][2];
    const int b = blockIdx.x >> 2, h = blockIdx.x & 3, j = threadIdx.x;
    float S[64];
#pragma unroll
    for (int i = 0; i < 64; ++i) S[i] = 0.f;
    const float ng = normg[j];
    for (int c = 1; c < LL / 64; ++c) {
        __syncthreads();
        for (int it = 0; it < 16; ++it) { const int rr = it * 4 + (j >> 4), cc = (j & 15) * 4; const size_t r = (size_t)b * LP + c * 64 + rr;
            *(float4*)&Kt[rr][cc] = *(const float4*)(gk + r * 256 + h * 64 + cc); *(float4*)&Qt[rr][cc] = *(const float4*)(gq + r * 256 + h * 64 + cc); *(float4*)&Vt[rr][cc] = *(const float4*)(gv + r * 256 + h * 64 + cc); }
        { const size_t r = (size_t)b * LP + c * 64 + j; bg[j][0] = gbeta[r * 4 + h]; bg[j][1] = expf(gg[r * 4 + h]); }
        __syncthreads();
        for (int tt = 0; tt < 64; ++tt) { const size_t r = (size_t)b * LP + c * 64 + tt;
            const float vj = Vt[tt][j];
            const float beta = bg[tt][0], dec = bg[tt][1]; float rr = 0.f;
#pragma unroll
            for (int i = 0; i < 64; i += 4) { const float4 kv = *(const float4*)&Kt[tt][i]; S[i] *= dec; S[i + 1] *= dec; S[i + 2] *= dec; S[i + 3] *= dec;
                rr += S[i] * kv.x + S[i + 1] * kv.y + S[i + 2] * kv.z + S[i + 3] * kv.w; }
            const float coef = beta * (vj - rr); float oj = 0.f;
#pragma unroll
            for (int i = 0; i < 64; i += 4) { const float4 kv = *(const float4*)&Kt[tt][i]; const float4 qv = *(const float4*)&Qt[tt][i];
                S[i] += coef * kv.x; S[i + 1] += coef * kv.y; S[i + 2] += coef * kv.z; S[i + 3] += coef * kv.w;
                oj += S[i] * qv.x + S[i + 1] * qv.y + S[i + 2] * qv.z + S[i + 3] * qv.w; }
            const float ms = wave_sum(oj * oj) * (1.f / 64.f);
            mixcat[r * DM + 768 + h * 64 + j] = oj * rsqrtf(ms + 1e-6f) * ng;
        }
    }
}
__global__ __launch_bounds__(256) void k_gdn_gate(const float* __restrict__ proj, float* __restrict__ mixcat) {
    const int row = blockIdx.x, c = threadIdx.x; const int t = row % LP; if (t < 64 || t >= LL) return;
    const float z = proj[(size_t)row * NPROJ + C_GZ + c]; mixcat[(size_t)row * DM + 768 + c] *= z / (1.f + expf(-z));
}
__global__ __launch_bounds__(256) void k_zero_pad_rows(float* __restrict__ buf) {
    const int w = (blockIdx.x * 256 + threadIdx.x) >> 6, lane = threadIdx.x & 63; if (w >= MP) return; const int t = w % LP; if (t >= 64 && t < LL) return;
    float4* o = (float4*)(buf + (size_t)w * DM);
#pragma unroll
    for (int j = 0; j < 4; ++j) o[lane + 64 * j] = make_float4(0.f, 0.f, 0.f, 0.f);
}

__global__ __launch_bounds__(256) void k_ln1_route(const float* __restrict__ stream, const float* __restrict__ mix, const float* __restrict__ g, const float* __restrict__ bta,
                                                   const float* __restrict__ rw, const float* __restrict__ rb, float* __restrict__ x1, int* __restrict__ topidx, float* __restrict__ gate, int* __restrict__ pos, int* __restrict__ cnt) {
    __shared__ float xs[4][DM];
    const int wv = threadIdx.x >> 6, row = blockIdx.x * 4 + wv, lane = threadIdx.x & 63; if (row >= MP) return; const int t = row % LP;
    float4* o = (float4*)(x1 + (size_t)row * DM);
    if (!row_valid(t)) {
#pragma unroll
        for (int j = 0; j < 4; ++j) o[lane + 64 * j] = make_float4(0.f, 0.f, 0.f, 0.f);
        return; }
    float4 v[4]; float s = 0.f;
#pragma unroll
    for (int j = 0; j < 4; ++j) { const float4 a = ((const float4*)(stream + (size_t)row * DM))[lane + 64 * j], m = ((const float4*)(mix + (size_t)row * DM))[lane + 64 * j];
        v[j] = make_float4(DN_ALPHA * a.x + m.x, DN_ALPHA * a.y + m.y, DN_ALPHA * a.z + m.z, DN_ALPHA * a.w + m.w); s += (v[j].x + v[j].y) + (v[j].z + v[j].w); }
    const float mean = wave_sum(s) * (1.f / DM); float q = 0.f;
#pragma unroll
    for (int j = 0; j < 4; ++j) { v[j].x -= mean; v[j].y -= mean; v[j].z -= mean; v[j].w -= mean; q += (v[j].x * v[j].x + v[j].y * v[j].y) + (v[j].z * v[j].z + v[j].w * v[j].w); }
    const float rstd = rsqrtf(wave_sum(q) * (1.f / DM) + 1e-5f);
#pragma unroll
    for (int j = 0; j < 4; ++j) { const float4 gg = ((const float4*)g)[lane + 64 * j], bb = ((const float4*)bta)[lane + 64 * j];
        const float4 r = make_float4(v[j].x * rstd * gg.x + bb.x, v[j].y * rstd * gg.y + bb.y, v[j].z * rstd * gg.z + bb.z, v[j].w * rstd * gg.w + bb.w);
        o[lane + 64 * j] = r; *(float4*)&xs[wv][(lane + 64 * j) * 4] = r; }
    asm volatile("s_waitcnt lgkmcnt(0)" ::: "memory");
    const int e = lane & 31, half = lane >> 5; float acc = 0.f;
    for (int k = half * 512; k < half * 512 + 512; ++k) acc += xs[wv][k] * rw[(size_t)k * NE + e];
    acc += __shfl_xor(acc, 32); acc += rb[e];
    float val = acc; float tv[4]; int ti[4];
#pragma unroll
    for (int k = 0; k < 4; ++k) { const float mx = wave_max(val); const unsigned long long bal = __ballot(val == mx); const int win = (int)(__ffsll((long long)(bal & 0xffffffffull)) - 1);
        tv[k] = mx; ti[k] = win; if (e == win) val = -INFINITY; }
    const float e0 = 1.f, e1 = expf(tv[1] - tv[0]), e2 = expf(tv[2] - tv[0]), e3 = expf(tv[3] - tv[0]); const float inv = 1.f / (e0 + e1 + e2 + e3);
    if (lane < 4) { const float gt = (lane == 0 ? e0 : lane == 1 ? e1 : lane == 2 ? e2 : e3) * inv; const int ex = lane == 0 ? ti[0] : lane == 1 ? ti[1] : lane == 2 ? ti[2] : ti[3];
        topidx[(size_t)row * 4 + lane] = ex; gate[(size_t)row * 4 + lane] = gt; pos[(size_t)row * 4 + lane] = atomicAdd(&cnt[ex], 1); }
}
__global__ void k_offsets(const int* __restrict__ cnt, int* __restrict__ offs) { if (threadIdx.x == 0) { int a = 0; for (int e = 0; e < NE; ++e) { offs[e] = a; a += cnt[e]; } offs[NE] = a; } }
__global__ void k_fill_slots(const int* __restrict__ topidx, const int* __restrict__ pos, const int* __restrict__ offs, int* __restrict__ slot_tok, int* __restrict__ tokslot) {
    const int i = blockIdx.x * 256 + threadIdx.x; if (i >= MP * 4) return; const int row = i >> 2; if (!row_valid(row % LP)) return;
    const int s = offs[topidx[i]] + pos[i]; slot_tok[s] = row; tokslot[i] = s;
}
__global__ __launch_bounds__(256) void k_combine_ln2(const float* __restrict__ x1, const float* __restrict__ y, const int* __restrict__ tokslot, const float* __restrict__ gate,
                                                     const float* __restrict__ g, const float* __restrict__ bta, float* __restrict__ stream, float* __restrict__ out) {
    const int row = (blockIdx.x * 256 + threadIdx.x) >> 6, lane = threadIdx.x & 63; if (row >= MP) return; const int t = row % LP, b = row / LP;
    float4* o = (float4*)(stream + (size_t)row * DM);
    if (!row_valid(t)) {
#pragma unroll
        for (int j = 0; j < 4; ++j) o[lane + 64 * j] = make_float4(0.f, 0.f, 0.f, 0.f);
        return; }
    float4 v[4];
#pragma unroll
    for (int j = 0; j < 4; ++j) { const float4 a = ((const float4*)(x1 + (size_t)row * DM))[lane + 64 * j]; v[j] = make_float4(DN_ALPHA * a.x, DN_ALPHA * a.y, DN_ALPHA * a.z, DN_ALPHA * a.w); }
    for (int k = 0; k < 4; ++k) { const int s = tokslot[(size_t)row * 4 + k]; const float gt = gate[(size_t)row * 4 + k];
#pragma unroll
        for (int j = 0; j < 4; ++j) { const float4 a = ((const float4*)(y + (size_t)s * DM))[lane + 64 * j]; v[j].x += gt * a.x; v[j].y += gt * a.y; v[j].z += gt * a.z; v[j].w += gt * a.w; } }
    float s = 0.f;
#pragma unroll
    for (int j = 0; j < 4; ++j) s += (v[j].x + v[j].y) + (v[j].z + v[j].w);
    const float mean = wave_sum(s) * (1.f / DM); float q = 0.f;
#pragma unroll
    for (int j = 0; j < 4; ++j) { v[j].x -= mean; v[j].y -= mean; v[j].z -= mean; v[j].w -= mean; q += (v[j].x * v[j].x + v[j].y * v[j].y) + (v[j].z * v[j].z + v[j].w * v[j].w); }
    const float rstd = rsqrtf(wave_sum(q) * (1.f / DM) + 1e-5f);
    float4* oo = (out && t >= NLEAD + NMETA) ? (float4*)(out + ((size_t)b * SEQ + (t - NLEAD - NMETA)) * DM) : nullptr;
#pragma unroll
    for (int j = 0; j < 4; ++j) { const float4 gg = ((const float4*)g)[lane + 64 * j], bb = ((const float4*)bta)[lane + 64 * j];
        const float4 r = make_float4(v[j].x * rstd * gg.x + bb.x, v[j].y * rstd * gg.y + bb.y, v[j].z * rstd * gg.z + bb.z, v[j].w * rstd * gg.w + bb.w);
        o[lane + 64 * j] = r; if (oo) oo[lane + 64 * j] = r; }
}

#define LAS __attribute__((address_space(3)))
#define GAS __attribute__((address_space(1)))
typedef unsigned short bf16_t;
typedef short bf16x8 __attribute__((ext_vector_type(8)));
typedef float f32x4 __attribute__((ext_vector_type(4)));
typedef float f32x2 __attribute__((ext_vector_type(2)));
typedef unsigned u32x4 __attribute__((ext_vector_type(4)));
typedef unsigned u32x2 __attribute__((ext_vector_type(2)));

constexpr int NPJ = 3328;
constexpr int P_DQ = 0, P_DK = 512, P_DV = 1024, P_FQ = 1536, P_FK = 1792, P_FV = 2048, P_GQKV = 2304, P_GZ = 3072;
constexpr float QK_C2 = 0.125f * 1.4426950408889634f;
constexpr int NWAVES = 8, NTHR = 512;
constexpr int PMAX = 320;
constexpr int FILL_ROW = NLEAD;

__device__ __forceinline__ unsigned cvt_pk_bf16(float lo, float hi) { unsigned r; asm volatile("v_cvt_pk_bf16_f32 %0, %1, %2" : "=v"(r) : "v"(lo), "v"(hi)); return r; }
typedef __bf16 bf16x2_nat __attribute__((ext_vector_type(2)));
__device__ __forceinline__ unsigned cvt_pk_bf16_m(float lo, float hi) { const f32x2 v = {lo, hi}; const bf16x2_nat b = __builtin_convertvector(v, bf16x2_nat); return __builtin_bit_cast(unsigned, b); }
__device__ __forceinline__ float bf2f(unsigned short h) { return __uint_as_float((unsigned)h << 16); }
__device__ __forceinline__ float bflo(unsigned w) { return __uint_as_float(w << 16); }
__device__ __forceinline__ float bfhi(unsigned w) { return __uint_as_float(w & 0xffff0000u); }

namespace pg8 {
constexpr int BM = 256, BK = 64, HALF = 128, HTB = HALF * BK * 2, STAGE_BYTES = 8 * HTB;
__host__ __device__ __forceinline__ int lds_byte(int r, int c) { const int st = (r >> 4) * 2 + (c >> 5), rr = r & 15, cc = c & 31, ob = rr * 64 + cc * 2; return st * 1024 + (ob ^ (((ob >> 9) & 1) << 5)); }
__host__ __device__ __forceinline__ void stage_rc(int b, int& R, int& C) { const int st = b / 1024, sb = b % 1024, swz = sb ^ (((sb >> 9) & 1) << 5); R = (st >> 1) * 16 + swz / 64; C = (st & 1) * 32 + (swz % 64) / 2; }
__host__ __device__ __forceinline__ int perm32(int rho) { const int n = rho >> 4, i = rho & 15; return 8 * (i >> 2) + 4 * n + (i & 3); }

struct Unit { int pm, pn, e; };
struct Gemm { const bf16_t* A; const bf16_t* Bt; int K; size_t bstride_e; };

struct DenseOrder {
    int nM, nN, nwg, G, c;
    __device__ void init(int nM_, int nN_, int G_, int c_) { nM = nM_; nN = nN_; nwg = nM * nN; G = G_; c = c_; }
    __device__ bool next(int i, Unit& u) const {
        const long L = (long)i * G + c; if (L >= nwg) return false;
        int wgid = (int)L; { const int q = nwg / 8, r = nwg % 8, xcd = wgid % 8, off = wgid / 8; wgid = (xcd < r ? xcd * (q + 1) : r * (q + 1) + (xcd - r) * q) + off; }
        const int nig = 8 * nN, gid = wgid / nig, fm = gid * 8, gsz = (nM - fm) < 8 ? (nM - fm) : 8;
        u.pm = fm + ((wgid % nig) % gsz); u.pn = (wgid % nig) / gsz; u.e = 0; return true;
    }
    __device__ void rows(const Unit&, const int*& list, int& nvalid) const { list = nullptr; nvalid = 0; }
};
struct ExpertOrder {
    const volatile LAS int* tab;
    const int* cnt; const int* etok; int nN, G, c;
    __device__ bool next(int i, Unit& u) const {
        const int P = __builtin_amdgcn_readfirstlane(tab[0]);
        if (G % (8 * nN) == 0) { const int ppx = G / (8 * nN), j = c >> 3; u.pm = i * (G / nN) + (c & 7) * ppx + j / nN; u.pn = j % nN; if (u.pm >= P) return false; }
        else { const int L = i * G + c; if (L >= P * nN) return false; u.pm = L / nN; u.pn = L % nN; }
        u.e = __builtin_amdgcn_readfirstlane(tab[40 + u.pm]); return true;
    }
    __device__ int idle_rank(int P) const {
        if (G % (8 * nN) != 0) { const int n = P * nN, rem = n - ((n + G - 1) / G - 1) * G; return c >= rem ? c - rem : -1; }
        const int ppr = G / nN, ilast = (P - 1) / ppr, t = P - ilast * ppr, ppx = G / (8 * nN), j = c >> 3, s_ = (c & 7) * ppx + j / nN;
        return s_ >= t ? (s_ - t) * nN + j % nN : -1;
    }
    __device__ void rows(const Unit& u, const int*& list, int& nvalid) const {
        const int lt = u.pm - __builtin_amdgcn_readfirstlane(tab[1 + u.e]); list = etok + (size_t)u.e * MP + lt * 256; int nv = __builtin_amdgcn_readfirstlane(cnt[u.e * 32]) - lt * 256; nvalid = nv > 256 ? 256 : nv;
    }
};

struct EpiStoreBf16 {
    static constexpr bool PERM = true;
    bf16_t* O; int ldc; const float* bias; int bias_stride;
    __device__ __forceinline__ void operator()(const f32x4 (&acc)[2][2][4][2], const Unit& u, int wr, int wc, int fr, int fq) const {
        const int row0 = u.pm * BM + wr * 64 + fr, col0 = u.pn * BM + wc * 32 + 8 * fq;
        f32x4 bv[2][2];
#pragma unroll
        for (int bj = 0; bj < 2; ++bj)
#pragma unroll
            for (int n = 0; n < 2; ++n) bv[bj][n] = bias ? *(const f32x4*)(bias + (size_t)u.e * bias_stride + col0 + bj * HALF + 4 * n) : (f32x4){0.f, 0.f, 0.f, 0.f};
#pragma unroll
        for (int ai = 0; ai < 2; ++ai)
#pragma unroll
            for (int m = 0; m < 4; ++m) { bf16_t* rowp = O + (size_t)(row0 + ai * HALF + m * 16) * ldc + col0;
#pragma unroll
                for (int bj = 0; bj < 2; ++bj) { const f32x4 v0 = acc[ai][bj][m][0] + bv[bj][0], v1 = acc[ai][bj][m][1] + bv[bj][1];
                    u32x4 w; w.x = cvt_pk_bf16(v0[0], v0[1]); w.y = cvt_pk_bf16(v0[2], v0[3]); w.z = cvt_pk_bf16(v1[0], v1[1]); w.w = cvt_pk_bf16(v1[2], v1[3]);
                    *(u32x4*)(rowp + bj * HALF) = w; } }
    }
};
struct EpiSwiglu {
    static constexpr bool PERM = true;
    bf16_t* O; const float* bias;
    __device__ __forceinline__ static float sw(float g, float l) { g = fminf(g, 7.f); l = fminf(fmaxf(l, -7.f), 7.f); const float sg = __builtin_amdgcn_rcpf(1.f + __builtin_amdgcn_exp2f(-1.702f * 1.4426950408889634f * g)); return g * sg * (l + 1.f); }
    __device__ __forceinline__ void operator()(const f32x4 (&acc)[2][2][4][2], const Unit& u, int wr, int wc, int fr, int fq) const {
        const int row0 = u.pm * BM + wr * 64 + fr, c0 = u.pn * HALF + wc * 32 + 8 * fq; const float* bs = bias + (size_t)u.e * 2048;
        f32x4 bg[2], bl[2];
#pragma unroll
        for (int n = 0; n < 2; ++n) { bg[n] = *(const f32x4*)(bs + c0 + 4 * n); bl[n] = *(const f32x4*)(bs + 1024 + c0 + 4 * n); }
#pragma unroll
        for (int ai = 0; ai < 2; ++ai)
#pragma unroll
            for (int m = 0; m < 4; ++m) { float o[8];
#pragma unroll
                for (int n = 0; n < 2; ++n) { const f32x4 g = acc[ai][0][m][n] + bg[n], l = acc[ai][1][m][n] + bl[n];
#pragma unroll
                    for (int i = 0; i < 4; ++i) o[4 * n + i] = sw(g[i], l[i]); }
                u32x4 w; w.x = cvt_pk_bf16(o[0], o[1]); w.y = cvt_pk_bf16(o[2], o[3]); w.z = cvt_pk_bf16(o[4], o[5]); w.w = cvt_pk_bf16(o[6], o[7]);
                *(u32x4*)(O + (size_t)(row0 + ai * HALF + m * 16) * 1024 + c0) = w; }
    }
};
struct EpiResid {
    static constexpr bool PERM = true;
    bf16_t* S; const bf16_t* R; int ldc; float alpha;
    __device__ __forceinline__ void operator()(const f32x4 (&acc)[2][2][4][2], const Unit& u, int wr, int wc, int fr, int fq) const {
        const int row0 = u.pm * BM + wr * 64 + fr, col0 = u.pn * BM + wc * 32 + 8 * fq;
#pragma unroll
        for (int ai = 0; ai < 2; ++ai)
#pragma unroll
            for (int m = 0; m < 4; ++m) { const size_t ro = (size_t)(row0 + ai * HALF + m * 16) * ldc + col0;
#pragma unroll
                for (int bj = 0; bj < 2; ++bj) { const u32x4 r = *(const u32x4*)(R + ro + bj * HALF);
                    const f32x4 x0 = {bflo(r.x), bfhi(r.x), bflo(r.y), bfhi(r.y)}, x1 = {bflo(r.z), bfhi(r.z), bflo(r.w), bfhi(r.w)};
                    const f32x4 v0 = x0 * alpha + acc[ai][bj][m][0], v1 = x1 * alpha + acc[ai][bj][m][1];
                    u32x4 w; w.x = cvt_pk_bf16(v0[0], v0[1]); w.y = cvt_pk_bf16(v0[2], v0[3]); w.z = cvt_pk_bf16(v1[0], v1[1]); w.w = cvt_pk_bf16(v1[2], v1[3]);
                    *(u32x4*)(S + ro + bj * HALF) = w; } }
    }
};

template <class Epi, class Sched, bool GATHER>
__device__ __forceinline__ void gemm_phase(LAS unsigned char* lds, const Gemm g, const Sched& S, const Epi& E, const int tid) {
    const int wid = __builtin_amdgcn_readfirstlane(tid >> 6), lane = tid & 63, wr = wid >> 2, wc = wid & 3, fr = lane & 15, fq = lane >> 4;
    const int K = g.K, nt = K / BK;
    int sR[2], sC[2]; unsigned voffB[2];
#pragma unroll
    for (int i = 0; i < 2; ++i) { stage_rc(tid * 16 + i * 8192, sR[i], sC[i]); const int Rb = Epi::PERM ? ((sR[i] & ~31) + perm32(sR[i] & 31)) : sR[i]; voffB[i] = (unsigned)(Rb * K + sC[i]) * 2u; }
    const size_t kstep = (size_t)(BK * 2);
    const size_t hstep = (size_t)HALF * K * 2;
    const size_t tstep = 2 * hstep;
    const unsigned ldsw = (unsigned)wid * 1024u;
    const int aoff = lds_byte(wr * 64 + fr, fq * 8), boff = lds_byte(wc * 32 + fr, fq * 8);
#define PG8_SA(b, h) (((b) * 2 + (h)) * HTB)
#define PG8_SB(b, h) ((4 + (b) * 2 + (h)) * HTB)
#define PG8_STAGE(bufoff, gbase, voff) do { _Pragma("unroll") for (int _i = 0; _i < 2; ++_i) \
        __builtin_amdgcn_global_load_lds((const unsigned*)((const char*)(gbase) + (voff)[_i]), (LAS unsigned*)(lds + (bufoff) + ldsw + _i * 8192), 16, 0, 0); } while (0)
#define PG8_LDA(dst, b, h) do { _Pragma("unroll") for (int m = 0; m < 4; ++m) _Pragma("unroll") for (int k = 0; k < 2; ++k) dst[m][k] = *(const LAS bf16x8*)(lds + PG8_SA(b, h) + aoff + m * 2048 + k * 1024); } while (0)
#define PG8_LDB(dst, b, h) do { _Pragma("unroll") for (int n = 0; n < 2; ++n) _Pragma("unroll") for (int k = 0; k < 2; ++k) dst[n][k] = *(const LAS bf16x8*)(lds + PG8_SB(b, h) + boff + n * 2048 + k * 1024); } while (0)
#define PG8_MMA(ai, bj, At, Bt) do { __builtin_amdgcn_s_setprio(1); _Pragma("unroll") for (int m = 0; m < 4; ++m) _Pragma("unroll") for (int n = 0; n < 2; ++n) _Pragma("unroll") for (int k = 0; k < 2; ++k) \
        acc[ai][bj][m][n] = __builtin_amdgcn_mfma_f32_16x16x32_bf16(Bt[n][k], At[m][k], acc[ai][bj][m][n], 0, 0, 0); __builtin_amdgcn_s_setprio(0); } while (0)
#define PG8_WAIT_V(n) asm volatile("s_waitcnt vmcnt(" #n ")" ::: "memory")
#define PG8_WAIT_L(n) asm volatile("s_waitcnt lgkmcnt(" #n ")" ::: "memory")
#define PG8_BAR __builtin_amdgcn_s_barrier()
#define PG8_SCHED __builtin_amdgcn_sched_barrier(0)
#define PG8_AOFFS(dst, u_) do { if (GATHER) { const int* _l; int _nv; S.rows(u_, _l, _nv); _Pragma("unroll") for (int _h = 0; _h < 2; ++_h) _Pragma("unroll") for (int _i = 0; _i < 2; ++_i) { \
            const int _r = sR[_i] + 128 * _h; const int _t = _r < _nv ? _l[_r] : FILL_ROW; dst[_h][_i] = (unsigned)(_t * K + sC[_i]) * 2u; } } \
        else { _Pragma("unroll") for (int _h = 0; _h < 2; ++_h) _Pragma("unroll") for (int _i = 0; _i < 2; ++_i) dst[_h][_i] = (unsigned)((sR[_i] + 128 * _h) * K + sC[_i]) * 2u; } } while (0)
#define PG8_ABASE(u_) (GATHER ? (const char*)g.A : (const char*)g.A + (size_t)(u_).pm * tstep)
#define PG8_BBASE(u_) ((const char*)g.Bt + ((size_t)(u_).e * g.bstride_e) * 2 + (size_t)(u_).pn * tstep)
    Unit cur, nxt; int ui = 0;
    if (!S.next(0, cur)) return;
    f32x4 acc[2][2][4][2];
#pragma unroll
    for (int a = 0; a < 2; ++a)
#pragma unroll
        for (int b = 0; b < 2; ++b)
#pragma unroll
            for (int m = 0; m < 4; ++m)
#pragma unroll
                for (int n = 0; n < 2; ++n) acc[a][b][m][n] = (f32x4){0.f, 0.f, 0.f, 0.f};
    bf16x8 At[4][2], B0[2][2], B1[2][2];
    unsigned cva[2][2], nva[2][2];
    PG8_AOFFS(cva, cur);
    const char* cA = PG8_ABASE(cur); const char* cB = PG8_BBASE(cur);
    PG8_STAGE(PG8_SB(0, 0), cB, voffB); PG8_STAGE(PG8_SB(0, 1), cB + hstep, voffB); PG8_STAGE(PG8_SA(0, 0), cA, cva[0]); PG8_STAGE(PG8_SA(0, 1), cA, cva[1]);
    if (wr == 1) PG8_BAR;
    PG8_WAIT_V(2); PG8_BAR;
    PG8_STAGE(PG8_SB(1, 0), cB + kstep, voffB); PG8_STAGE(PG8_SA(1, 0), cA + kstep, cva[0]); PG8_STAGE(PG8_SB(1, 1), cB + hstep + kstep, voffB);
    PG8_WAIT_V(6); PG8_BAR;
    for (;;) {
        const bool has_next = S.next(ui + 1, nxt);
        if (GATHER) { if (has_next) { PG8_AOFFS(nva, nxt); } else {
#pragma unroll
            for (int h = 0; h < 2; ++h)
#pragma unroll
                for (int i = 0; i < 2; ++i) nva[h][i] = cva[h][i]; } }
        const char* nA = has_next ? PG8_ABASE(nxt) : cA; const char* nB = has_next ? PG8_BBASE(nxt) : cB;
        for (int t = 0; t < nt; t += 2) {
            const bool last = (t == nt - 2);
            const char* a1 = cA + (size_t)(t + 1) * kstep;
            const char* a2 = last ? nA : cA + (size_t)(t + 2) * kstep; const char* b2 = last ? nB : cB + (size_t)(t + 2) * kstep;
            const char* a3 = a2 + kstep; const char* b3 = b2 + kstep;
            unsigned va[2][2];
#pragma unroll
            for (int h = 0; h < 2; ++h)
#pragma unroll
                for (int i = 0; i < 2; ++i) va[h][i] = (GATHER && last) ? nva[h][i] : cva[h][i];
            PG8_LDB(B0, 0, 0); PG8_LDB(B1, 0, 1); PG8_SCHED; PG8_LDA(At, 0, 0); PG8_STAGE(PG8_SA(1, 1), a1, cva[1]);
            PG8_WAIT_V(8); PG8_WAIT_L(0); PG8_BAR; PG8_MMA(0, 0, At, B0); PG8_MMA(0, 1, At, B1); PG8_BAR; PG8_SCHED;
            PG8_LDA(At, 0, 1); PG8_STAGE(PG8_SB(0, 0), b2, voffB); PG8_STAGE(PG8_SB(0, 1), b2 + hstep, voffB); PG8_STAGE(PG8_SA(0, 0), a2, va[0]);
            PG8_WAIT_V(8); PG8_WAIT_L(0); PG8_BAR; PG8_MMA(1, 0, At, B0); PG8_MMA(1, 1, At, B1); PG8_BAR; PG8_SCHED;
            PG8_LDB(B0, 1, 0); PG8_LDB(B1, 1, 1); PG8_SCHED; PG8_LDA(At, 1, 0); PG8_STAGE(PG8_SA(0, 1), a2, va[1]);
            PG8_WAIT_V(8); PG8_WAIT_L(0); PG8_BAR; PG8_MMA(0, 0, At, B0); PG8_MMA(0, 1, At, B1); PG8_BAR; PG8_SCHED;
            PG8_LDA(At, 1, 1); PG8_STAGE(PG8_SB(1, 0), b3, voffB); PG8_STAGE(PG8_SB(1, 1), b3 + hstep, voffB); PG8_STAGE(PG8_SA(1, 0), a3, va[0]);
            PG8_WAIT_V(8); PG8_WAIT_L(0); PG8_BAR; PG8_MMA(1, 0, At, B0); PG8_MMA(1, 1, At, B1); PG8_BAR; PG8_SCHED;
        }
        if (wr == 0) PG8_BAR;
        E(acc, cur, wr, wc, fr, fq);
        if (!has_next) break;
#pragma unroll
        for (int a = 0; a < 2; ++a)
#pragma unroll
            for (int b = 0; b < 2; ++b)
#pragma unroll
                for (int m = 0; m < 4; ++m)
#pragma unroll
                    for (int n = 0; n < 2; ++n) acc[a][b][m][n] = (f32x4){0.f, 0.f, 0.f, 0.f};
        cur = nxt; cA = nA; cB = nB; ++ui;
        if (GATHER) {
#pragma unroll
        for (int h = 0; h < 2; ++h)
#pragma unroll
            for (int i = 0; i < 2; ++i) cva[h][i] = nva[h][i]; }
        if (wr == 1) PG8_BAR;
    }
    PG8_WAIT_V(0);
    PG8_BAR;
#undef PG8_SA
#undef PG8_SB
#undef PG8_STAGE
#undef PG8_LDA
#undef PG8_LDB
#undef PG8_MMA
#undef PG8_WAIT_V
#undef PG8_WAIT_L
#undef PG8_BAR
#undef PG8_SCHED
#undef PG8_AOFFS
#undef PG8_ABASE
#undef PG8_BBASE
}
}
constexpr int LDS_RING = 131072;
constexpr int LDS_TAB = LDS_RING + 3072;
constexpr int LDS_MISC = LDS_RING + 2048;
constexpr int LDS_BYTES = 147456;

struct MKP {
    const float *x, *meta, *ln_in_g, *ln_in_b, *w_in, *diff_lambda, *diff_subln_g, *fox_forget_b, *gdn_conv_w, *gdn_a_log, *gdn_dt_bias, *gdn_norm_g, *w_out, *ln1_g, *ln1_b,
        *router_w, *router_b, *w1, *b1, *w2, *b2, *ln2_g, *ln2_b;
    float* out;
    bf16_t *Win_t, *Wout_t, *W1_t, *W2_t;
    float* stream;
    bf16_t* actb;
    bf16_t* proj;
    float* gates;
    bf16_t* mixcat;
    bf16_t* act;
    bf16_t* ybuf;
    int* cnt;
    int* etok;
    int* tok_e; int* tok_pos; float* tok_gate;
    unsigned* ctl;
    bf16_t* tmpO;
    unsigned long long* Gk;
    float* wgc;
    float* rwT;
    float* Gf;
    float *fox_loc, *fox_tot;
    unsigned char* gch; float* gcd;
    float *gq, *gk, *gv, *gsc, *gdn_o;
    int ph_lo, ph_hi;
};

#define LDS_WAIT() asm volatile("s_waitcnt lgkmcnt(0)" ::: "memory")
#define VM_WAIT() asm volatile("s_waitcnt vmcnt(0)" ::: "memory")

typedef GAS unsigned gu32;
#define XB_TMO      128
#define XB_XCNT(j)  (256  + 64 * (j))
#define XB_XSUB(j)  (1280 + 64 * (j))
#define XB_XGEN(j)  (2304 + 64 * (j))
#define XB_TOP      3328
#define XB_TOPGEN   3392
#define XCD_BAR_WORDS 3456
#define XB_SPIN_CAP (1u << 18)

__device__ __forceinline__ unsigned xb_ld(unsigned* p)              { return __hip_atomic_load(p, __ATOMIC_RELAXED, __HIP_MEMORY_SCOPE_AGENT); }
__device__ __forceinline__ unsigned xb_add(unsigned* p, unsigned v) { return __hip_atomic_fetch_add(p, v, __ATOMIC_RELAXED, __HIP_MEMORY_SCOPE_AGENT); }
__device__ __forceinline__ unsigned xb_xcc_id() { return (unsigned)__builtin_amdgcn_s_getreg((3 << 11) | 20) & 0xFu; }
#define XB_SPIN(cond, bar) do { unsigned _sp = 0; while (cond) { __builtin_amdgcn_s_sleep(1); \
    if ((++_sp & 255u) == 0u) { if (xb_ld(&(bar)[XB_TMO])) break; if (_sp > XB_SPIN_CAP) { atomicAdd(&(bar)[XB_TMO], 1u); break; } } } } while (0)

struct XcdBarrier {
    unsigned* bar; unsigned x;
    volatile LAS unsigned* st;
};

__device__ __forceinline__ XcdBarrier xcd_barrier_post(unsigned* bar, volatile LAS unsigned* st) {
    XcdBarrier b; b.bar = bar; b.x = xb_xcc_id(); b.st = st;
    if (threadIdx.x == 0) (void)xb_add(&bar[XB_XCNT(b.x)], 1u);
    return b;
}
__device__ __forceinline__ void xcd_barrier_complete(unsigned* bar, unsigned x, unsigned& nloc, unsigned& nx) {
    const unsigned G = gridDim.x * gridDim.y * gridDim.z;
    unsigned sum, cnt, mine, sp = 0u;
    for (;;) {
        sum = 0u; cnt = 0u; mine = 0u;
#pragma unroll
        for (unsigned j = 0; j < 16; ++j) { const unsigned c = xb_ld(&bar[XB_XCNT(j)]); sum += c; cnt += (c > 0u) ? 1u : 0u; mine = (j == x) ? c : mine; }
        if (sum == G) break;
        __builtin_amdgcn_s_sleep(1);
        if ((++sp & 255u) == 0u) { if (xb_ld(&bar[XB_TMO])) break; if (sp > XB_SPIN_CAP) { atomicAdd(&bar[XB_TMO], 1u); break; } }
    }
    nloc = mine > 0u ? mine : 1u; nx = cnt > 0u ? cnt : 1u;
}

__device__ __forceinline__ void xcd_barrier(const XcdBarrier& b) {
    asm volatile("s_waitcnt vmcnt(0)" ::: "memory");
    __syncthreads();
    if (threadIdx.x == 0) {
        unsigned* bar = b.bar;
        __builtin_amdgcn_s_waitcnt(0);
        unsigned nloc = b.st[0], nx = b.st[1];
        if (nloc == 0u) { xcd_barrier_complete(bar, b.x, nloc, nx); b.st[0] = nloc; b.st[1] = nx; }
        const unsigned old = xb_add(&bar[XB_XSUB(b.x)], 1u);
        const unsigned gen = old / nloc;
        if (old + 1u == (gen + 1u) * nloc) {
            __builtin_amdgcn_fence(__ATOMIC_RELEASE, "agent");
            asm volatile("s_waitcnt vmcnt(0)" ::: "memory");
            const unsigned og = xb_add(&bar[XB_TOP], 1u);
            const unsigned tg = og / nx;
            if (og + 1u == (tg + 1u) * nx) xb_add(&bar[XB_TOPGEN], 1u);
            else XB_SPIN(xb_ld(&bar[XB_TOPGEN]) == tg, bar);
            __builtin_amdgcn_fence(__ATOMIC_ACQUIRE, "agent");
            xb_add(&bar[XB_XGEN(b.x)], 1u);
            asm volatile("s_waitcnt vmcnt(0)" ::: "memory");
        } else {
            XB_SPIN(xb_ld(&bar[XB_XGEN(b.x)]) == gen, bar);
            __builtin_amdgcn_fence(__ATOMIC_ACQUIRE, "agent");
            asm volatile("s_waitcnt vmcnt(0)" ::: "memory");
        }
    }
    __syncthreads();
}


struct CvItem { const float* src; bf16_t* dst; int ldw, K; float scale; };
__device__ __forceinline__ void cv_load(const CvItem& it, f32x4 (&v)[16], int lane) {
    const float* s = it.src + (size_t)(lane >> 4) * it.ldw + (lane & 15) * 4;
#pragma unroll
    for (int i = 0; i < 16; ++i) v[i] = __builtin_nontemporal_load((const f32x4*)(s + (size_t)(4 * i) * it.ldw));
}
__device__ __forceinline__ void cv_store(const CvItem& it, const f32x4 (&v)[16], LAS float* scr, int lane) {
#pragma unroll
    for (int i = 0; i < 16; ++i) { const int kk = 4 * i + (lane >> 4); LAS float* d = scr + ((lane & 15) * 4) * 65 + kk;
        d[0] = v[i][0] * it.scale; d[65] = v[i][1] * it.scale; d[130] = v[i][2] * it.scale; d[195] = v[i][3] * it.scale; }
    LDS_WAIT();
    const int c = lane & 7;
#pragma unroll
    for (int j = 0; j < 8; ++j) { const int n = (lane >> 3) + 8 * j; const LAS float* s = scr + n * 65 + 8 * c;
        u32x4 o; o.x = cvt_pk_bf16(s[0], s[1]); o.y = cvt_pk_bf16(s[2], s[3]); o.z = cvt_pk_bf16(s[4], s[5]); o.w = cvt_pk_bf16(s[6], s[7]);
        *(u32x4*)(it.dst + (size_t)n * it.K + 8 * c) = o; }
    LDS_WAIT();
}
__device__ __forceinline__ CvItem cv_w1_item(const MKP& p, int layer, int r) {
    const int le = layer * NE + r / 512, q = r % 512, kb = q / 32, nb = q % 32, n0 = nb * 64;
    const int tile = n0 >> 8, w = n0 & 255; const int src = w < 128 ? tile * 128 + w : 1024 + tile * 128 + (w - 128);
    CvItem it; it.src = p.w1 + (size_t)le * DM * 2 * DE + (size_t)(kb * 64) * (2 * DE) + src; it.ldw = 2 * DE; it.dst = p.W1_t + (size_t)le * 2 * DE * DM + (size_t)n0 * DM + kb * 64; it.K = DM; it.scale = 1.f; return it;
}
constexpr int W1_Q = 3;
constexpr int W1_DEFER_A = (256 - 77) * NWAVES * W1_Q, W1_DEFER_B = (256 - 4) * NWAVES * W1_Q, W1_DEFER = W1_DEFER_A + W1_DEFER_B;
static_assert(W1_DEFER <= NE * 512, "deferred W1 blocks");
__device__ __forceinline__ void convert_w1_deferred(const MKP& p, LAS unsigned char* lds, int layer, int first, int wave, int lane) {
    LAS float* scr = (LAS float*)(lds + wave * 16640);
    f32x4 cur[16], nxt[16]; CvItem ci = cv_w1_item(p, layer, first); cv_load(ci, cur, lane);
    for (int i = 0; i < W1_Q; ++i) { CvItem ni = ci; if (i + 1 < W1_Q) { ni = cv_w1_item(p, layer, first + i + 1); cv_load(ni, nxt, lane); }
        cv_store(ci, cur, scr, lane); ci = ni;
#pragma unroll
        for (int k = 0; k < 16; ++k) cur[k] = nxt[k]; }
}
__device__ __forceinline__ CvItem cv_w2_item(const MKP& p, int r) {
    const int le = r / 256, q = r % 256, kb = q / 16, nb = q % 16; CvItem c;
    c.src = p.w2 + (size_t)le * DE * DM + (size_t)(kb * 64) * DM + nb * 64; c.ldw = DM; c.dst = p.W2_t + (size_t)le * DM * DE + (size_t)(nb * 64) * DE + kb * 64; c.K = DE; c.scale = 1.f; return c;
}
constexpr int W2_DEFER = 8192, W2_L1 = 32 * 256;
__device__ __forceinline__ void convert_w2_blocks(const MKP& p, LAS unsigned char* lds, int first, int step, int n, int wave, int lane) {
    LAS float* scr = (LAS float*)(lds + wave * 16640);
    f32x4 cur[16], nxt[16]; int r = first; if (r >= W2_DEFER || n <= 0) return;
    CvItem ci = cv_w2_item(p, W2_L1 + r); cv_load(ci, cur, lane);
    for (int i = 0; i < n; ++i) { CvItem ni = ci; const int rn = r + step; const bool more = i + 1 < n && rn < W2_DEFER;
        if (more) { ni = cv_w2_item(p, W2_L1 + rn); cv_load(ni, nxt, lane); }
        cv_store(ci, cur, scr, lane); if (!more) break; ci = ni; r = rn;
#pragma unroll
        for (int k = 0; k < 16; ++k) cur[k] = nxt[k]; }
}
__device__ __forceinline__ int moe_last_round_units(int nunits, int G) { return nunits - ((nunits + G - 1) / G - 1) * G; }
__device__ __forceinline__ CvItem cv_p0_item(const MKP& p, int it) {
    constexpr int I_IN = 16 * (NPJ / 64), I_OUT = 16 * 16, I_W1L = NE * 512 - W1_DEFER, I_W2 = 16 * 16;
    constexpr int T_IN = 2 * I_IN, T_OUT = 2 * I_OUT, T_W1 = 2 * I_W1L;
    int r = it; CvItem c;
    if (r < T_IN) { const int l = r / I_IN, q = r % I_IN, kb = q / (NPJ / 64), nb = q % (NPJ / 64), n0 = nb * 64;
        const int src = n0 < 2304 ? n0 : (n0 < 3072 ? n0 + 4 : n0 + 12);
        c.src = p.w_in + (size_t)l * DM * NPROJ + (size_t)(kb * 64) * NPROJ + src; c.ldw = NPROJ; c.dst = p.Win_t + (size_t)l * NPJ * DM + (size_t)n0 * DM + kb * 64; c.K = DM; c.scale = (n0 < 512 || (n0 >= P_FQ && n0 < P_FK)) ? QK_C2 : 1.f; return c; }
    r -= T_IN;
    if (r < T_OUT) { const int l = r / I_OUT, q = r % I_OUT, kb = q / 16, nb = q % 16;
        c.src = p.w_out + (size_t)l * DM * DM + (size_t)(kb * 64) * DM + nb * 64; c.ldw = DM; c.dst = p.Wout_t + (size_t)l * DM * DM + (size_t)(nb * 64) * DM + kb * 64; c.K = DM; c.scale = 1.f; return c; }
    r -= T_OUT;
    if (r < T_W1) return cv_w1_item(p, r / I_W1L, W1_DEFER + r % I_W1L);
    r -= T_W1;
    return cv_w2_item(p, r < W2_L1 ? r : r + W2_DEFER);
}
__device__ __forceinline__ void phase_convert_weights(const MKP& p, LAS unsigned char* lds, int gw, int ngw, int wave, int lane) {
    LAS float* scr = (LAS float*)(lds + wave * 16640);
    constexpr int NIT = 2 * 16 * (NPJ / 64) + 2 * 256 + 2 * (NE * 512 - W1_DEFER) + 64 * 256 - W2_DEFER;
    int it = gw; if (it >= NIT) return;
    f32x4 cur[16], nxt[16]; CvItem ci = cv_p0_item(p, it); cv_load(ci, cur, lane);
    for (; it < NIT; it += ngw) { CvItem ni = ci; const bool more = it + ngw < NIT;
        if (more) { ni = cv_p0_item(p, it + ngw); cv_load(ni, nxt, lane); }
        cv_store(ci, cur, scr, lane); ci = ni;
#pragma unroll
        for (int k = 0; k < 16; ++k) cur[k] = nxt[k]; }
}

__device__ __forceinline__ void ln_core(f32x4 (&v)[4], const float* __restrict__ g, const float* __restrict__ bta, int lane) {
    float s = 0.f;
#pragma unroll
    for (int j = 0; j < 4; ++j) s += (v[j][0] + v[j][1]) + (v[j][2] + v[j][3]);
    const float mean = wave_sum(s) * (1.f / DM); float q = 0.f;
#pragma unroll
    for (int j = 0; j < 4; ++j) { v[j] = v[j] - mean; q += (v[j][0] * v[j][0] + v[j][1] * v[j][1]) + (v[j][2] * v[j][2] + v[j][3] * v[j][3]); }
    const float rstd = rsqrtf(wave_sum(q) * (1.f / DM) + 1e-5f);
#pragma unroll
    for (int j = 0; j < 4; ++j) { const f32x4 gg = ((const f32x4*)g)[lane + 64 * j], bb = ((const f32x4*)bta)[lane + 64 * j]; v[j] = v[j] * rstd * gg + bb; }
}
__device__ __forceinline__ void store_row_bf16(bf16_t* dst, const f32x4 (&v)[4], int lane) {
#pragma unroll
    for (int j = 0; j < 4; ++j) { u32x2 w; w.x = cvt_pk_bf16(v[j][0], v[j][1]); w.y = cvt_pk_bf16(v[j][2], v[j][3]); ((u32x2*)dst)[lane + 64 * j] = w; }
}
__device__ __forceinline__ void zero_row_bf16(bf16_t* dst, int lane) {
#pragma unroll
    for (int j = 0; j < 4; ++j) ((u32x2*)dst)[lane + 64 * j] = (u32x2){0u, 0u};
}
__device__ __forceinline__ void gate_w_load(const float* __restrict__ w_in_l, float (&v)[24], int tid) {
#pragma unroll
    for (int q = 0; q < 24; ++q) { const int i = q * NTHR + tid, k = i / 12, c = i % 12; const int col = c < 4 ? C_FF + c : (c < 8 ? C_GB + (c - 4) : C_GA + (c - 8)); v[q] = w_in_l[(size_t)k * NPROJ + col]; }
}
__device__ __forceinline__ void gate_w_store(const float (&v)[24], LAS float* wg, int tid) {
#pragma unroll
    for (int q = 0; q < 24; ++q) { const int i = q * NTHR + tid, k = i / 12, c = i % 12; wg[c * DM + k] = v[q]; }
}
__device__ __forceinline__ void gates_row(const f32x4 (&v)[4], const LAS float* wg, float* __restrict__ grow, int lane) {
    float mine = 0.f;
#pragma unroll
    for (int cb = 0; cb < 12; cb += 4) { f32x4 w[4][4];
#pragma unroll
        for (int q = 0; q < 4; ++q)
#pragma unroll
            for (int j = 0; j < 4; ++j) w[q][j] = *(const LAS f32x4*)(wg + (cb + q) * DM + 4 * (lane + 64 * j));
        __builtin_amdgcn_sched_barrier(0);
#pragma unroll
        for (int q = 0; q < 4; ++q) { float a = 0.f;
#pragma unroll
            for (int j = 0; j < 4; ++j) a += (v[j][0] * w[q][j][0] + v[j][1] * w[q][j][1]) + (v[j][2] * w[q][j][2] + v[j][3] * w[q][j][3]);
            a = wave_sum(a); if (lane == cb + q) mine = a; } }
    if (lane < 16) grow[lane] = lane < 12 ? mine : 0.f;
}

__device__ __forceinline__ void phase_ln_in(const MKP& p, LAS unsigned char* lds, int gw, int ngw, int tid, int lane, const float (&gwv)[24]) {
    LAS float* wg = (LAS float*)lds;
    gate_w_store(gwv, wg, tid); __syncthreads();
    for (int r = gw; r < MP; r += ngw) { if ((r % LP) < NLEAD) { zero_row_bf16(p.actb + (size_t)r * DM, lane); if (lane < 16) p.gates[(size_t)r * 16 + lane] = 0.f; } }
#define LNIN_SRC(r_) (((r_) % LP) >= NLEAD + NMETA ? p.x + ((size_t)((r_) / LP) * SEQ + (((r_) % LP) - NLEAD - NMETA)) * DM : p.meta + (size_t)(((r_) % LP) - NLEAD) * DM)
    int r = gw; while (r < MP && (r % LP) < NLEAD) r += ngw;
    f32x4 nv[4];
    if (r < MP) { const float* src = LNIN_SRC(r);
#pragma unroll
        for (int j = 0; j < 4; ++j) nv[j] = ((const f32x4*)src)[lane + 64 * j]; }
    while (r < MP) {
        f32x4 v[4];
#pragma unroll
        for (int j = 0; j < 4; ++j) v[j] = nv[j];
        int rn = r + ngw; while (rn < MP && (rn % LP) < NLEAD) rn += ngw;
        if (rn < MP) { const float* src = LNIN_SRC(rn);
#pragma unroll
            for (int j = 0; j < 4; ++j) nv[j] = ((const f32x4*)src)[lane + 64 * j]; }
        ln_core(v, p.ln_in_g, p.ln_in_b, lane);
        store_row_bf16(p.actb + (size_t)r * DM, v, lane);
        gates_row(v, wg, p.gates + (size_t)r * 16, lane);
        r = rn;
    }
#undef LNIN_SRC
    __syncthreads();
}

constexpr int CNT_STRIDE = 32;
__device__ __forceinline__ void phase_ln1_route(const MKP& p, int layer, LAS unsigned char* lds, int gw, int ngw, int tid, int lane, int dump = 0) {
    float* stream_w = dump ? (float*)p.act : p.stream; bf16_t* actb_w = dump ? p.act + (size_t)40 * 1024 * 1024 : p.actb;
    int* tok_e_w = dump ? (int*)p.gch : p.tok_e; int* tok_pos_w = dump ? (int*)p.gch + (1 << 18) : p.tok_pos; float* tok_gate_w = dump ? (float*)p.gch + (2 << 18) : p.tok_gate; int* etok_w = dump ? (int*)p.gch + (4 << 18) : p.etok;
    constexpr int RS = DM + 4;
    constexpr int REC_OFF = 136192, LCNT_OFF = REC_OFF + 8192, BASE_OFF = LCNT_OFF + 128;
    LAS float* rwT = (LAS float*)lds; LAS int* rec = (LAS int*)(lds + REC_OFF); LAS int* lcnt = (LAS int*)(lds + LCNT_OFF); LAS int* lbase = (LAS int*)(lds + BASE_OFF);
    const int wave = tid >> 6;
    if (tid < 32) lcnt[tid] = 0;
    const float rbl = p.router_b[layer * NE + (lane & 31)]; int* cnt = p.cnt + layer * 2048 + (dump ? 1024 : 0);
    int r = gw; while (r < MP && (r % LP) < NLEAD) r += ngw;
    u32x2 nv[2][4]; int nrec = 0; const bf16_t* sumb = (const bf16_t*)p.stream;
    int rr[2]; rr[0] = r; { int x = r < MP ? r + ngw : MP; while (x < MP && (x % LP) < NLEAD) x += ngw; rr[1] = x < MP ? x : MP; }
#pragma unroll
    for (int k = 0; k < 2; ++k) if (rr[k] < MP) {
#pragma unroll
        for (int j = 0; j < 4; ++j) nv[k][j] = ((const u32x2*)(sumb + (size_t)rr[k] * DM))[lane + 64 * j]; }
    { const f32x4* src = (const f32x4*)(p.rwT + (size_t)layer * NE * RS);
      f32x4 t4[17];
#pragma unroll
      for (int q = 0; q < 17; ++q) { const int i = q * NTHR + tid; if (i < NE * RS / 4) t4[q] = src[i]; }
#pragma unroll
      for (int q = 0; q < 17; ++q) { const int i = q * NTHR + tid; if (i < NE * RS / 4) *(LAS f32x4*)(rwT + 4 * i) = t4[q]; } }
    __syncthreads();
    const float* lng = p.ln1_g + layer * DM; const float* lnb = p.ln1_b + layer * DM;
    const int ex_l = ((lane >> 5) << 4) | (((lane >> 4) & 1) << 3) | (((lane >> 3) & 1) << 2) | (((lane >> 2) & 1) << 1) | ((lane >> 1) & 1);
    const float rb_l = shfl_idx(rbl, ex_l);
    while (rr[0] < MP) {
        const bool hasB = rr[1] < MP;
        f32x4 v[2][4];
#pragma unroll
        for (int j = 0; j < 4; ++j) { v[0][j] = (f32x4){bflo(nv[0][j].x), bfhi(nv[0][j].x), bflo(nv[0][j].y), bfhi(nv[0][j].y)};
            const u32x2 wB = hasB ? nv[1][j] : nv[0][j]; v[1][j] = (f32x4){bflo(wB.x), bfhi(wB.x), bflo(wB.y), bfhi(wB.y)}; }
        int nr[2]; { int x = hasB ? rr[1] + ngw : MP; while (x < MP && (x % LP) < NLEAD) x += ngw; nr[0] = x < MP ? x : MP; x = nr[0] < MP ? nr[0] + ngw : MP; while (x < MP && (x % LP) < NLEAD) x += ngw; nr[1] = x < MP ? x : MP; }
#pragma unroll
        for (int k = 0; k < 2; ++k) if (nr[k] < MP) {
#pragma unroll
            for (int j = 0; j < 4; ++j) nv[k][j] = ((const u32x2*)(sumb + (size_t)nr[k] * DM))[lane + 64 * j]; }
        { float s0 = 0.f, s1 = 0.f;
#pragma unroll
          for (int j = 0; j < 4; ++j) { s0 += (v[0][j][0] + v[0][j][1]) + (v[0][j][2] + v[0][j][3]); s1 += (v[1][j][0] + v[1][j][1]) + (v[1][j][2] + v[1][j][3]); }
          const float m0 = wave_sum(s0) * (1.f / DM), m1 = wave_sum(s1) * (1.f / DM); float q0 = 0.f, q1 = 0.f;
#pragma unroll
          for (int j = 0; j < 4; ++j) { v[0][j] = v[0][j] - m0; v[1][j] = v[1][j] - m1;
              q0 += (v[0][j][0] * v[0][j][0] + v[0][j][1] * v[0][j][1]) + (v[0][j][2] * v[0][j][2] + v[0][j][3] * v[0][j][3]); q1 += (v[1][j][0] * v[1][j][0] + v[1][j][1] * v[1][j][1]) + (v[1][j][2] * v[1][j][2] + v[1][j][3] * v[1][j][3]); }
          const float r0 = rsqrtf(wave_sum(q0) * (1.f / DM) + 1e-5f), r1 = rsqrtf(wave_sum(q1) * (1.f / DM) + 1e-5f);
#pragma unroll
          for (int j = 0; j < 4; ++j) { const f32x4 gg = ((const f32x4*)lng)[lane + 64 * j], bb = ((const f32x4*)lnb)[lane + 64 * j]; v[0][j] = v[0][j] * r0 * gg + bb; v[1][j] = v[1][j] * r1 * gg + bb; } }
        store_row_bf16(actb_w + (size_t)rr[0] * DM, v[0], lane);
        if (hasB) store_row_bf16(actb_w + (size_t)rr[1] * DM, v[1], lane);
        float lg[2][32];
#pragma unroll
        for (int eb = 0; eb < 32; eb += 4) { f32x4 w[4][4];
#pragma unroll
            for (int q = 0; q < 4; ++q) if (eb + q < 32) {
#pragma unroll
                for (int j = 0; j < 4; ++j) w[q][j] = *(const LAS f32x4*)(rwT + (eb + q) * RS + 4 * (lane + 64 * j)); }
            __builtin_amdgcn_sched_barrier(0);
#pragma unroll
            for (int q = 0; q < 4; ++q) if (eb + q < 32) { f32x2 a0 = {0.f, 0.f}, a1 = {0.f, 0.f};
#pragma unroll
                for (int j = 0; j < 4; ++j) { const f32x2 wl = {w[q][j][0], w[q][j][1]}, wh = {w[q][j][2], w[q][j][3]};
                    a0 = __builtin_elementwise_fma((f32x2){v[0][j][0], v[0][j][1]}, wl, a0); a0 = __builtin_elementwise_fma((f32x2){v[0][j][2], v[0][j][3]}, wh, a0);
                    a1 = __builtin_elementwise_fma((f32x2){v[1][j][0], v[1][j][1]}, wl, a1); a1 = __builtin_elementwise_fma((f32x2){v[1][j][2], v[1][j][3]}, wh, a1); }
                lg[0][eb + q] = a0[0] + a0[1]; lg[1][eb + q] = a1[0] + a1[1]; }
            __builtin_amdgcn_sched_barrier(0); }
        float h1[2];
#define XSWZ(v_, m_) __int_as_float(__builtin_amdgcn_ds_swizzle(__float_as_int(v_), (((m_) << 10) | 0x1F)))
        { float h16[2][16], h8[2][8], h4[2][4], h2[2][2];
#pragma unroll
          for (int e = 0; e < 16; ++e)
#pragma unroll
              for (int k = 0; k < 2; ++k) { auto sw = __builtin_amdgcn_permlane32_swap(__float_as_uint(lg[k][e]), __float_as_uint(lg[k][16 + e]), false, false);
                  h16[k][e] = __uint_as_float(sw[0]) + __uint_as_float(sw[1]); }
          { const bool up = (lane & 16) != 0;
#pragma unroll
            for (int e = 0; e < 8; ++e)
#pragma unroll
                for (int k = 0; k < 2; ++k) { const float keep = up ? h16[k][8 + e] : h16[k][e], give = up ? h16[k][e] : h16[k][8 + e]; h8[k][e] = keep + XSWZ(give, 16); } }
          { const bool up = (lane & 8) != 0;
#pragma unroll
            for (int e = 0; e < 4; ++e)
#pragma unroll
                for (int k = 0; k < 2; ++k) { const float keep = up ? h8[k][4 + e] : h8[k][e], give = up ? h8[k][e] : h8[k][4 + e]; h4[k][e] = keep + XSWZ(give, 8); } }
          { const bool up = (lane & 4) != 0;
#pragma unroll
            for (int e = 0; e < 2; ++e)
#pragma unroll
                for (int k = 0; k < 2; ++k) { const float keep = up ? h4[k][2 + e] : h4[k][e], give = up ? h4[k][e] : h4[k][2 + e]; h2[k][e] = keep + XSWZ(give, 4); } }
          { const bool up = (lane & 2) != 0;
#pragma unroll
            for (int k = 0; k < 2; ++k) { const float keep = up ? h2[k][1] : h2[k][0], give = up ? h2[k][0] : h2[k][1]; h1[k] = keep + XSWZ(give, 2); } }
#pragma unroll
          for (int k = 0; k < 2; ++k) h1[k] += XSWZ(h1[k], 1); }
#undef XSWZ
        float val[2] = {h1[0] + rb_l, h1[1] + rb_l};
        float tv[2][4]; int ti[2][4];
#pragma unroll
        for (int t4 = 0; t4 < 4; ++t4) { const float mx0 = wave_max(val[0]), mx1 = wave_max(val[1]);
            const int c0 = (int)__builtin_ctzll(__ballot(val[0] == mx0)) >> 1, c1 = (int)__builtin_ctzll(__ballot(val[1] == mx1)) >> 1;
            tv[0][t4] = mx0; ti[0][t4] = c0; if (ex_l == c0) val[0] = -INFINITY; tv[1][t4] = mx1; ti[1][t4] = c1; if (ex_l == c1) val[1] = -INFINITY; }
#pragma unroll
        for (int k = 0; k < 2; ++k) if (k == 0 || hasB) {
            const float e1 = __expf(tv[k][1] - tv[k][0]), e2 = __expf(tv[k][2] - tv[k][0]), e3 = __expf(tv[k][3] - tv[k][0]); const float inv = 1.f / (1.f + e1 + e2 + e3);
            if (lane < 4) { const float gt = (lane == 0 ? 1.f : lane == 1 ? e1 : lane == 2 ? e2 : e3) * inv; const int ex = lane == 0 ? ti[k][0] : lane == 1 ? ti[k][1] : lane == 2 ? ti[k][2] : ti[k][3];
                const int rank = __hip_atomic_fetch_add(lcnt + ex, 1, __ATOMIC_RELAXED, __HIP_MEMORY_SCOPE_WORKGROUP);
                LAS int* rc = rec + ((wave * 16 + nrec) * 4 + lane) * 4; rc[0] = ex; rc[1] = rank; rc[2] = __float_as_int(gt); rc[3] = rr[k]; }
            ++nrec; }
        rr[0] = nr[0]; rr[1] = nr[1];
    }
    __syncthreads();
    if (tid < 32) lbase[tid] = atomicAdd(&cnt[tid * CNT_STRIDE], lcnt[tid]);
    __syncthreads();
    for (int i = lane; i < nrec * 4; i += 64) { const LAS int* rc = rec + ((wave * 16) * 4 + i) * 4; const int ex = rc[0], pos = lbase[ex] + rc[1], rr_ = rc[3], k = i & 3;
        tok_e_w[(size_t)rr_ * 4 + k] = ex; tok_pos_w[(size_t)rr_ * 4 + k] = pos; tok_gate_w[(size_t)rr_ * 4 + k] = __int_as_float(rc[2]); etok_w[(size_t)ex * MP + pos] = rr_; }
    __syncthreads();
}

__device__ __forceinline__ void build_expert_tab(const int* cnt, volatile LAS int* tab, int tid) {
    __syncthreads();
    if (tid < 64) { const int e = tid & 31; int np = 0; if (tid < 32) np = (__hip_atomic_load(cnt + e * CNT_STRIDE, __ATOMIC_RELAXED, __HIP_MEMORY_SCOPE_AGENT) + 255) >> 8;
        int incl = np;
#pragma unroll
        for (int o = 1; o < 32; o <<= 1) { const int u = shfl_up_li(incl, o, tid); if (tid >= o) incl += u; }
        const int base = incl - np;
        if (tid < 32) { tab[1 + e] = base; for (int q = 0; q < np; ++q) tab[40 + base + q] = e; if (e == 31) { tab[33] = incl; tab[0] = incl; } } }
    __syncthreads();
}

__device__ __forceinline__ void phase_combine_ln2(const MKP& p, int layer, LAS unsigned char* lds, int gw, int ngw, int tid, int lane, int dump = 0) {
    float* stream_w = dump ? (float*)p.act : p.stream; bf16_t* actb_w = dump ? p.act + (size_t)40 * 1024 * 1024 : p.actb; float* gates_w = dump ? (float*)p.gch : p.gates; float* out_w = dump ? (float*)p.act : p.out;
    volatile LAS int* tab = (volatile LAS int*)(lds + LDS_TAB);
    LAS float* wg = (LAS float*)lds;
    if (dump) build_expert_tab(p.cnt + layer * 2048, tab, tid);
    if (layer == 0) { for (int i = tid; i < 12 * DM / 4; i += NTHR) *(LAS f32x4*)(wg + 4 * i) = *(const f32x4*)(p.wgc + 4 * i); __syncthreads(); }
    if (layer == 0) for (int r = gw; r < MP; r += ngw) { if ((r % LP) < NLEAD) { zero_row_bf16(actb_w + (size_t)r * DM, lane); if (lane < 16) gates_w[(size_t)r * 16 + lane] = 0.f; } }
    int r = gw; while (r < MP && (r % LP) < NLEAD) r += ngw;
    int te = 0, tp = 0; float tg = 0.f;
    if (r < MP && lane < 4) { te = p.tok_e[(size_t)r * 4 + lane]; tp = p.tok_pos[(size_t)r * 4 + lane]; tg = p.tok_gate[(size_t)r * 4 + lane]; }
    while (r < MP) { const int b = r / LP, t = r % LP;
        const bf16_t* yr[4]; float gt[4];
#pragma unroll
        for (int k = 0; k < 4; ++k) { const int e = __builtin_amdgcn_readlane(te, k), pos = __builtin_amdgcn_readlane(tp, k); gt[k] = __int_as_float(__builtin_amdgcn_readlane(__float_as_int(tg), k));
            yr[k] = p.ybuf + ((size_t)tab[1 + e] * 256 + pos) * DM; }
        f32x4 v[4]; u32x2 yw[4][4];
#pragma unroll
        for (int j = 0; j < 4; ++j) { const u32x2 w = ((const u32x2*)(p.actb + (size_t)r * DM))[lane + 64 * j]; v[j] = (f32x4){bflo(w.x), bfhi(w.x), bflo(w.y), bfhi(w.y)}; }
#pragma unroll
        for (int k = 0; k < 4; ++k)
#pragma unroll
            for (int j = 0; j < 4; ++j) yw[k][j] = ((const u32x2*)yr[k])[lane + 64 * j];
        int rn = r + ngw; while (rn < MP && (rn % LP) < NLEAD) rn += ngw;
        if (rn < MP && lane < 4) { te = p.tok_e[(size_t)rn * 4 + lane]; tp = p.tok_pos[(size_t)rn * 4 + lane]; tg = p.tok_gate[(size_t)rn * 4 + lane]; }
#pragma unroll
        for (int j = 0; j < 4; ++j) { v[j] = v[j] * DN_ALPHA;
#pragma unroll
            for (int k = 0; k < 4; ++k) { const u32x2 w = yw[k][j]; v[j][0] += gt[k] * bflo(w.x); v[j][1] += gt[k] * bfhi(w.x); v[j][2] += gt[k] * bflo(w.y); v[j][3] += gt[k] * bfhi(w.y); } }
        ln_core(v, p.ln2_g + layer * DM, p.ln2_b + layer * DM, lane);
        if (layer == 0) {
            store_row_bf16(actb_w + (size_t)r * DM, v, lane);
            gates_row(v, wg, gates_w + (size_t)r * 16, lane);
        } else if (t >= NLEAD + NMETA) {
#pragma unroll
            for (int j = 0; j < 4; ++j) ((f32x4*)(out_w + ((size_t)b * SEQ + (t - NLEAD - NMETA)) * DM))[lane + 64 * j] = v[j];
        }
        r = rn;
    }
    __syncthreads();
}
namespace attn_body {
using bf16=unsigned short;
using bf16x8=__attribute__((ext_vector_type(8)))short;
using s16x4=__attribute__((ext_vector_type(4)))short;
using f32x16=__attribute__((ext_vector_type(16)))float;
using u32x4=__attribute__((ext_vector_type(4)))unsigned;
constexpr int D=64,PQ=NPJ;
constexpr int NW=8,QBLK=32,QB=QBLK*NW,KVBLK=64;
__device__ __forceinline__ int crow(int r,int hi){return (r&3)+8*(r>>2)+4*hi;}
#define SBAR() __builtin_amdgcn_sched_barrier(0)
template<int MODE> __device__ __forceinline__ void cmask(f32x16&p0,f32x16&p1,int jb,int qrel,int hi){
  const float NEG=-INFINITY;
  if(MODE==0||MODE==2){ if(jb>(qrel>>6)){
      #pragma unroll
      for(int r=0;r<16;++r){p0[r]=NEG;p1[r]=NEG;} } }
  else{ int kb=64*jb+4*hi;
    #pragma unroll
    for(int r=0;r<16;++r){int kv=kb+(r&3)+8*(r>>2); if(kv>qrel)p0[r]=NEG; if(kv+32>qrel)p1[r]=NEG;} }
}

constexpr int NSLOT=3, SLOTB=8192;
constexpr int LDS_K=0, LDS_V=NSLOT*SLOTB, LDS_WS=2*NSLOT*SLOTB, LDS_OST=LDS_WS+NW*64*4, LDS_BYTES=LDS_OST+NW*4096+NSLOT*SLOTB;
constexpr float C2=0.125f*1.4426950408889634f;
__device__ __forceinline__ void glds16(const void*gsrc,unsigned lds_dst){unsigned keep;
  asm volatile("s_mov_b32 %0, m0\n\ts_mov_b32 m0, %2\n\ts_nop 0\n\tglobal_load_lds_dwordx4 %1, off\n\ts_mov_b32 m0, %0":"=&s"(keep):"v"(gsrc),"s"(lds_dst):"memory");}
__device__ __forceinline__ float max3f(float a,float b,float c){float r;asm("v_max3_f32 %0, %1, %2, %3":"=v"(r):"v"(a),"v"(b),"v"(c));return r;}
__device__ __forceinline__ float max2f(float a,float b){float r;asm("v_max_f32_e32 %0, %1, %2":"=v"(r):"v"(a),"v"(b));return r;}
__device__ __forceinline__ float fadd_s(float a,float b){float r;asm("v_add_f32_e32 %0, %1, %2":"=v"(r):"v"(a),"v"(b));return r;}
__device__ __forceinline__ float fsub_s(float a,float b){float r;asm("v_sub_f32_e32 %0, %1, %2":"=v"(r):"v"(a),"v"(b));return r;}
typedef float f32x2_t __attribute__((ext_vector_type(2))); typedef __bf16 bf16x2_t __attribute__((ext_vector_type(2)));
__device__ __forceinline__ unsigned cvtpk_s(float lo,float hi){f32x2_t v={lo,hi};bf16x2_t b=__builtin_convertvector(v,bf16x2_t);return __builtin_bit_cast(unsigned,b);}
#define WAIT_BAR(N) asm volatile("s_waitcnt vmcnt(" #N ") lgkmcnt(0)\n\ts_barrier":::"memory")

__device__ __forceinline__ void qkt(f32x16&p0,f32x16&p1,const char*Kslot,const bf16x8*qr,const f32x16&ci0,const f32x16&ci1,int r32,int hi){
  const char*kb=Kslot+hi*1024+r32*16;
  #pragma unroll
  for(int d0=0;d0<4;++d0){
    const bf16x8 b0=*reinterpret_cast<const bf16x8*>(kb+d0*2048);
    const bf16x8 b1=*reinterpret_cast<const bf16x8*>(kb+d0*2048+512);
    if(d0==0){p0=__builtin_amdgcn_mfma_f32_32x32x16_bf16(b0,qr[0],ci0,0,0,0);p1=__builtin_amdgcn_mfma_f32_32x32x16_bf16(b1,qr[0],ci1,0,0,0);}
    else{p0=__builtin_amdgcn_mfma_f32_32x32x16_bf16(b0,qr[d0],p0,0,0,0);p1=__builtin_amdgcn_mfma_f32_32x32x16_bf16(b1,qr[d0],p1,0,0,0);}}
}
typedef __attribute__((address_space(3))) const char* lds_cptr;
typedef short v4i16_t __attribute__((ext_vector_type(4)));
__device__ __forceinline__ void kload8(bf16x8*kf,lds_cptr kp){
  kf[0]=*(const __attribute__((address_space(3))) bf16x8*)(kp);      kf[1]=*(const __attribute__((address_space(3))) bf16x8*)(kp+512);
  kf[2]=*(const __attribute__((address_space(3))) bf16x8*)(kp+2048); kf[3]=*(const __attribute__((address_space(3))) bf16x8*)(kp+2560);
  kf[4]=*(const __attribute__((address_space(3))) bf16x8*)(kp+4096); kf[5]=*(const __attribute__((address_space(3))) bf16x8*)(kp+4608);
  kf[6]=*(const __attribute__((address_space(3))) bf16x8*)(kp+6144); kf[7]=*(const __attribute__((address_space(3))) bf16x8*)(kp+6656);
}
__device__ __forceinline__ void kload2(bf16x8*kf,lds_cptr kp,int j){ kf[2*j]=*(const __attribute__((address_space(3))) bf16x8*)(kp+j*2048); kf[2*j+1]=*(const __attribute__((address_space(3))) bf16x8*)(kp+j*2048+512); }
__device__ __forceinline__ s16x4 vtr(lds_cptr p){ return __builtin_bit_cast(s16x4,__builtin_amdgcn_ds_read_tr16_b64_v4i16((__attribute__((address_space(3))) v4i16_t*)p)); }
__device__ __forceinline__ float rowmax(const f32x16&p0,const f32x16&p1){
  float a=max3f(p0[0],p0[1],p1[0]),b=max3f(p0[2],p0[3],p1[1]);a=max3f(a,p1[2],p1[3]);
  #pragma unroll
  for(int r=4;r<16;r+=4){a=max3f(a,p0[r],p0[r+1]);b=max3f(b,p0[r+2],p0[r+3]);a=max3f(a,p1[r],p1[r+1]);b=max3f(b,p1[r+2],p1[r+3]);}
  const float m=max2f(a,b);
  auto rr=__builtin_amdgcn_permlane32_swap(__float_as_uint(m),__float_as_uint(m),false,false);
  return max2f(__uint_as_float(rr[0]),__uint_as_float(rr[1]));
}
template<int NDB_> __device__ __forceinline__ void pv(f32x16*o,int vb,bf16x8 pa0,bf16x8 pa1,bf16x8 pa2,bf16x8 pa3){
  #pragma unroll
  for(int d0=0;d0<NDB_;++d0){s16x4 lo[4],hi[4];
    #pragma unroll
    for(int ks=0;ks<4;++ks){
      asm volatile("ds_read_b64_tr_b16 %0,%1 offset:%c2":"=&v"(lo[ks]):"v"(vb),"i"(d0*4096+ks*1024):"memory");
      asm volatile("ds_read_b64_tr_b16 %0,%1 offset:%c2":"=&v"(hi[ks]):"v"(vb),"i"(d0*4096+ks*1024+512):"memory");}
    asm volatile("s_waitcnt lgkmcnt(0)":::"memory");SBAR();
    #define PK(k) (bf16x8){lo[k][0],lo[k][1],lo[k][2],lo[k][3],hi[k][0],hi[k][1],hi[k][2],hi[k][3]}
    o[d0]=__builtin_amdgcn_mfma_f32_32x32x16_bf16(pa0,PK(0),o[d0],0,0,0);
    o[d0]=__builtin_amdgcn_mfma_f32_32x32x16_bf16(pa1,PK(1),o[d0],0,0,0);
    o[d0]=__builtin_amdgcn_mfma_f32_32x32x16_bf16(pa2,PK(2),o[d0],0,0,0);
    o[d0]=__builtin_amdgcn_mfma_f32_32x32x16_bf16(pa3,PK(3),o[d0],0,0,0);
    #undef PK
  }
}

__device__ __forceinline__ bf16x8 make_qx(float nm){
  const unsigned p1=cvtpk_s(nm,0.f)&0xffffu; const float r1=nm-__uint_as_float(p1<<16);
  const unsigned p2=cvtpk_s(r1,0.f)&0xffffu; const float r2=r1-__uint_as_float(p2<<16);
  const unsigned p3=cvtpk_s(r2,0.f)&0xffffu;
  u32x4 w; w.x=0x3F803F80u; w.y=0x3F80u|(p1<<16); w.z=p2|(p3<<16); w.w=0u; return __builtin_bit_cast(bf16x8,w);
}
__device__ __forceinline__ bf16x8 make_gf(unsigned long long g,unsigned msk){
  u32x4 w; w.x=(unsigned)g&msk; w.y=(unsigned)(g>>32)&msk; w.z=0x3F803F80u&msk; w.w=0u; return __builtin_bit_cast(bf16x8,w);
}
__device__ __forceinline__ void gload(unsigned long long&d,const unsigned long long*sbase,unsigned voff){ asm volatile("global_load_dwordx2 %0, %1, %2":"=&v"(d):"v"(voff),"s"(sbase):"memory"); }
#ifndef ATTN_STORE16
#define ATTN_STORE16(p,v) (*(u32x4*)(p)=(v))
#endif
template<int MODE,int THRL,int DUP=0> __device__ __forceinline__ void attn_unit(int q0,const bf16*Qh,const bf16*__restrict__ Kh,const bf16*__restrict__ Vh,bf16*Oh,int po,const unsigned long long*__restrict__ Gk0,float lcorr,char*shm,const int tid,const long ohalf=0,const int tile0=0,const int rmax=LL){
  constexpr int VM=(MODE==2?2:1),NDB=(MODE==2?4:2),LWS=LDS_V+NSLOT*SLOTB*VM,LOST=LWS+NW*64*4;
  const int lane=tid&63,r32=lane&31,hi=lane>>5; const int wid=__builtin_amdgcn_readfirstlane(tid>>6);
  const bf16*Qw=Qh+(long)(q0+wid*QBLK)*PQ;
  Kh+=(long)tile0*KVBLK*PQ; Vh+=(long)tile0*KVBLK*PQ; const unsigned long long*__restrict__ Gk=Gk0+tile0*KVBLK;
  const unsigned lds0=(unsigned)(uintptr_t)shm;
  float*wsf=(float*)(shm+LWS)+wid*64;
  const bf16*ksrc=Kh+(long)lane*PQ+wid*8;
  const bf16*vsrc=Vh+(long)(16*(wid&3)+(lane>>2))*PQ+(wid>>2)*32+(lane&3)*8;
  const unsigned kdst=lds0+LDS_K+wid*1024, vdst=lds0+LDS_V+wid*1024;
  #define DMA_K(t,slot) glds16(ksrc+(long)(t)*KVBLK*PQ,(unsigned)__builtin_amdgcn_readfirstlane(kdst+(slot)))
  #define DMA_V(t,slot) do{ glds16(vsrc+(long)(t)*KVBLK*PQ,(unsigned)__builtin_amdgcn_readfirstlane(vdst+(slot)*VM)); if(MODE==2) glds16(vsrc+64+(long)(t)*KVBLK*PQ,(unsigned)__builtin_amdgcn_readfirstlane(vdst+(slot)*VM+8192)); }while(0)
  const int vb0=(int)(lds0+LDS_V)+((lane>>4)&1)*32+(lane&3)*8+(4*hi+((lane&15)>>2))*64;
  const char*Kbase=shm+LDS_K; bf16x8 kf[8];
  const lds_cptr shm3=(lds_cptr)shm; const lds_cptr kp0=shm3+LDS_K+hi*1024+r32*16; const lds_cptr vp0=shm3+LDS_V+((lane>>4)&1)*32+(lane&3)*8+(4*hi+((lane&15)>>2))*64;
  const int NT=(q0+QB)/KVBLK-tile0;
  unsigned long long gc0=0,gc1=0; const unsigned goff=(unsigned)r32*8u;
  #define GMSK (hi?0u:0xffffffffu)
  #define QX make_qx(-mhat)
  if(MODE==1){ gload(gc0,Gk,goff); gload(gc1,Gk+32,goff); }
  DMA_K(0,0);DMA_V(0,0);DMA_K(1,SLOTB);
  bf16x8 qr[4];
  #pragma unroll
  for(int d0=0;d0<4;++d0)qr[d0]=*reinterpret_cast<const bf16x8*>(&Qw[(long)r32*PQ+d0*16+hi*8]);
  float mhat=0.f,l_reg=0.f;f32x16 o[NDB];
  #pragma unroll
  for(int d_=0;d_<NDB;++d_)o[d_]=f32x16{};
  f32x16 negm=f32x16{};if(MODE==0)asm volatile("":"+v"(negm));
  const int qrel=wid*QBLK+r32;
  #define CMASK(P0,P1,t) do{int jb_=(t)-(NT-4); if(jb_>=0)cmask<MODE>(P0,P1,jb_,qrel,hi);}while(0)
  #define NEGM_UPD() do{ if(MODE==1){ } else { _Pragma("unroll") for(int r=0;r<16;++r)negm[r]=-mhat; asm volatile("":"+v"(negm)); } }while(0)
  bool resc=false;
  #define START(P0,P1) do{ const float rm=rowmax(P0,P1); resc=false; \
    { const float dl=rm; mhat=fadd_s(mhat,dl); \
      _Pragma("unroll") for(int r=0;r<16;++r){P0[r]=fsub_s(P0[r],dl);P1[r]=fsub_s(P1[r],dl);} \
      NEGM_UPD(); } \
    _Pragma("unroll") for(int r=0;r<16;++r)P0[r]=__builtin_amdgcn_exp2f(P0[r]); }while(0)
  #define RESC() do{ if(resc){ asm volatile("s_waitcnt lgkmcnt(0)":::"memory"); \
      _Pragma("unroll") for(int d_=0;d_<NDB;++d_) _Pragma("unroll") for(int r=0;r<16;++r)o[d_][r]*=wsf[crow(r,hi)]; } }while(0)
  f32x16 pA0,pA1,pB0,pB1;
  int sl_prev=0,sl_cur=0,sl_next=SLOTB;
  #define ROT() do{sl_prev=sl_cur;sl_cur=sl_next;sl_next=(sl_next==(NSLOT-1)*SLOTB)?0:sl_next+SLOTB;}while(0)
  DMA_K(2,2*SLOTB);
  #define GPIN() asm volatile("":"+v"(gc0),"+v"(gc1))
  #define WB_A() do{ if(MODE==2){WAIT_BAR(3);}else{WAIT_BAR(2);} }while(0)
  #define WB_B() do{ if(MODE==2){WAIT_BAR(2);}else{WAIT_BAR(1);} }while(0)
  if(MODE==2){WAIT_BAR(4);}else{WAIT_BAR(3);} GPIN();
  const f32x16 zero16=f32x16{};
  if(MODE==1){ const bf16x8 qx0=make_qx(0.f); const f32x16 cb0=__builtin_amdgcn_mfma_f32_32x32x16_bf16(make_gf(gc0,GMSK),qx0,zero16,0,0,0),cb1=__builtin_amdgcn_mfma_f32_32x32x16_bf16(make_gf(gc1,GMSK),qx0,zero16,0,0,0);
    qkt(pA0,pA1,Kbase,qr,cb0,cb1,r32,hi); gload(gc0,Gk+64,goff); gload(gc1,Gk+96,goff); }
  else qkt(pA0,pA1,Kbase,qr,negm,negm,r32,hi);
  asm volatile("s_nop 15\n\ts_nop 7":"+v"(pA0),"+v"(pA1));CMASK(pA0,pA1,0);
  START(pA0,pA1);
  _Pragma("unroll") for(int r=0;r<16;++r)pA1[r]=__builtin_amdgcn_exp2f(pA1[r]);
  #define GADV() do{ if(MODE==1){ GPIN(); } }while(0)
  WAIT_BAR(0); GADV();
  DMA_K(3,0);DMA_V(1,SLOTB);
  ROT();
  kload8(kf,kp0+sl_cur);
  WB_A();
  s16x4 vlo[8],vhi[8]; u32x4 pw0,pw1,pw2,pw3;
  #define PKW(P,B) cvtpk_s(P[B],P[B+1])
  #define PAF(k) __builtin_bit_cast(bf16x8,pw##k)
  #define VFR(i) (bf16x8){vlo[i][0],vlo[i][1],vlo[i][2],vlo[i][3],vhi[i][0],vhi[i][1],vhi[i][2],vhi[i][3]}
  #define PIN(x) asm volatile("":"+v"(x))
  #define MX3(a,b,c) __builtin_fmaxf(__builtin_fmaxf((a),(b)),(c))
  #define GAPA(MF,A0,A1,A2,A3,W0,W1,PW) do{ MF; sacc+=A0; sacc+=A1; sacc+=A2; sacc+=A3; PIN(sacc); W0; W1; PIN(PW); SBAR(); }while(0)
  #define EX(v) __builtin_amdgcn_exp2f(v)
  #define GAPB(MF,X,B) do{ MF; if(DUP){ MF; } X[B]=EX(X[B]); X[B+1]=EX(X[B+1]); X[B+2]=EX(X[B+2]); X[B+3]=EX(X[B+3]); PIN(X); SBAR(); }while(0)
  #define VRD(i) do{ vlo[i]=vtr(vp_+(((i)>>2)*4096+((i)&3)*1024)); vhi[i]=vtr(vp_+(((i)>>2)*4096+((i)&3)*1024+512)); }while(0)
  #define KRD(G,j) do{ if(G){ kload2(kf,kp0+sl_next,j); SBAR(); } }while(0)
  #define STEP(C0,C1,P0,P1,t,GK,GV,GL) do{ SBAR(); \
    if(MODE==1){ const bf16x8 qx_=QX; { const bf16x8 gf0_=make_gf(gc0,GMSK); C0=__builtin_amdgcn_mfma_f32_32x32x16_bf16(gf0_,qx_,zero16,0,0,0); } SBAR(); \
      { const bf16x8 gf1_=make_gf(gc1,GMSK); C1=__builtin_amdgcn_mfma_f32_32x32x16_bf16(gf1_,qx_,zero16,0,0,0); } SBAR(); \
      if((t)+1<NT){ gload(gc0,Gk+((t)+1)*64,goff); gload(gc1,Gk+((t)+1)*64+32,goff); } } \
    const lds_cptr vp_=vp0+sl_prev; \
    VRD(0); SBAR(); float sacc=(P0[0]+P0[1]); \
    GAPA(C0=__builtin_amdgcn_mfma_f32_32x32x16_bf16(kf[0],qr[0],(MODE==1?C0:negm),0,0,0), P0[2],P0[3],P0[4],P0[5],     pw0[0]=PKW(P0,0), pw0[1]=PKW(P0,2), pw0); \
    VRD(4); SBAR(); GAPA(C1=__builtin_amdgcn_mfma_f32_32x32x16_bf16(kf[1],qr[0],(MODE==1?C1:negm),0,0,0), P0[6],P0[7],P0[8],P0[9],     pw0[2]=PKW(P0,4), pw0[3]=PKW(P0,6), pw0); \
    VRD(1); SBAR(); GAPA(C0=__builtin_amdgcn_mfma_f32_32x32x16_bf16(kf[2],qr[1],C0,0,0,0),   P0[10],P0[11],P0[12],P0[13], pw1[0]=PKW(P0,8), pw1[1]=PKW(P0,10), pw1); \
    VRD(5); SBAR(); GAPA(C1=__builtin_amdgcn_mfma_f32_32x32x16_bf16(kf[3],qr[1],C1,0,0,0),   P0[14],P0[15],P1[0],P1[1],   pw1[2]=PKW(P0,12),pw1[3]=PKW(P0,14), pw1); \
    if(MODE==0){VRD(2);} SBAR(); GAPA(C0=__builtin_amdgcn_mfma_f32_32x32x16_bf16(kf[4],qr[2],C0,0,0,0),   P1[2],P1[3],P1[4],P1[5],     pw2[0]=PKW(P1,0), pw2[1]=PKW(P1,2), pw2); \
    if(MODE==0){VRD(6);} SBAR(); GAPA(C1=__builtin_amdgcn_mfma_f32_32x32x16_bf16(kf[5],qr[2],C1,0,0,0),   P1[6],P1[7],P1[8],P1[9],     pw2[2]=PKW(P1,4), pw2[3]=PKW(P1,6), pw2); \
    if(MODE==0){VRD(3);} SBAR(); GAPA(C0=__builtin_amdgcn_mfma_f32_32x32x16_bf16(kf[6],qr[3],C0,0,0,0),   P1[10],P1[11],P1[12],P1[13], pw3[0]=PKW(P1,8), pw3[1]=PKW(P1,10), pw3); \
    if(MODE==0){VRD(7);} SBAR(); GAPA(C1=__builtin_amdgcn_mfma_f32_32x32x16_bf16(kf[7],qr[3],C1,0,0,0),   P1[14],P1[15],0.f,0.f,       pw3[2]=PKW(P1,12),pw3[3]=PKW(P1,14), pw3); \
    l_reg+=sacc; \
    if(GK){DMA_K((t)+3,sl_cur);} if(GV){DMA_V((t)+1,sl_next);} \
    CMASK(C0,C1,t); \
    { float a=MX3(C0[0],C0[1],C1[0]),b=MX3(C0[2],C0[3],C1[1]); a=MX3(a,C1[2],C1[3]); \
      _Pragma("unroll") for(int r=4;r<16;r+=4){a=MX3(a,C0[r],C0[r+1]);b=MX3(b,C0[r+2],C0[r+3]);a=MX3(a,C1[r],C1[r+1]);b=MX3(b,C1[r+2],C1[r+3]);} \
      float rm=__builtin_fmaxf(a,b); { auto rr=__builtin_amdgcn_permlane32_swap(__float_as_uint(rm),__float_as_uint(rm),false,false); rm=__builtin_fmaxf(__uint_as_float(rr[0]),__uint_as_float(rr[1])); } \
      resc=false; \
      if(__builtin_expect(__any(rm>(float)THRL),0)){ const float dl=__builtin_fmaxf(rm,0.f); mhat+=dl; \
        _Pragma("unroll") for(int r=0;r<16;++r){C0[r]-=dl;C1[r]-=dl;} \
        NEGM_UPD(); \
        const float f=__builtin_amdgcn_exp2f(-dl); l_reg*=f; if(hi==0)wsf[r32]=f; resc=true; } } \
    SBAR(); \
    if(MODE==1){VRD(2);VRD(6);SBAR();} GAPB(o[0]=__builtin_amdgcn_mfma_f32_32x32x16_bf16(PAF(0),VFR(0),o[0],0,0,0), C0,0); \
    GAPB(o[1]=__builtin_amdgcn_mfma_f32_32x32x16_bf16(PAF(0),VFR(4),o[1],0,0,0), C0,4); \
    if(MODE==1){VRD(3);VRD(7);SBAR();} KRD(GL,0); GAPB(o[0]=__builtin_amdgcn_mfma_f32_32x32x16_bf16(PAF(1),VFR(1),o[0],0,0,0), C0,8); \
    KRD(GL,1); GAPB(o[1]=__builtin_amdgcn_mfma_f32_32x32x16_bf16(PAF(1),VFR(5),o[1],0,0,0), C0,12); \
    KRD(GL,2); GAPB(o[0]=__builtin_amdgcn_mfma_f32_32x32x16_bf16(PAF(2),VFR(2),o[0],0,0,0), C1,0); \
    KRD(GL,3); GAPB(o[1]=__builtin_amdgcn_mfma_f32_32x32x16_bf16(PAF(2),VFR(6),o[1],0,0,0), C1,4); \
    GAPB(o[0]=__builtin_amdgcn_mfma_f32_32x32x16_bf16(PAF(3),VFR(3),o[0],0,0,0), C1,8); \
    GAPB(o[1]=__builtin_amdgcn_mfma_f32_32x32x16_bf16(PAF(3),VFR(7),o[1],0,0,0), C1,12); \
    }while(0)
  #define GAPB2(MF,X,B) do{ MF; if(DUP){ MF; } X[B]=EX(X[B]); X[B+1]=EX(X[B+1]); PIN(X); SBAR(); }while(0)
  #define VRD2(sl_,i) do{ vlo[sl_]=vtr(vp_+(((i)>>2)*4096+((i)&3)*1024)); vhi[sl_]=vtr(vp_+(((i)>>2)*4096+((i)&3)*1024+512)); }while(0)
  #define FI(j) ((((j)&3)<<2)|((j)>>2))
  #define PVJ(j,X,B) GAPB2(o[(j)&3]=__builtin_amdgcn_mfma_f32_32x32x16_bf16(PAFS((j)>>2),VFR((j)&3),o[(j)&3],0,0,0), X,B)
  #define PAFS(k) ((k)==0?PAF(0):(k)==1?PAF(1):(k)==2?PAF(2):PAF(3))
  #define STEP2(C0,C1,P0,P1,t,GK,GV,GL) do{ SBAR(); \
    const lds_cptr vp_=vp0+sl_prev*VM; \
    float sacc=(P0[0]+P0[1]); \
    GAPA(C0=__builtin_amdgcn_mfma_f32_32x32x16_bf16(kf[0],qr[0],negm,0,0,0), P0[2],P0[3],P0[4],P0[5],     pw0[0]=PKW(P0,0), pw0[1]=PKW(P0,2), pw0); \
    GAPA(C1=__builtin_amdgcn_mfma_f32_32x32x16_bf16(kf[1],qr[0],negm,0,0,0), P0[6],P0[7],P0[8],P0[9],     pw0[2]=PKW(P0,4), pw0[3]=PKW(P0,6), pw0); \
    GAPA(C0=__builtin_amdgcn_mfma_f32_32x32x16_bf16(kf[2],qr[1],C0,0,0,0),   P0[10],P0[11],P0[12],P0[13], pw1[0]=PKW(P0,8), pw1[1]=PKW(P0,10), pw1); \
    GAPA(C1=__builtin_amdgcn_mfma_f32_32x32x16_bf16(kf[3],qr[1],C1,0,0,0),   P0[14],P0[15],P1[0],P1[1],   pw1[2]=PKW(P0,12),pw1[3]=PKW(P0,14), pw1); \
    VRD2(0,FI(0)); SBAR(); GAPA(C0=__builtin_amdgcn_mfma_f32_32x32x16_bf16(kf[4],qr[2],C0,0,0,0),   P1[2],P1[3],P1[4],P1[5],     pw2[0]=PKW(P1,0), pw2[1]=PKW(P1,2), pw2); \
    VRD2(1,FI(1)); SBAR(); GAPA(C1=__builtin_amdgcn_mfma_f32_32x32x16_bf16(kf[5],qr[2],C1,0,0,0),   P1[6],P1[7],P1[8],P1[9],     pw2[2]=PKW(P1,4), pw2[3]=PKW(P1,6), pw2); \
    VRD2(2,FI(2)); SBAR(); GAPA(C0=__builtin_amdgcn_mfma_f32_32x32x16_bf16(kf[6],qr[3],C0,0,0,0),   P1[10],P1[11],P1[12],P1[13], pw3[0]=PKW(P1,8), pw3[1]=PKW(P1,10), pw3); \
    VRD2(3,FI(3)); SBAR(); GAPA(C1=__builtin_amdgcn_mfma_f32_32x32x16_bf16(kf[7],qr[3],C1,0,0,0),   P1[14],P1[15],0.f,0.f,       pw3[2]=PKW(P1,12),pw3[3]=PKW(P1,14), pw3); \
    l_reg+=sacc; \
    if(GK){DMA_K((t)+3,sl_cur);} if(GV){DMA_V((t)+1,sl_next);} \
    CMASK(C0,C1,t); \
    { float a=MX3(C0[0],C0[1],C1[0]),b=MX3(C0[2],C0[3],C1[1]); a=MX3(a,C1[2],C1[3]); \
      _Pragma("unroll") for(int r=4;r<16;r+=4){a=MX3(a,C0[r],C0[r+1]);b=MX3(b,C0[r+2],C0[r+3]);a=MX3(a,C1[r],C1[r+1]);b=MX3(b,C1[r+2],C1[r+3]);} \
      float rm=__builtin_fmaxf(a,b); { auto rr=__builtin_amdgcn_permlane32_swap(__float_as_uint(rm),__float_as_uint(rm),false,false); rm=__builtin_fmaxf(__uint_as_float(rr[0]),__uint_as_float(rr[1])); } \
      resc=false; \
      if(__builtin_expect(__any(rm>(float)THRL),0)){ const float dl=__builtin_fmaxf(rm,0.f); mhat+=dl; \
        _Pragma("unroll") for(int r=0;r<16;++r){C0[r]-=dl;C1[r]-=dl;} \
        NEGM_UPD(); \
        const float f=__builtin_amdgcn_exp2f(-dl); l_reg*=f; if(hi==0)wsf[r32]=f; resc=true; } } \
    SBAR(); \
    PVJ(0,C0,0);  VRD2(0,FI(4));  SBAR(); \
    PVJ(1,C0,2);  VRD2(1,FI(5));  SBAR(); \
    PVJ(2,C0,4);  VRD2(2,FI(6));  SBAR(); \
    PVJ(3,C0,6);  VRD2(3,FI(7));  SBAR(); \
    KRD(GL,0); PVJ(4,C0,8);  VRD2(0,FI(8));  SBAR(); \
    KRD(GL,1); PVJ(5,C0,10); VRD2(1,FI(9));  SBAR(); \
    KRD(GL,2); PVJ(6,C0,12); VRD2(2,FI(10)); SBAR(); \
    KRD(GL,3); PVJ(7,C0,14); VRD2(3,FI(11)); SBAR(); \
    PVJ(8,C1,0);  VRD2(0,FI(12)); SBAR(); \
    PVJ(9,C1,2);  VRD2(1,FI(13)); SBAR(); \
    PVJ(10,C1,4); VRD2(2,FI(14)); SBAR(); \
    PVJ(11,C1,6); VRD2(3,FI(15)); SBAR(); \
    PVJ(12,C1,8); PVJ(13,C1,10); PVJ(14,C1,12); PVJ(15,C1,14); \
    }while(0)
  #define STEPX(C0,C1,P0,P1,t,GK,GV,GL) do{ if(MODE==2){ STEP2(C0,C1,P0,P1,t,GK,GV,GL); } else { STEP(C0,C1,P0,P1,t,GK,GV,GL); } }while(0)
  int t=1;
  #undef CMASK
  #define CMASK(P0,P1,t) do{}while(0)
  for(;t+5<NT;t+=2){
    STEPX(pB0,pB1,pA0,pA1,t,true,true,true);     WB_A(); GADV(); RESC(); ROT();
    STEPX(pA0,pA1,pB0,pB1,t+1,true,true,true);   WB_A(); GADV(); RESC(); ROT();
  }
  #undef CMASK
  #define CMASK(P0,P1,t) do{int jb_=(t)-(NT-4); if(jb_>=0)cmask<MODE>(P0,P1,jb_,qrel,hi);}while(0)
  #define ENDW(tt) do{ if((tt)+3<NT){WB_A();} else if((tt)+2<NT){WB_B();} else {WAIT_BAR(0);} }while(0)
  for(;t+1<NT;t+=2){
    STEPX(pB0,pB1,pA0,pA1,t,(t+3<NT),(t+1<NT),(t+1<NT));       ENDW(t);   GADV(); RESC(); ROT();
    STEPX(pA0,pA1,pB0,pB1,t+1,(t+4<NT),(t+2<NT),(t+2<NT));     ENDW(t+1); GADV(); RESC(); ROT();
  }
  STEPX(pB0,pB1,pA0,pA1,NT-1,false,false,false); RESC();
  { float sacc=pB0[0]+pB0[1]; _Pragma("unroll") for(int r=2;r<16;++r)sacc+=pB0[r]; _Pragma("unroll") for(int r=0;r<16;++r)sacc+=pB1[r]; l_reg+=sacc;
    pw0=(u32x4){PKW(pB0,0),PKW(pB0,2),PKW(pB0,4),PKW(pB0,6)};pw1=(u32x4){PKW(pB0,8),PKW(pB0,10),PKW(pB0,12),PKW(pB0,14)};pw2=(u32x4){PKW(pB1,0),PKW(pB1,2),PKW(pB1,4),PKW(pB1,6)};pw3=(u32x4){PKW(pB1,8),PKW(pB1,10),PKW(pB1,12),PKW(pB1,14)};
    SBAR(); pv<NDB>(o,vb0+sl_cur*VM,PAF(0),PAF(1),PAF(2),PAF(3)); }
  #undef PKW
  #undef PAF
  #undef VFR
  #undef PIN
  #undef MX3
  #undef GAPA
  #undef GAPB
  #undef EX
  #undef VRD
  #undef KRD
  #undef STEP
  #undef STEP2
  #undef STEPX
  #undef GAPB2
  #undef VRD2
  #undef FI
  #undef PVJ
  #undef PAFS
  #undef ENDW
  {auto rr=__builtin_amdgcn_permlane32_swap(__float_as_uint(l_reg),__float_as_uint(l_reg),false,false);l_reg=__uint_as_float(rr[0])+__uint_as_float(rr[1]);}
  if(MODE!=1) l_reg=__builtin_fmaxf(l_reg-lcorr*__builtin_amdgcn_exp2f(-mhat),1e-30f);
  if(hi==0)wsf[32+r32]=l_reg;asm volatile("s_waitcnt lgkmcnt(0)":::"memory");
  float rli[16];
  #pragma unroll
  for(int r=0;r<16;++r)rli[r]=__builtin_amdgcn_rcpf(wsf[32+crow(r,hi)]);
  bf16*Ow=Oh+(long)(q0+wid*QBLK)*po; const int rlim=rmax-(q0+wid*QBLK);
  #pragma unroll
  for(int pp=0;pp<NDB/2;++pp){ bf16*stg=(bf16*)(shm+LOST)+wid*2048;
    #pragma unroll
    for(int r=0;r<16;++r){const int orow=crow(r,hi);
      #pragma unroll
      for(int d0=0;d0<2;++d0)stg[orow*64+d0*32+r32]=(bf16)(cvtpk_s(o[2*pp+d0][r]*rli[r],0.f)&0xffffu);}
    asm volatile("s_waitcnt lgkmcnt(0)":::"memory");
    #pragma unroll
    for(int i=0;i<4;++i){const int row=i*8+(lane>>3),ch=lane&7; const u32x4 v=*(const u32x4*)(stg+row*64+ch*8); if(row<rlim) ATTN_STORE16(Ow+pp*ohalf+(long)row*po+ch*8,v);}
    asm volatile("s_waitcnt lgkmcnt(0)":::"memory"); }
  asm volatile("s_waitcnt lgkmcnt(0)\n\ts_barrier":::"memory");
  #undef GADV
  #undef WB_A
  #undef WB_B
  #undef GMSK
  #undef QX
  #undef GPIN
  #undef NEGM_UPD
  #undef DMA_K
  #undef DMA_V
  #undef CMASK
  #undef START
  #undef RESC
  #undef ROT
}
constexpr int ATTN_LDS_BYTES=LDS_BYTES;
#undef SBAR
#undef WAIT_BAR
}
constexpr int GCH_BYTES = 49152, GCH_UNITS = NB * 4 * (LL / 64);
__device__ __forceinline__ int gch_unit(int b, int h, int n) { return (b * 4 + h) * (LL / 64) + n; }

template <int J> struct FwdRow {
    static constexpr int I0 = J + 1, IA = ((I0 + 3) & ~3) < 64 ? ((I0 + 3) & ~3) : 64, NH = IA - I0, NG = (64 - IA) / 4;
};
template <int J> __device__ __forceinline__ void fwd_load(const LAS float* AT, f32x4 (&v)[16], float (&hd)[3]) {
    using R = FwdRow<J>;
#pragma unroll
    for (int q = 0; q < R::NH; ++q) hd[q] = AT[J * 64 + R::I0 + q];
#pragma unroll
    for (int g = 0; g < R::NG; ++g) v[g] = *(const LAS f32x4*)(AT + J * 64 + R::IA + 4 * g);
}
template <int J> struct FwdSubPK {
    static __device__ __forceinline__ void run(f32x2 (&x)[32], const LAS float* AT) {
        using R = FwdRow<J>;
        f32x4 cur[16]; float curh[3];
        fwd_load<J>(AT, cur, curh);
        __builtin_amdgcn_sched_barrier(0);
        const float xj = x[J >> 1][J & 1]; const f32x2 nxj = {-xj, -xj};
#pragma unroll
        for (int q = 0; q < R::NH; ++q) x[(R::I0 + q) >> 1][(R::I0 + q) & 1] -= curh[q] * xj;
#pragma unroll
        for (int g = 0; g < R::NG; ++g) { x[(R::IA + 4 * g) >> 1] = __builtin_elementwise_fma((f32x2){cur[g][0], cur[g][1]}, nxj, x[(R::IA + 4 * g) >> 1]);
            x[((R::IA + 4 * g) >> 1) + 1] = __builtin_elementwise_fma((f32x2){cur[g][2], cur[g][3]}, nxj, x[((R::IA + 4 * g) >> 1) + 1]); }
        __builtin_amdgcn_sched_barrier(0);
        FwdSubPK<J + 1>::run(x, AT);
    }
};
template <> struct FwdSubPK<63> { static __device__ __forceinline__ void run(f32x2 (&)[32], const LAS float*) {} };
template <int J> struct FwdSubRL {
    static __device__ __forceinline__ void run(float (&x)[64], const LAS float* AT) {
        using R = FwdRow<J>;
        f32x4 cur[16]; float curh[3];
        fwd_load<J>(AT, cur, curh);
        __builtin_amdgcn_sched_barrier(0);
        const float xj = x[J];
#pragma unroll
        for (int q = 0; q < R::NH; ++q) x[R::I0 + q] -= curh[q] * xj;
#pragma unroll
        for (int g = 0; g < R::NG; ++g) { x[R::IA + 4 * g] -= cur[g][0] * xj; x[R::IA + 4 * g + 1] -= cur[g][1] * xj; x[R::IA + 4 * g + 2] -= cur[g][2] * xj; x[R::IA + 4 * g + 3] -= cur[g][3] * xj; }
        __builtin_amdgcn_sched_barrier(0);
        FwdSubRL<J + 1>::run(x, AT);
    }
};
template <> struct FwdSubRL<63> { static __device__ __forceinline__ void run(float (&)[64], const LAS float*) {} };

#define LDS_BAR() asm volatile("s_waitcnt lgkmcnt(0)\n\ts_barrier" ::: "memory")
constexpr int GCU_LDS = (3 * 64 * 68 + 128 + 768) * 4;
#ifndef PREP_ABL
#define PREP_ABL 0
#endif
template <bool PK>
__device__ __forceinline__ void gdn_chunk_unit(const MKP& p, int layer, int b, int h, int n, bool active, LAS unsigned char* ldsU, int t_in, int lane_in, int dump = 0, int shi = 0) {
    int t = t_in, lane = lane_in; asm volatile("" : "+v"(t), "+v"(lane));
    constexpr int KS = 68;
    LAS float* Kt = (LAS float*)ldsU;
    LAS float* Qt = Kt + 64 * KS;
    LAS float* Vt = Qt + 64 * KS;
    LAS float* At = Qt;
    LAS float* sc = Vt + 64 * KS;
    LAS float* cwl = sc + 128;
    const float* cw = p.gdn_conv_w + layer * 4 * 768;
    const size_t r0 = (size_t)b * LP + n * 64;
    unsigned char* ub = (dump ? (unsigned char*)p.act : (unsigned char*)p.gch) + (size_t)gch_unit(b, h, n) * GCH_BYTES;
    bf16_t* gW = (bf16_t*)ub; bf16_t* gQd = gW + 4096; bf16_t* gQK = gQd + 4096; bf16_t* gKdT = gQK + 4096; float* gU = (float*)(ub + 32768);
    u32x4 raw2[2][3][4]; float cwv[3] = {0.f, 0.f, 0.f}; float bl = 0.f, al = 0.f;
    if constexpr (PK) { if (active) {
#pragma unroll
        for (int i = 0; i < 3; ++i) { const int q = t + 256 * i, tp = q / 192, c = q % 192; cwv[i] = cw[tp * 768 + (c >> 6) * 256 + h * 64 + (c & 63)]; }
        if (t < 64) { bl = p.gates[(r0 + t) * 16 + 4 + h]; al = p.gates[(r0 + t) * 16 + 8 + h] + p.gdn_dt_bias[layer * 4 + h]; }
        if (!(dump && (PREP_ABL & 1))) {
#pragma unroll
        for (int bt = 0; bt < 2; ++bt) {
#pragma unroll
            for (int it = 0; it < 3; ++it) { const int item = (bt * 3 + it) * 256 + t, row = item / 24, vec = item % 24, ch = (vec >> 3) * 256 + h * 64 + (vec & 7) * 8; const bf16_t* pr = p.proj + (r0 + row) * NPJ + P_GQKV + ch;
#pragma unroll
                for (int tp = 0; tp < 4; ++tp) raw2[bt][it][tp] = *(const u32x4*)(pr - (size_t)(3 - tp) * NPJ); }
        } } } }
    LDS_BAR();
    if (active) { if constexpr (PK) {
#pragma unroll
            for (int i = 0; i < 3; ++i) cwl[t + 256 * i] = cwv[i]; }
        else { for (int q = t; q < 768; q += 256) { const int tp = q / 192, c = q % 192; cwl[q] = cw[tp * 768 + (c >> 6) * 256 + h * 64 + (c & 63)]; } } }
    LDS_BAR();
    if (active && !(dump && (PREP_ABL & 1))) {
        if constexpr (!PK) { if (t < 64) { bl = p.gates[(r0 + t) * 16 + 4 + h]; al = p.gates[(r0 + t) * 16 + 8 + h] + p.gdn_dt_bias[layer * 4 + h]; } }
        if constexpr (PK) {
#pragma unroll
        for (int bt = 0; bt < 2; ++bt) {
#pragma unroll
            for (int it = 0; it < 3; ++it) { const int item = (bt * 3 + it) * 256 + t, row = item / 24, vec = item % 24, part = vec >> 3, d0 = (vec & 7) * 8, ch = part * 256 + h * 64 + d0; float a[8];
#pragma unroll
                for (int e = 0; e < 8; ++e) a[e] = 0.f;
#pragma unroll
                for (int tp = 0; tp < 4; ++tp) { const f32x4 w0 = *(const LAS f32x4*)(cwl + tp * 192 + part * 64 + d0), w1 = *(const LAS f32x4*)(cwl + tp * 192 + part * 64 + d0 + 4); const u32x4 r = raw2[bt][it][tp];
                    a[0] += w0[0] * bflo(r.x); a[1] += w0[1] * bfhi(r.x); a[2] += w0[2] * bflo(r.y); a[3] += w0[3] * bfhi(r.y); a[4] += w1[0] * bflo(r.z); a[5] += w1[1] * bfhi(r.z); a[6] += w1[2] * bflo(r.w); a[7] += w1[3] * bfhi(r.w); }
                float ss = 0.f;
#pragma unroll
                for (int e = 0; e < 8; ++e) { a[e] = a[e] * __builtin_amdgcn_rcpf(1.f + __expf(-a[e])); ss += a[e] * a[e]; }
                ss += __int_as_float(__builtin_amdgcn_update_dpp(0, __float_as_int(ss), 0xB1, 0xf, 0xf, true)); ss += __int_as_float(__builtin_amdgcn_update_dpp(0, __float_as_int(ss), 0x4E, 0xf, 0xf, true));
                ss += __int_as_float(__builtin_amdgcn_update_dpp(0, __float_as_int(ss), 0x141, 0xf, 0xf, true));
                const float rn = part == 2 ? 1.f : rsqrtf(ss + 1e-6f) * (part == 0 ? 0.125f : 1.f);
                LAS float* dst = (part == 0 ? Qt : part == 1 ? Kt : Vt) + row * KS + d0;
                *(LAS f32x4*)dst = (f32x4){a[0] * rn, a[1] * rn, a[2] * rn, a[3] * rn}; *(LAS f32x4*)(dst + 4) = (f32x4){a[4] * rn, a[5] * rn, a[6] * rn, a[7] * rn}; }
        } } else {
#pragma unroll 1
        for (int bt = 0; bt < 2; ++bt) { u32x4 raw[3][4];
#pragma unroll
            for (int it = 0; it < 3; ++it) { const int item = (bt * 3 + it) * 256 + t, row = item / 24, vec = item % 24, ch = (vec >> 3) * 256 + h * 64 + (vec & 7) * 8; const bf16_t* pr = p.proj + (r0 + row) * NPJ + P_GQKV + ch;
#pragma unroll
                for (int tp = 0; tp < 4; ++tp) raw[it][tp] = *(const u32x4*)(pr - (size_t)(3 - tp) * NPJ); }
#pragma unroll
            for (int it = 0; it < 3; ++it) { const int item = (bt * 3 + it) * 256 + t, row = item / 24, vec = item % 24, part = vec >> 3, d0 = (vec & 7) * 8, ch = part * 256 + h * 64 + d0; float a[8];
#pragma unroll
                for (int e = 0; e < 8; ++e) a[e] = 0.f;
#pragma unroll
                for (int tp = 0; tp < 4; ++tp) { const f32x4 w0 = *(const LAS f32x4*)(cwl + tp * 192 + part * 64 + d0), w1 = *(const LAS f32x4*)(cwl + tp * 192 + part * 64 + d0 + 4); const u32x4 r = raw[it][tp];
                    a[0] += w0[0] * bflo(r.x); a[1] += w0[1] * bfhi(r.x); a[2] += w0[2] * bflo(r.y); a[3] += w0[3] * bfhi(r.y); a[4] += w1[0] * bflo(r.z); a[5] += w1[1] * bfhi(r.z); a[6] += w1[2] * bflo(r.w); a[7] += w1[3] * bfhi(r.w); }
                float ss = 0.f;
#pragma unroll
                for (int e = 0; e < 8; ++e) { a[e] = a[e] * __builtin_amdgcn_rcpf(1.f + __expf(-a[e])); ss += a[e] * a[e]; }
                ss += __int_as_float(__builtin_amdgcn_update_dpp(0, __float_as_int(ss), 0xB1, 0xf, 0xf, true)); ss += __int_as_float(__builtin_amdgcn_update_dpp(0, __float_as_int(ss), 0x4E, 0xf, 0xf, true));
                ss += __int_as_float(__builtin_amdgcn_update_dpp(0, __float_as_int(ss), 0x141, 0xf, 0xf, true));
                const float rn = part == 2 ? 1.f : rsqrtf(ss + 1e-6f) * (part == 0 ? 0.125f : 1.f);
                LAS float* dst = (part == 0 ? Qt : part == 1 ? Kt : Vt) + row * KS + d0;
                *(LAS f32x4*)dst = (f32x4){a[0] * rn, a[1] * rn, a[2] * rn, a[3] * rn}; *(LAS f32x4*)(dst + 4) = (f32x4){a[4] * rn, a[5] * rn, a[6] * rn, a[7] * rn}; } }
        }
        if (t < 64) { const float sp = fmaxf(al, 0.f) + __logf(1.f + __expf(-fabsf(al)));
            float gv = -__expf(p.gdn_a_log[layer * 4 + h]) * sp;
            int ll_ = lane; asm volatile("" : "+v"(ll_));
#pragma unroll
            for (int o = 1; o < 64; o <<= 1) { const float t_ = shfl_up_l(gv, o, ll_); if (ll_ >= o) gv += t_; }
            sc[t] = 1.f / (1.f + __expf(-bl)); sc[64 + t] = gv; }
    }
    LDS_BAR();
    float kk[16]; const int gi_ = t & 63, gj0 = (t >> 6) * 16;
    if (active) {
        const float gl = sc[64 + 63];
        if (!(dump && (PREP_ABL & 2))) { const int i = gi_, j0 = gj0; float qk[16]; int zg_ = 0; asm volatile("" : "+v"(zg_));
            if constexpr (PK) {
            f32x2 kk2[16], qk2[16];
#pragma unroll
            for (int jj = 0; jj < 16; ++jj) { kk2[jj] = (f32x2){0.f, 0.f}; qk2[jj] = (f32x2){0.f, 0.f}; }
#pragma unroll 1
            for (int d = 0; d < 64; d += 4) { const f32x4 ki = *(const LAS f32x4*)(Kt + i * KS + d), qi = *(const LAS f32x4*)(Qt + i * KS + d);
                const f32x2 kil = {ki[0], ki[1]}, kih = {ki[2], ki[3]}, qil = {qi[0], qi[1]}, qih = {qi[2], qi[3]};
#pragma unroll
                for (int hb = 0; hb < 2; ++hb) { f32x4 kj[8];
#pragma unroll
                    for (int jj = 0; jj < 8; ++jj) kj[jj] = *(const LAS f32x4*)(Kt + zg_ + (j0 + hb * 8 + jj) * KS + d);
                    __builtin_amdgcn_sched_barrier(0);
#pragma unroll
                    for (int jj = 0; jj < 8; ++jj) { const f32x2 jl = {kj[jj][0], kj[jj][1]}, jh = {kj[jj][2], kj[jj][3]};
                        kk2[hb * 8 + jj] = __builtin_elementwise_fma(kil, jl, kk2[hb * 8 + jj]); kk2[hb * 8 + jj] = __builtin_elementwise_fma(kih, jh, kk2[hb * 8 + jj]);
                        qk2[hb * 8 + jj] = __builtin_elementwise_fma(qil, jl, qk2[hb * 8 + jj]); qk2[hb * 8 + jj] = __builtin_elementwise_fma(qih, jh, qk2[hb * 8 + jj]); }
                    __builtin_amdgcn_sched_barrier(0); } }
#pragma unroll
            for (int jj = 0; jj < 16; ++jj) { kk[jj] = kk2[jj][0] + kk2[jj][1]; qk[jj] = qk2[jj][0] + qk2[jj][1]; }
            } else {
#pragma unroll
            for (int jj = 0; jj < 16; ++jj) { kk[jj] = 0.f; qk[jj] = 0.f; }
#pragma unroll 1
            for (int d = 0; d < 64; d += 4) { const f32x4 ki = *(const LAS f32x4*)(Kt + i * KS + d), qi = *(const LAS f32x4*)(Qt + i * KS + d);
#pragma unroll
                for (int hb = 0; hb < 2; ++hb) { f32x4 kj[8];
#pragma unroll
                    for (int jj = 0; jj < 8; ++jj) kj[jj] = *(const LAS f32x4*)(Kt + zg_ + (j0 + hb * 8 + jj) * KS + d);
                    __builtin_amdgcn_sched_barrier(0);
#pragma unroll
                    for (int jj = 0; jj < 8; ++jj) { kk[hb * 8 + jj] += (ki[0] * kj[jj][0] + ki[1] * kj[jj][1]) + (ki[2] * kj[jj][2] + ki[3] * kj[jj][3]); qk[hb * 8 + jj] += (qi[0] * kj[jj][0] + qi[1] * kj[jj][1]) + (qi[2] * kj[jj][2] + qi[3] * kj[jj][3]); }
                    __builtin_amdgcn_sched_barrier(0); } }
            }
            const float gi = sc[64 + i], bi = sc[i]; unsigned w[8];
#pragma unroll
            for (int jj = 0; jj < 16; ++jj) { const int j = j0 + jj; const float dec = __expf(fminf(gi - sc[64 + j], 0.f));
                kk[jj] = j < i ? bi * kk[jj] * dec : 0.f; qk[jj] = j <= i ? qk[jj] * dec : 0.f; }
#pragma unroll
            for (int jj = 0; jj < 8; ++jj) w[jj] = cvt_pk_bf16(qk[2 * jj], qk[2 * jj + 1]);
            *(u32x4*)(gQK + i * 64 + j0) = (u32x4){w[0], w[1], w[2], w[3]}; *(u32x4*)(gQK + i * 64 + j0 + 8) = (u32x4){w[4], w[5], w[6], w[7]}; }
        if (!(dump && (PREP_ABL & 4))) for (int idx = t; idx < 64 * 32; idx += 256) { const int row = idx >> 5, d = (idx & 31) * 2; const float eg = __expf(sc[64 + row]);
            *(unsigned*)(gQd + row * 64 + d) = cvt_pk_bf16(Qt[row * KS + d] * eg, Qt[row * KS + d + 1] * eg); }
        if (!(dump && (PREP_ABL & 4))) for (int idx = t; idx < 64 * 32; idx += 256) { const int d = idx >> 5, i = (idx & 31) * 2;
            *(unsigned*)(gKdT + d * 64 + i) = cvt_pk_bf16(Kt[i * KS + d] * __expf(gl - sc[64 + i]), Kt[(i + 1) * KS + d] * __expf(gl - sc[64 + i + 1])); }
        if (t == 0) (dump ? (float*)((unsigned char*)p.act + (64u << 20)) : p.gcd)[gch_unit(b, h, n)] = __expf(gl);
    }
    LDS_BAR();
    if (active) {
#pragma unroll
        for (int jj = 0; jj < 16; ++jj) At[(gj0 + jj) * 64 + gi_] = kk[jj];
        if (t < 64) cwl[t] = sc[t] * __expf(sc[64 + t]); }
    LDS_BAR();
    const int ts = shi ? t - 128 : t;
    if (active && ts >= 0 && ts < 128 && !(dump && (PREP_ABL & 8))) { const int c = ts & 63;
        if constexpr (PK) { f32x2 x[32];
            { int zi_ = 0; asm volatile("" : "+v"(zi_));
              const LAS float* src = (ts < 64 ? Vt : Kt) + c; const LAS float* fac = (ts < 64 ? sc : cwl) + zi_;
#pragma unroll
              for (int hh = 0; hh < 2; ++hh) { float xv[32], fv[32];
#pragma unroll
                  for (int i = 0; i < 32; ++i) { xv[i] = src[(32 * hh + i) * KS]; fv[i] = fac[32 * hh + i]; }
                  __builtin_amdgcn_sched_barrier(0);
#pragma unroll
                  for (int i = 0; i < 32; ++i) x[(32 * hh + i) >> 1][i & 1] = xv[i] * fv[i];
                  __builtin_amdgcn_sched_barrier(0); } }
            if (!(dump && (PREP_ABL & 16))) { int z_ = 0; asm volatile("" : "+v"(z_)); FwdSubPK<0>::run(x, At + z_); }
            if (ts < 64) {
#pragma unroll
                for (int i = 0; i < 64; ++i) gU[i * 64 + c] = x[i >> 1][i & 1]; }
            else {
#pragma unroll
                for (int i = 0; i < 64; ++i) gW[i * 64 + c] = (bf16_t)(cvt_pk_bf16(x[i >> 1][i & 1], 0.f) & 0xffffu); }
        } else { float x[64];
#pragma unroll
            for (int i = 0; i < 64; ++i) x[i] = ts < 64 ? sc[i] * Vt[i * KS + c] : sc[i] * __expf(sc[64 + i]) * Kt[i * KS + c];
            { int z_ = 0; asm volatile("" : "+v"(z_)); FwdSubRL<0>::run(x, At + z_); }
            if (ts < 64) {
#pragma unroll
                for (int i = 0; i < 64; ++i) gU[i * 64 + c] = x[i]; }
            else {
#pragma unroll
                for (int i = 0; i < 64; ++i) gW[i * 64 + c] = (bf16_t)(cvt_pk_bf16(x[i], 0.f) & 0xffffu); } } }
}
__device__ __forceinline__ void phase_gdn_chunk_prep(const MKP& p, int layer, int vcu, int G, LAS unsigned char* lds, int tid, int lane, int dump = 0) {
    const int hf = tid >> 8, t = tid & 255; constexpr int NU = NB * 4 * (LL / 64 - 2);
    for (int u0 = vcu * 2; u0 < NU; u0 += G * 2) { const int u = u0 + hf; const bool active = u < NU; const int uu = active ? u : 0;
        const int bh = uu / (LL / 64 - 2), n = 2 + uu % (LL / 64 - 2);
        gdn_chunk_unit<true>(p, layer, bh >> 2, bh & 3, n, active, lds + hf * GCU_LDS, t, lane, dump, hf); }
    __syncthreads();
}

struct ScanG { static constexpr int AMAT = 8192, UOFF = 4 * AMAT, UROW = 272, CDOFF = UOFF + 64 * UROW, STG = CDOFF + 16, PRIV = 2 * STG, SMAT = 2048, NCH = LL / 64; };
__device__ __forceinline__ void gdn_scan_step(const MKP& p, int b, int h, int n, const LAS unsigned char* st, f32x4 (&S)[4], LAS unsigned char* StT, LAS unsigned char* VnT, int wave, int c16, int kg, int a0, int a1, int wb) {
    constexpr int AMAT = ScanG::AMAT, UOFF = ScanG::UOFF, UROW = ScanG::UROW;
    bf16x8 sb[2], wf[4][2], qdf[4][2], qkf[4][2], kdf[4][2]; float uu[16];
    sb[0] = *(const LAS bf16x8*)(StT + a0); sb[1] = *(const LAS bf16x8*)(StT + a1);
#pragma unroll
    for (int rt = 0; rt < 4; ++rt) { wf[rt][0] = *(const LAS bf16x8*)(st + rt * 2048 + a0); wf[rt][1] = *(const LAS bf16x8*)(st + rt * 2048 + a1); }
#pragma unroll
    for (int rt = 0; rt < 4; ++rt)
#pragma unroll
        for (int i = 0; i < 4; ++i) uu[4 * rt + i] = *(const LAS float*)(st + UOFF + (16 * rt + 4 * kg + i) * UROW + (16 * wave + c16) * 4);
    const float cd = *(const LAS float*)(st + ScanG::CDOFF);
#pragma unroll
    for (int rt = 0; rt < 4; ++rt) { qdf[rt][0] = *(const LAS bf16x8*)(st + AMAT + rt * 2048 + a0); qdf[rt][1] = *(const LAS bf16x8*)(st + AMAT + rt * 2048 + a1); }
#pragma unroll
    for (int rt = 0; rt < 4; ++rt) { kdf[rt][0] = *(const LAS bf16x8*)(st + 3 * AMAT + rt * 2048 + a0); kdf[rt][1] = *(const LAS bf16x8*)(st + 3 * AMAT + rt * 2048 + a1); }
#pragma unroll
    for (int rt = 0; rt < 4; ++rt) { qkf[rt][0] = *(const LAS bf16x8*)(st + 2 * AMAT + rt * 2048 + a0); qkf[rt][1] = *(const LAS bf16x8*)(st + 2 * AMAT + rt * 2048 + a1); }
    __builtin_amdgcn_sched_barrier(0);
#pragma unroll
    for (int rt = 0; rt < 4; ++rt) { f32x4 acc = f32x4{0.f, 0.f, 0.f, 0.f};
        acc = __builtin_amdgcn_mfma_f32_16x16x32_bf16(wf[rt][0], sb[0], acc, 0, 0, 0); acc = __builtin_amdgcn_mfma_f32_16x16x32_bf16(wf[rt][1], sb[1], acc, 0, 0, 0);
        *(LAS u32x2*)(VnT + (wb ^ (rt << 5))) = (u32x2){cvt_pk_bf16_m(uu[4 * rt] - acc[0], uu[4 * rt + 1] - acc[1]), cvt_pk_bf16_m(uu[4 * rt + 2] - acc[2], uu[4 * rt + 3] - acc[3])}; }
    asm volatile("s_waitcnt lgkmcnt(0)" ::: "memory");
    bf16x8 vb[2]; vb[0] = *(const LAS bf16x8*)(VnT + a0); vb[1] = *(const LAS bf16x8*)(VnT + a1);
#pragma unroll
    for (int kt = 0; kt < 4; ++kt) { f32x4 acc = S[kt] * cd;
        acc = __builtin_amdgcn_mfma_f32_16x16x32_bf16(kdf[kt][0], vb[0], acc, 0, 0, 0); acc = __builtin_amdgcn_mfma_f32_16x16x32_bf16(kdf[kt][1], vb[1], acc, 0, 0, 0);
        S[kt] = acc;
        *(LAS u32x2*)(StT + (wb ^ (kt << 5))) = (u32x2){cvt_pk_bf16_m(acc[0], acc[1]), cvt_pk_bf16_m(acc[2], acc[3])}; }
    float* og = p.gdn_o + ((size_t)b * LP + (size_t)n * 64) * 256 + h * 64 + 16 * wave + c16;
#pragma unroll
    for (int rt = 0; rt < 4; ++rt) { f32x4 acc = f32x4{0.f, 0.f, 0.f, 0.f};
        acc = __builtin_amdgcn_mfma_f32_16x16x32_bf16(qdf[rt][0], sb[0], acc, 0, 0, 0); acc = __builtin_amdgcn_mfma_f32_16x16x32_bf16(qdf[rt][1], sb[1], acc, 0, 0, 0);
        acc = __builtin_amdgcn_mfma_f32_16x16x32_bf16(qkf[rt][0], vb[0], acc, 0, 0, 0); acc = __builtin_amdgcn_mfma_f32_16x16x32_bf16(qkf[rt][1], vb[1], acc, 0, 0, 0);
#pragma unroll
        for (int i = 0; i < 4; ++i) og[(size_t)(16 * rt + 4 * kg + i) * 256] = acc[i]; }
}
__device__ __forceinline__ void gdn_scan_chunked(const MKP& p, int layer, int b, int h, LAS unsigned char* lds, int tid) {
    gdn_chunk_unit<false>(p, layer, b, h, 1, tid < 256, lds + (tid >> 8) * GCU_LDS, tid & 255, tid & 63);
    asm volatile("s_waitcnt vmcnt(0)" ::: "memory"); __syncthreads();
    constexpr int AMAT = ScanG::AMAT, UOFF = ScanG::UOFF, UROW = ScanG::UROW, STG = ScanG::STG, PRIV = ScanG::PRIV, SMAT = ScanG::SMAT, NCH = ScanG::NCH;
    const int lane = tid & 63, wave = __builtin_amdgcn_readfirstlane(tid >> 6);
    const int unit0 = gch_unit(b, h, 0);
    if (wave < 4) {
        const int c16 = lane & 15, kg = lane >> 4, x7 = c16 & 7;
        const int a0 = c16 * 128 + ((kg ^ x7) << 4), a1 = a0 ^ 64;
        const int wb = c16 * 128 + ((((kg >> 1) ^ x7)) << 4) + (kg & 1) * 8;
        f32x4 S[4];
#pragma unroll
        for (int i = 0; i < 4; ++i) S[i] = f32x4{0.f, 0.f, 0.f, 0.f};
        LAS unsigned char* StT = lds + PRIV + wave * 2 * SMAT; LAS unsigned char* VnT = StT + SMAT;
#pragma unroll
        for (int i = 0; i < 2; ++i) *(LAS u32x4*)(StT + c16 * 128 + kg * 32 + i * 16) = (u32x4){0u, 0u, 0u, 0u};
        __syncthreads();
        for (int n = 1; n < NCH; ++n) {
            gdn_scan_step(p, b, h, n, lds + (n & 1) * STG, S, StT, VnT, wave, c16, kg, a0, a1, wb);
            __syncthreads(); }
    } else {
        const int t2 = tid - 256;
        f32x4 ldA[12], ldB[12]; float cdA = 0.f, cdB = 0.f;
#define SC_LOADX(L_, C_, n_) do { const unsigned char* src_ = (const unsigned char*)p.gch + (size_t)(unit0 + (n_)) * GCH_BYTES; _Pragma("unroll") for (int i = 0; i < 12; ++i) L_[i] = *(const f32x4*)(src_ + (size_t)(i * 256 + t2) * 16); C_ = p.gcd[unit0 + (n_)]; } while (0)
#define SC_STOREX(L_, C_, st_) do { LAS unsigned char* dst_ = lds + (st_) * STG; \
        _Pragma("unroll") for (int i = 0; i < 8; ++i) { const int o16 = i * 256 + t2, row = (o16 >> 3) & 63; *(LAS f32x4*)(dst_ + (o16 >> 9) * AMAT + row * 128 + (((o16 & 7) ^ (row & 7)) << 4)) = L_[i]; } \
        _Pragma("unroll") for (int i = 0; i < 4; ++i) { const int u16 = i * 256 + t2; *(LAS f32x4*)(dst_ + UOFF + (u16 >> 4) * UROW + (u16 & 15) * 16) = L_[8 + i]; } \
        if (t2 == 0) *(LAS float*)(dst_ + ScanG::CDOFF) = C_; } while (0)
        SC_LOADX(ldA, cdA, 1); SC_STOREX(ldA, cdA, 1);
        SC_LOADX(ldA, cdA, 2); SC_LOADX(ldB, cdB, 3);
        __syncthreads();
        for (int n = 1; n < NCH; n += 2) {
            if (n + 1 < NCH) { SC_STOREX(ldA, cdA, 0); if (n + 3 < NCH) SC_LOADX(ldA, cdA, n + 3); }
            __syncthreads();
            if (n + 1 >= NCH) break;
            if (n + 2 < NCH) { SC_STOREX(ldB, cdB, 1); if (n + 4 < NCH) SC_LOADX(ldB, cdB, n + 4); }
            __syncthreads();
        }
#undef SC_LOADX
#undef SC_STOREX
    }
}

__device__ __forceinline__ void gdn_scan_chunked_g(const MKP& p, int b, int h, LAS unsigned char* lds, int tid) {
    typedef float f32x16 __attribute__((ext_vector_type(16)));
    constexpr int AROW = 144, AMAT = 64 * AROW, STG = 4 * AMAT + 16384, PRIV = 2 * STG, SROW = 144, SMAT = 32 * SROW;
    const int lane = tid & 63, wave = __builtin_amdgcn_readfirstlane(tid >> 6), r32 = lane & 31, hi = lane >> 5;
    const int unit0 = gch_unit(b, h, 0);
    f32x4 ld[6]; float cdn = 0.f;
#define SC_LOAD(n_) do { const unsigned char* src_ = (const unsigned char*)p.gch + (size_t)(unit0 + (n_)) * GCH_BYTES; _Pragma("unroll") for (int i = 0; i < 6; ++i) ld[i] = *(const f32x4*)(src_ + (size_t)(i * 512 + tid) * 16); cdn = p.gcd[unit0 + (n_)]; } while (0)
#define SC_STORE(st_) do { LAS unsigned char* dst_ = lds + (st_) * STG; _Pragma("unroll") for (int i = 0; i < 6; ++i) { const int off = (i * 512 + tid) * 16; \
        if (off < 32768) { const int m = off >> 13, wi = off & 8191; *(LAS f32x4*)(dst_ + m * AMAT + (wi >> 7) * AROW + (wi & 127)) = ld[i]; } else *(LAS f32x4*)(dst_ + 4 * AMAT + (off - 32768)) = ld[i]; } } while (0)
    f32x16 S[2]; S[0] = f32x16{}; S[1] = f32x16{};
    LAS unsigned char* StT = lds + PRIV + wave * 2 * SMAT; LAS unsigned char* VnT = StT + SMAT;
    if (wave < 2) {
#pragma unroll
        for (int i = 0; i < 4; ++i) *(LAS u32x4*)(StT + r32 * SROW + hi * 64 + i * 16) = (u32x4){0u, 0u, 0u, 0u};
    }
    __syncthreads();
    for (int n = 1; n < LL / 64; ++n) {
        const int cur = n & 1;
        if (wave < 2) {
            const unsigned char* st = (const unsigned char*)p.gch + (size_t)(unit0 + n) * GCH_BYTES; const unsigned char* Wm = st, *Qdm = st + 8192, *QKm = st + 16384, *KdTm = st + 24576; const float* Um = (const float*)(st + 32768); const float cd = p.gcd[unit0 + n];
            bf16x8 sb[4], vb[4];
#pragma unroll
            for (int s = 0; s < 4; ++s) sb[s] = *(const LAS bf16x8*)(StT + r32 * SROW + (16 * s + 8 * hi) * 2);
#pragma unroll
            for (int ct = 0; ct < 2; ++ct) { f32x16 acc = f32x16{};
#pragma unroll
                for (int s = 0; s < 4; ++s) acc = __builtin_amdgcn_mfma_f32_32x32x16_bf16(*(const bf16x8*)(Wm + (32 * ct + r32) * 128 + (16 * s + 8 * hi) * 2), sb[s], acc, 0, 0, 0);
#pragma unroll
                for (int g4 = 0; g4 < 4; ++g4) { float v4[4];
#pragma unroll
                    for (int i = 0; i < 4; ++i) v4[i] = Um[(32 * ct + 8 * g4 + 4 * hi + i) * 64 + 32 * wave + r32] - acc[4 * g4 + i];
                    *(LAS u32x2*)(VnT + r32 * SROW + (32 * ct + 8 * g4 + 4 * hi) * 2) = (u32x2){cvt_pk_bf16_m(v4[0], v4[1]), cvt_pk_bf16_m(v4[2], v4[3])}; } }
            asm volatile("s_waitcnt lgkmcnt(0)" ::: "memory");
#pragma unroll
            for (int s = 0; s < 4; ++s) vb[s] = *(const LAS bf16x8*)(VnT + r32 * SROW + (16 * s + 8 * hi) * 2);
            float* og = p.gdn_o + ((size_t)b * LP + (size_t)n * 64) * 256 + h * 64 + 32 * wave + r32;
#pragma unroll
            for (int ct = 0; ct < 2; ++ct) { f32x16 acc = f32x16{};
#pragma unroll
                for (int s = 0; s < 4; ++s) acc = __builtin_amdgcn_mfma_f32_32x32x16_bf16(*(const bf16x8*)(Qdm + (32 * ct + r32) * 128 + (16 * s + 8 * hi) * 2), sb[s], acc, 0, 0, 0);
#pragma unroll
                for (int s = 0; s < 4; ++s) acc = __builtin_amdgcn_mfma_f32_32x32x16_bf16(*(const bf16x8*)(QKm + (32 * ct + r32) * 128 + (16 * s + 8 * hi) * 2), vb[s], acc, 0, 0, 0);
#pragma unroll
                for (int r = 0; r < 16; ++r) og[(size_t)(32 * ct + (r & 3) + 8 * (r >> 2) + 4 * hi) * 256] = acc[r]; }
#pragma unroll
            for (int kt = 0; kt < 2; ++kt) { f32x16 acc = S[kt] * cd;
#pragma unroll
                for (int s = 0; s < 4; ++s) acc = __builtin_amdgcn_mfma_f32_32x32x16_bf16(*(const bf16x8*)(KdTm + (32 * kt + r32) * 128 + (16 * s + 8 * hi) * 2), vb[s], acc, 0, 0, 0);
                S[kt] = acc;
#pragma unroll
                for (int g4 = 0; g4 < 4; ++g4) *(LAS u32x2*)(StT + r32 * SROW + (32 * kt + 8 * g4 + 4 * hi) * 2) = (u32x2){cvt_pk_bf16_m(acc[4 * g4], acc[4 * g4 + 1]), cvt_pk_bf16_m(acc[4 * g4 + 2], acc[4 * g4 + 3])}; }
        }
        __syncthreads();
    }
#undef SC_LOAD
#undef SC_STORE
}

#define RB(x) bflo(cvt_pk_bf16((x), 0.f) & 0xffffu)
__device__ __forceinline__ void gdn_scan_simple(const MKP& p, int b, int h, LAS unsigned char* lds, int tid) {
    LAS float* S = (LAS float*)lds;
    LAS float* Vn = S + 4096;
    LAS float* Sn = Vn + 4096;
    for (int i = tid; i < 4096; i += NTHR) S[i] = 0.f;
    __syncthreads();
    for (int n = 1; n < LL / 64; ++n) {
        const unsigned char* ub = (const unsigned char*)p.gch + (size_t)gch_unit(b, h, n) * GCH_BYTES;
        const bf16_t* gW = (const bf16_t*)ub; const bf16_t* gQd = gW + 4096; const bf16_t* gQK = gQd + 4096; const bf16_t* gKdT = gQK + 4096; const float* gU = (const float*)(ub + 32768);
        const float cd = p.gcd[gch_unit(b, h, n)];
        for (int e = tid; e < 4096; e += NTHR) { const int c = e >> 6, v = e & 63; float a = gU[e];
            for (int k = 0; k < 64; ++k) a -= bf2f(gW[c * 64 + k]) * RB(S[k * 64 + v]);
            Vn[e] = RB(a); }
        __syncthreads();
        for (int e = tid; e < 4096; e += NTHR) { const int c = e >> 6, v = e & 63; float a = 0.f;
            for (int k = 0; k < 64; ++k) a += bf2f(gQd[c * 64 + k]) * RB(S[k * 64 + v]) + bf2f(gQK[c * 64 + k]) * Vn[k * 64 + v];
            p.gdn_o[((size_t)b * LP + (size_t)n * 64 + c) * 256 + h * 64 + v] = a;
            float s = cd * S[e];
            for (int cc = 0; cc < 64; ++cc) s += bf2f(gKdT[c * 64 + cc]) * Vn[cc * 64 + v];
            Sn[e] = s; }
        __syncthreads();
        for (int e = tid; e < 4096; e += NTHR) S[e] = Sn[e];
        __syncthreads();
    }
}

constexpr int GSTRIDE = LL + 256;
constexpr int N_ATT_ITEMS = 33 * 24;
constexpr float LOG2E = 1.4426950408889634f;

constexpr int FOX_SEGS = (GSTRIDE + 511) / 512, FOX_WGS = NB * 4 * FOX_SEGS;
__device__ __forceinline__ void fox_seg_scan(const MKP& p, int layer, int bx, LAS unsigned char* lds, int tid, int lane, int wave) {
    if (bx >= FOX_WGS) return;
    const int bh = bx / FOX_SEGS, seg = bx % FOX_SEGS, b = bh >> 2, h = bh & 3, t = seg * 512 + tid; const float fb = p.fox_forget_b[layer * 4 + h];
    volatile LAS float* wt = (volatile LAS float*)(lds + LDS_MISC + 128);
    float ls = 0.f;
    if (t >= NLEAD && t < LL) { const float z = p.gates[((size_t)b * LP + t) * 16 + h] + fb; ls = fminf(z, 0.f) - __logf(1.f + __expf(-fabsf(z))); }
#pragma unroll
    for (int o = 1; o < 64; o <<= 1) { const float u = shfl_up_l(ls, o, lane); if (lane >= o) ls += u; }
    if (lane == 63) wt[wave] = ls;
    __syncthreads();
    float pre = 0.f;
    for (int w = 0; w < wave; ++w) pre += wt[w];
    ls += pre;
    p.fox_loc[(size_t)bh * (FOX_SEGS * 512) + t] = ls;
    if (tid == 511) p.fox_tot[bh * 32 + seg] = ls;
    __syncthreads();
}
__device__ __forceinline__ void fox_finalize(const MKP& p, int layer, int bx, int tid, int lane) {
    if (bx >= FOX_WGS) return;
    const int bh = bx / FOX_SEGS, seg = bx % FOX_SEGS, b = bh >> 2, h = bh & 3, t = seg * 512 + tid;
    float nq = 0.f, nk = 0.f;
    { const int t0 = seg * 512 + (tid & ~63), c = lane & 7; u32x4 wq[8], wk[8];
#pragma unroll
      for (int i = 0; i < 8; ++i) { int row = t0 + 8 * i + (lane >> 3); row = row < LL ? row : LL - 1; const bf16_t* pr = p.proj + ((size_t)b * LP + row) * NPJ + h * 64 + 8 * c;
          wq[i] = *(const u32x4*)(pr + P_FQ); wk[i] = *(const u32x4*)(pr + P_FK); }
      float tot[FOX_SEGS];
#pragma unroll
      for (int s2 = 0; s2 < FOX_SEGS; ++s2) tot[s2] = p.fox_tot[bh * 32 + s2];
      double base = 0.0;
#pragma unroll
      for (int s2 = 0; s2 < FOX_SEGS; ++s2) base += s2 < seg ? (double)tot[s2] : 0.0;
      if (t < GSTRIDE) {
          const float loc = p.fox_loc[(size_t)bh * (FOX_SEGS * 512) + t];
          const float gv = t < NLEAD ? -30000.f : (t < LL ? (float)(-(base + (double)loc) * (double)LOG2E) : 0.f);
          const unsigned p1 = cvt_pk_bf16(gv, 0.f) & 0xffffu; const float r1 = gv - __uint_as_float(p1 << 16);
          const unsigned p2 = cvt_pk_bf16(r1, 0.f) & 0xffffu; const float r2 = r1 - __uint_as_float(p2 << 16);
          const unsigned p3 = cvt_pk_bf16(r2, 0.f) & 0xffffu;
          p.Gk[(size_t)bh * GSTRIDE + t] = (unsigned long long)(p1 | (p2 << 16)) | ((unsigned long long)(p3 | (0x3F80u << 16)) << 32);
          p.Gf[(size_t)bh * GSTRIDE + t] = gv; }
#pragma unroll
      for (int i = 0; i < 8; ++i) { const int row = t0 + 8 * i + (lane >> 3); const u32x4 q4 = wq[i], k4 = wk[i];
          float sq = (bflo(q4.x) * bflo(q4.x) + bfhi(q4.x) * bfhi(q4.x)) + (bflo(q4.y) * bflo(q4.y) + bfhi(q4.y) * bfhi(q4.y)) + (bflo(q4.z) * bflo(q4.z) + bfhi(q4.z) * bfhi(q4.z)) + (bflo(q4.w) * bflo(q4.w) + bfhi(q4.w) * bfhi(q4.w));
          float sk = (bflo(k4.x) * bflo(k4.x) + bfhi(k4.x) * bfhi(k4.x)) + (bflo(k4.y) * bflo(k4.y) + bfhi(k4.y) * bfhi(k4.y)) + (bflo(k4.z) * bflo(k4.z) + bfhi(k4.z) * bfhi(k4.z)) + (bflo(k4.w) * bflo(k4.w) + bfhi(k4.w) * bfhi(k4.w));
          sq += __int_as_float(__builtin_amdgcn_update_dpp(0, __float_as_int(sq), 0xB1, 0xf, 0xf, true)); sk += __int_as_float(__builtin_amdgcn_update_dpp(0, __float_as_int(sk), 0xB1, 0xf, 0xf, true));
          sq += __int_as_float(__builtin_amdgcn_update_dpp(0, __float_as_int(sq), 0x4E, 0xf, 0xf, true)); sk += __int_as_float(__builtin_amdgcn_update_dpp(0, __float_as_int(sk), 0x4E, 0xf, 0xf, true));
          sq += __int_as_float(__builtin_amdgcn_update_dpp(0, __float_as_int(sq), 0x141, 0xf, 0xf, true)); sk += __int_as_float(__builtin_amdgcn_update_dpp(0, __float_as_int(sk), 0x141, 0xf, 0xf, true));
          if (row >= NLEAD && row < LL) { nq = fmaxf(nq, sq); nk = fmaxf(nk, sk); } } }
    nq = wave_max(nq); nk = wave_max(nk);
    if (lane == 0) { float* mx = (float*)(p.ctl + 196608 + layer * 4096) + ((bh * FOX_SEGS + seg) * 8 + (tid >> 6)) * 2; mx[0] = nq; mx[1] = nk; }
}

__device__ __forceinline__ void phase_mixer_attn(const MKP& p, int layer, int qslot, char* lds_gen, LAS unsigned char* lds, int tid, int bx) {
    if (bx < NB * 4 && qslot < 2) {
        gdn_scan_chunked(p, layer, bx >> 2, bx & 3, lds, tid);
        __syncthreads();
#if PROBE_SUB == 103
        gdn_scan_chunked(p, layer, bx >> 2, bx & 3, lds, tid);
        __syncthreads();
#endif
        }
    volatile LAS int* misc = (volatile LAS int*)(lds + LDS_MISC);
    unsigned* qctr = p.ctl + 1024 + qslot * 64;
    for (;;) {
        if (tid == 0) misc[0] = (int)atomicAdd(qctr, 1u);
        __syncthreads(); const int item = __builtin_amdgcn_readfirstlane(misc[0]); __syncthreads();
        if (item >= N_ATT_ITEMS) break;
        int tid_u = tid; asm volatile("" : "+v"(tid_u));
        const int qb = 32 - item / 24, sub = item % 24;
        const int q0 = qb == 0 ? 0 : qb * 256 - 128, rmax = qb == 0 ? 128 : LL;
#ifdef ATT_ABL
        if (qslot >= 2 && ((ATT_ABL & 1) ? sub < 16 : sub >= 16)) continue;
#endif
        if (sub < 16) { const int b = sub >> 3, h = (sub >> 1) & 3, s = sub & 1; const bf16_t* base = p.proj + (size_t)b * LP * NPJ;
            attn_body::attn_unit<2, 8>(q0, base + P_DQ + h * 128 + s * 64, base + P_DK + h * 128 + s * 64, base + P_DV + h * 128,
                                       (qslot >= 2 ? p.act : p.tmpO) + ((size_t)(h * 4 + s * 2) * MP + (size_t)b * LP) * 64, 64, nullptr, (float)NLEAD, lds_gen, tid_u, (long)MP * 64, 0, rmax);
        } else { const int f = sub - 16, b = f >> 2, h = f & 3; const bf16_t* base = p.proj + (size_t)b * LP * NPJ;
            int tile0 = 0;
            if (qb > 0) { const float* mx = (const float*)(p.ctl + 196608 + layer * 4096) + (size_t)(b * 4 + h) * FOX_SEGS * 16; const float* gf = p.Gf + (size_t)(b * 4 + h) * GSTRIDE;
                float mq = 0.f, mk = 0.f;
#pragma unroll
                for (int q3 = 0; q3 < 3; ++q3) { const int sl = (tid & 63) + 64 * q3; if (sl < FOX_SEGS * 8) { mq = fmaxf(mq, mx[sl * 2]); mk = fmaxf(mk, mx[sl * 2 + 1]); } }
                mq = wave_max(mq); mk = wave_max(mk);
                const float thr = gf[q0] - (2.f * sqrtf(mq * mk) + 230.f); const int ntf = (q0 + 256) / 64, ln = tid & 63; int c = 0;
#pragma unroll
                for (int q3 = 0; q3 < 3; ++q3) { const int tt = ln + 64 * q3; const bool sk = tt < ntf - 4 && gf[tt * 64 + 63] < thr; c += __builtin_popcountll(__ballot(sk)); }
                tile0 = c & ~1; }
            attn_body::attn_unit<1, 60>(q0, base + P_FQ + h * 64, base + P_FK + h * 64, base + P_FV + h * 64,
                                        (qslot >= 2 ? p.act + (size_t)32 * MP * 64 : p.mixcat) + (size_t)b * LP * DM + 512 + h * 64, DM, p.Gk + (size_t)(b * 4 + h) * GSTRIDE, 0.f, lds_gen, tid_u, 0, tile0, rmax);
        }
    }
}

__device__ __forceinline__ void phase_diff_combine(const MKP& p, int layer, int gw, int ngw, int lane) {
    const float* lv = p.diff_lambda + layer * 256; const float* sg = p.diff_subln_g + layer * 128;
    const float lam_init = 0.8f - 0.6f * __expf(-0.3f * (float)layer);
    const float lam = __expf(wave_sum(lv[lane] * lv[64 + lane])) - __expf(wave_sum(lv[128 + lane] * lv[192 + lane])) + lam_init;
    const float g0 = sg[lane] * (1.f - lam_init), g1 = sg[64 + lane] * (1.f - lam_init); const float ng = p.gdn_norm_g[layer * 64 + lane];
    for (int row = gw; row < MP; row += ngw) { if ((row % LP) < NLEAD) { bf16_t* o = p.mixcat + (size_t)row * DM;
#pragma unroll
            for (int h = 0; h < 4; ++h) { o[h * 128 + lane] = 0; o[h * 128 + 64 + lane] = 0; o[768 + h * 64 + lane] = 0; } } }
    unsigned short a[4][4], na[4][4]; float ov[4], nov[4]; unsigned short zz[4], nzz[4];
#define D2_LOAD(row_, A_, O_, Z_) do { _Pragma("unroll") for (int h = 0; h < 4; ++h) { \
            _Pragma("unroll") for (int k = 0; k < 4; ++k) A_[h][k] = p.tmpO[((size_t)(h * 4 + k) * MP + (row_)) * 64 + lane]; \
            O_[h] = p.gdn_o[(size_t)(row_) * 256 + h * 64 + lane]; Z_[h] = p.proj[(size_t)(row_) * NPJ + P_GZ + h * 64 + lane]; } } while (0)
    int row = gw; while (row < MP && (row % LP) < NLEAD) row += ngw;
    if (row < MP) D2_LOAD(row, a, ov, zz);
    while (row < MP) { bf16_t* o = p.mixcat + (size_t)row * DM;
        int rn = row + ngw; while (rn < MP && (rn % LP) < NLEAD) rn += ngw;
        if (rn < MP) D2_LOAD(rn, na, nov, nzz);
#pragma unroll
        for (int h = 0; h < 4; ++h) { const float o0 = bf2f(a[h][0]) - lam * bf2f(a[h][2]), o1 = bf2f(a[h][1]) - lam * bf2f(a[h][3]);
            const float r = rsqrtf(wave_sum(o0 * o0 + o1 * o1) * (1.f / 128.f) + 1e-5f);
            o[h * 128 + lane] = (bf16_t)(cvt_pk_bf16(o0 * r * g0, 0.f) & 0xffffu); o[h * 128 + 64 + lane] = (bf16_t)(cvt_pk_bf16(o1 * r * g1, 0.f) & 0xffffu);
            const float rr = rsqrtf(wave_sum(ov[h] * ov[h]) * (1.f / 64.f) + 1e-6f); const float z = bf2f(zz[h]);
            o[768 + h * 64 + lane] = (bf16_t)(cvt_pk_bf16(ov[h] * rr * ng * z * __builtin_amdgcn_rcpf(1.f + __expf(-z)), 0.f) & 0xffffu); }
        row = rn;
#pragma unroll
        for (int h = 0; h < 4; ++h) { ov[h] = nov[h]; zz[h] = nzz[h];
#pragma unroll
            for (int k = 0; k < 4; ++k) a[h][k] = na[h][k]; }
    }
#undef D2_LOAD
}

#ifndef PROBE_SUB
#define PROBE_SUB -1
#endif
#ifndef PROBE_NREP
#define PROBE_NREP 1
#endif
constexpr int PH_PER_LAYER = 9, N_PHASES = PROBE_SUB == 100 ? 2 + 2 * PH_PER_LAYER : (PROBE_SUB >= 0 ? 1 + 2 * (PH_PER_LAYER + PROBE_NREP) : 1 + 2 * PH_PER_LAYER);

template <class T> __device__ __forceinline__ T* lnd_global(T* x) { __attribute__((address_space(1))) T* g = (__attribute__((address_space(1))) T*)x; asm volatile("" : "+s"(g)); return (T*)g; }
#define LND(x) x = lnd_global(x)
__global__ void __launch_bounds__(NTHR, 2) mk_fwd(MKP p) {
    extern __shared__ __attribute__((aligned(16))) unsigned char lds_raw[];
    LAS unsigned char* lds0 = (LAS unsigned char*)lds_raw;
    { volatile LAS unsigned* st0 = (volatile LAS unsigned*)(lds0 + LDS_MISC + 64); if (threadIdx.x < 2) st0[threadIdx.x] = 0u; __syncthreads(); }
    XcdBarrier bar = xcd_barrier_post(p.ctl + 4096, (volatile LAS unsigned*)(lds0 + LDS_MISC + 64));
    const int lo = p.ph_lo, hi = p.ph_hi;
    const int wave_s = __builtin_amdgcn_readfirstlane((int)threadIdx.x >> 6);
#ifndef PROBE_SUB
#define PROBE_SUB -1
#endif
    for (int ph = lo; ph < hi; ++ph) {
        bool phase_is0; int layer = 0, sub = 0, rep = 0;
        if (PROBE_SUB == 100) { phase_is0 = ph < 2; if (!phase_is0) { layer = (ph - 2) / PH_PER_LAYER; sub = (ph - 2) % PH_PER_LAYER; } }
        else if (PROBE_SUB >= 0) { phase_is0 = ph == 0; if (!phase_is0) { layer = (ph - 1) / (PH_PER_LAYER + PROBE_NREP); const int s = (ph - 1) % (PH_PER_LAYER + PROBE_NREP); sub = s <= PROBE_SUB ? s : (s <= PROBE_SUB + PROBE_NREP ? PROBE_SUB : s - PROBE_NREP); rep = s > PROBE_SUB && s <= PROBE_SUB + PROBE_NREP; } }
        else { phase_is0 = ph == 0; if (!phase_is0) { layer = (ph - 1) / PH_PER_LAYER; sub = (ph - 1) % PH_PER_LAYER; } }
        int tid, G = gridDim.x, bx = blockIdx.x; asm volatile("v_mbcnt_lo_u32_b32 %0, -1, 0\n\tv_mbcnt_hi_u32_b32 %0, -1, %0" : "=v"(tid)); tid += wave_s * 64; asm volatile("" : "+v"(tid), "+s"(G), "+s"(bx));
        const int vcu = (G % 8 == 0) ? (bx % 8) * (G / 8) + bx / 8 : bx;
        const int ngw = G * NWAVES;
        const int lane = tid & 63, wave = __builtin_amdgcn_readfirstlane(tid >> 6), gw = vcu * NWAVES + wave;
        LAS unsigned char* lds = lds0; asm volatile("" : "+s"(lds));
        MKP q = p;
        if (phase_is0) {
#ifndef NO_P0
            LND(q.w_in); LND(q.w_out); LND(q.w1); LND(q.w2); LND(q.Win_t); LND(q.Wout_t); LND(q.W1_t); LND(q.W2_t); LND(q.wgc);
            float gwv[24]; gate_w_load(q.w_in, gwv, tid);
            { LND(q.router_w); LND(q.rwT);
                if (tid < 256) { const int g = bx * 256 + tid; if (g < 2 * DM * NE) { const int l = g >> 15, i = g & (DM * NE - 1), k = i >> 5, e = i & 31; q.rwT[(size_t)l * NE * (DM + 4) + e * (DM + 4) + k] = q.router_w[(size_t)l * DM * NE + i]; } }
                if (bx == 0 && tid >= 256) { const int i = tid - 256; q.rwT[(size_t)(i >> 7) * NE * (DM + 4) + ((i & 127) >> 2) * (DM + 4) + DM + (i & 3)] = 0.f; } }
            if (tid < 48) { const float* wl = q.w_in + (size_t)DM * NPROJ; const int g = bx * 48 + tid, ci = g >> 10, k = g & 1023; const int col = ci < 4 ? C_FF + ci : (ci < 8 ? C_GB + (ci - 4) : C_GA + (ci - 8)); if (g < 12 * DM) q.wgc[ci * DM + k] = wl[(size_t)k * NPROJ + col]; }
            phase_convert_weights(q, lds, gw, ngw, wave, lane);
#if PROBE_SUB == 101
            __syncthreads(); phase_convert_weights(q, lds, gw, ngw, wave, lane);
#endif
            __syncthreads();
            LND(q.x); LND(q.meta); LND(q.ln_in_g); LND(q.ln_in_b); LND(q.stream); LND(q.actb); LND(q.gates);
            phase_ln_in(q, lds, gw, ngw, tid, lane, gwv);
#endif
        } else {
            if (sub == 0) {
#ifndef NO_S0
                LND(q.fox_forget_b); LND(q.gates); LND(q.fox_loc); LND(q.fox_tot); fox_seg_scan(q, layer, bx, lds, tid, lane, wave);
                LND(q.actb); LND(q.Win_t); LND(q.proj);
                pg8::Gemm g{q.actb, q.Win_t + (size_t)layer * NPJ * DM, DM, 0}; pg8::DenseOrder S; S.init(MP / 256, NPJ / 256, G, bx);
                pg8::EpiStoreBf16 E{q.proj, NPJ, nullptr, 0};
                pg8::gemm_phase<pg8::EpiStoreBf16, pg8::DenseOrder, false>(lds, g, S, E, tid);
                if (bx >= 77) { LND(q.w1); LND(q.W1_t); convert_w1_deferred(q, lds, layer, ((bx - 77) * NWAVES + wave) * W1_Q, wave, lane); }
#endif
            } else if (sub == 1) { LND(q.fox_loc); LND(q.fox_tot); LND(q.Gk); LND(q.Gf); LND(q.proj); LND(q.ctl);
                LND(q.gdn_conv_w); LND(q.gdn_a_log); LND(q.gdn_dt_bias); LND(q.proj); LND(q.gch); LND(q.gcd); LND(q.act); phase_gdn_chunk_prep(q, layer, vcu, G, lds, tid, lane, rep); if (!rep) fox_finalize(q, layer, bx, tid, lane);
            } else if (sub == 2) { LND(q.proj); LND(q.tmpO); LND(q.mixcat); LND(q.Gk); LND(q.Gf); LND(q.ctl); LND(q.act); LND(q.gch); LND(q.gcd); LND(q.gdn_o); LND(q.gdn_conv_w); LND(q.gdn_a_log); LND(q.gdn_dt_bias); LND(q.gates); phase_mixer_attn(q, layer, layer + 2 * rep, (char*)lds_raw, lds, tid, bx);
            } else if (sub == 3) { LND(q.diff_lambda); LND(q.diff_subln_g); LND(q.tmpO); LND(q.mixcat); LND(q.gdn_o); LND(q.gdn_norm_g); LND(q.proj); phase_diff_combine(q, layer, gw, ngw, lane);
            } else if (sub == 4) {
#ifndef NO_S4
                LND(q.mixcat); LND(q.Wout_t); LND(q.stream);
                pg8::Gemm g{q.mixcat, q.Wout_t + (size_t)layer * DM * DM, DM, 0}; pg8::DenseOrder S; S.init(MP / 256, DM / 256, G, bx);
                LND(q.actb); pg8::EpiResid E{(bf16_t*)q.stream, q.actb, DM, DN_ALPHA};
                pg8::gemm_phase<pg8::EpiResid, pg8::DenseOrder, false>(lds, g, S, E, tid);
                if (bx >= 4) { LND(q.w1); LND(q.W1_t); convert_w1_deferred(q, lds, layer, W1_DEFER_A + ((bx - 4) * NWAVES + wave) * W1_Q, wave, lane); }
                if (layer == 1 && bx >= 4) {
                    LND(q.cnt); LND(q.w2); LND(q.W2_t); int np = 0; if (lane < NE) np = (q.cnt[lane * CNT_STRIDE] + 255) >> 8; const int P0 = (int)(wave_sum((float)np) + 0.5f);
                    const int cov0 = ((G - moe_last_round_units(8 * P0, G)) + (G - moe_last_round_units(4 * P0, G))) * NWAVES * W1_Q;
                    convert_w2_blocks(q, lds, cov0 + (bx - 4) * NWAVES + wave, 1, 1, wave, lane); }
#endif
            } else if (sub == 5) {
#ifndef NO_S5
                LND(q.rwT); LND(q.router_b); LND(q.cnt); LND(q.stream); LND(q.ln1_g); LND(q.ln1_b); LND(q.actb); LND(q.tok_e); LND(q.tok_pos); LND(q.tok_gate); LND(q.etok);
                LND(q.act); LND(q.gch); phase_ln1_route(q, layer, lds, gw, ngw, tid, lane, rep);
#endif
            } else if (sub == 6) {
#ifndef NO_S6
                LND(q.actb); LND(q.W1_t); LND(q.cnt); LND(q.etok); LND(q.act); LND(q.b1);
                if (layer == 1) {
                    int np = 0; if (lane < NE) np = (q.cnt[lane * CNT_STRIDE] + 255) >> 8; const int P0 = (int)(wave_sum((float)np) + 0.5f);
                    const int idle = (G - moe_last_round_units(8 * P0, G)) + (G - moe_last_round_units(4 * P0, G)), covered = idle * NWAVES * W1_Q + (G - 4) * NWAVES;
                    LND(q.w2); LND(q.W2_t); convert_w2_blocks(q, lds, covered + gw, ngw, 1 << 20, wave, lane); __syncthreads(); }
                volatile LAS int* tab = (volatile LAS int*)(lds + LDS_TAB); build_expert_tab(q.cnt + layer * 2048, tab, tid);
                pg8::Gemm g{q.actb, q.W1_t + (size_t)layer * NE * 2 * DE * DM, DM, (size_t)2 * DE * DM};
                pg8::ExpertOrder S{tab, q.cnt + layer * 2048, q.etok, 8, G, bx};
                pg8::EpiSwiglu E{q.act, q.b1 + (size_t)layer * NE * 2 * DE};
                const int P_ = __builtin_amdgcn_readfirstlane(tab[0]);
                pg8::gemm_phase<pg8::EpiSwiglu, pg8::ExpertOrder, true>(lds, g, S, E, tid);
                if (layer == 0) { const int ir = S.idle_rank(P_);
                    if (ir >= 0) { LND(q.w2); LND(q.W2_t); convert_w2_blocks(q, lds, (ir * NWAVES + wave) * W1_Q, 1, W1_Q, wave, lane); } }
#endif
            } else if (sub == 7) {
#ifndef NO_S7
                LND(q.act); LND(q.W2_t); LND(q.cnt); LND(q.etok); LND(q.ybuf); LND(q.b2);
                volatile LAS int* tab = (volatile LAS int*)(lds + LDS_TAB); if (rep) build_expert_tab(q.cnt + layer * 2048, tab, tid);
                pg8::Gemm g{q.act, q.W2_t + (size_t)layer * NE * DM * DE, DE, (size_t)DM * DE};
                pg8::ExpertOrder S{tab, q.cnt + layer * 2048, q.etok, 4, G, bx};
                pg8::EpiStoreBf16 E{q.ybuf, DM, q.b2 + (size_t)layer * NE * DM, DM};
                const int P_ = __builtin_amdgcn_readfirstlane(tab[0]);
                pg8::gemm_phase<pg8::EpiStoreBf16, pg8::ExpertOrder, false>(lds, g, S, E, tid);
                if (layer == 0) { const int idle1 = G - moe_last_round_units(8 * P_, G), ir = S.idle_rank(P_);
                    if (ir >= 0) { LND(q.w2); LND(q.W2_t); convert_w2_blocks(q, lds, ((idle1 + ir) * NWAVES + wave) * W1_Q, 1, W1_Q, wave, lane); } }
#endif
            } else if (sub == 8) {
#ifndef NO_S8
                LND(q.cnt); LND(q.wgc); LND(q.stream); LND(q.tok_e); LND(q.tok_pos); LND(q.tok_gate); LND(q.ybuf); LND(q.ln2_g); LND(q.ln2_b); LND(q.actb); LND(q.gates); LND(q.out);
                LND(q.act); LND(q.gch); phase_combine_ln2(q, layer, lds, gw, ngw, tid, lane, rep);
#endif
            }
        }
        if (ph + 1 < hi) xcd_barrier(bar);
    }
}

__global__ __launch_bounds__(256) void k_proj_to_naive(const bf16_t* __restrict__ proj, const float* __restrict__ gates, float* __restrict__ nproj) {
    const int row = blockIdx.x;
    for (int c = threadIdx.x; c < NPROJ; c += 256) { float v;
        if (c < 2304) { v = bf2f(proj[(size_t)row * NPJ + c]); if (c < 512 || (c >= C_FQ && c < C_FK)) v *= (1.f / QK_C2); }
        else if (c < 2308) v = gates[(size_t)row * 16 + (c - 2304)];
        else if (c < 3076) v = bf2f(proj[(size_t)row * NPJ + P_GQKV + (c - 2308)]);
        else if (c < 3084) v = gates[(size_t)row * 16 + 4 + (c - 3076)];
        else v = bf2f(proj[(size_t)row * NPJ + P_GZ + (c - 3084)]);
        nproj[(size_t)row * NPROJ + c] = v; }
}
__global__ __launch_bounds__(256) void k_gdn_to_fast(const float* __restrict__ nm, bf16_t* __restrict__ m) {
    const int row = blockIdx.x, c = threadIdx.x, t = row % LP; const float v = (t >= 64 && t < LL) ? nm[(size_t)row * DM + 768 + c] : 0.f; m[(size_t)row * DM + 768 + c] = (bf16_t)(cvt_pk_bf16(v, 0.f) & 0xffffu);
}
__global__ __launch_bounds__(256) void k_mixcat_to_fast(const float* __restrict__ nm, bf16_t* __restrict__ m) {
    const size_t i = ((size_t)blockIdx.x * 256 + threadIdx.x) * 2; if (i >= (size_t)MP * DM) return; *(unsigned*)(m + i) = cvt_pk_bf16(nm[i], nm[i + 1]);
}


#ifdef GDN_DEBUG
__global__ __launch_bounds__(256) void k_dbg_cmp(const float* __restrict__ ref, const bf16_t* __restrict__ fast, float* __restrict__ stats) {
    const int row = blockIdx.x, c = threadIdx.x, t = row % LP; if (t < NLEAD) return;
    const int h = c >> 6, tm = t & 63, cls = 3 * h + (tm == 0 ? 0 : tm == 63 ? 1 : 2);
    const float r = ref[(size_t)row * DM + 768 + c], f = bf2f(fast[(size_t)row * DM + 768 + c]);
    float e = wave_sum((r - f) * (r - f)), q = wave_sum(r * r);
    if ((c & 63) == 0) { atomicAdd(&stats[2 * cls], e); atomicAdd(&stats[2 * cls + 1], q); }
}
__global__ void k_dbg_scale(const float* __restrict__ stats, float* __restrict__ out, int n) {
    float worst = 0.f; int wc = -1;
    for (int c = 0; c < 12; ++c) { const float rel = stats[2 * c] / fmaxf(stats[2 * c + 1], 1e-30f); if (rel > worst) { worst = rel; wc = c; } }
    float scale = 1.f;
#if GDN_DEBUG == 1
    if (worst > 1e-3f) scale = 1.f + 0.1f * (float)(wc + 1);
#else
    { const int c = GDN_DEBUG % 100; scale = 1.f + sqrtf(stats[2 * c] / fmaxf(stats[2 * c + 1], 1e-30f)); }
#endif
    for (size_t i = (size_t)blockIdx.x * blockDim.x + threadIdx.x; i < (size_t)n; i += (size_t)gridDim.x * blockDim.x) out[i] *= scale;
}
#endif
struct Bump { char* base; size_t off, cap; void* get(size_t bytes) { off = (off + 255) & ~(size_t)255; void* p = base + off; off += bytes; return p; } };
struct NaiveBufs { float *stream, *proj, *mixcat, *mix, *x1, *tmpA, *cum, *gq, *gk, *gv, *gbeta, *gg, *gate, *act, *y; int *rowmask, *topidx, *pos, *tokslot, *cnt, *offs, *slot_tok; };

static void launch_mk(MKP p, int lo, int hi, int grid, hipStream_t st) {
    p.ph_lo = lo; p.ph_hi = hi; void* args[] = {&p};
    hipError_t e = hipLaunchCooperativeKernel((const void*)mk_fwd, dim3(grid), dim3(NTHR), args, LDS_BYTES, st);
    if (e != hipSuccess) fprintf(stderr, "cooperative launch failed: %s (grid %d)\n", hipGetErrorString(e), grid);
}
static void naive_mixer(void* const* d_in, int layer, NaiveBufs& nb, hipStream_t st) {
    const float* diff_lambda = (const float*)d_in[5]; const float* diff_subln_g = (const float*)d_in[6]; const float* fox_forget_b = (const float*)d_in[7];
    const float* gdn_conv_w = (const float*)d_in[8]; const float* gdn_a_log = (const float*)d_in[9]; const float* gdn_dt_bias = (const float*)d_in[10]; const float* gdn_norm_g = (const float*)d_in[11];
    const float lam_init = 0.8f - 0.6f * expf(-0.3f * (float)layer);
    k_fox_cum<<<NB * 4, 64, 0, st>>>(nb.proj, fox_forget_b + layer * 4, nb.cum);
    k_nattn<<<dim3(LL / 64, 20, NB), 64, 0, st>>>(nb.proj, nb.cum, nb.tmpA, nb.mixcat);
    k_diff_combine<<<(MP * 4 * 64 + 255) / 256, 256, 0, st>>>(nb.tmpA, diff_lambda + layer * 256, diff_subln_g + layer * 128, lam_init, nb.mixcat);
    k_gdn_prep<<<MP, 256, 0, st>>>(nb.proj, gdn_conv_w + layer * 4 * 768, gdn_a_log + layer * 4, gdn_dt_bias + layer * 4, nb.gq, nb.gk, nb.gv, nb.gbeta, nb.gg);
    k_gdn_seq<<<NB * 4, 64, 0, st>>>(nb.gq, nb.gk, nb.gv, nb.gbeta, nb.gg, nb.proj, gdn_norm_g + layer * 64, nb.mixcat);
    k_gdn_gate<<<MP, 256, 0, st>>>(nb.proj, nb.mixcat);
    k_zero_pad_rows<<<(MP * 64 + 255) / 256, 256, 0, st>>>(nb.mixcat);
}

extern "C" void kernel_launch(void* const* d_in, const int* in_sizes, int n_in, void* d_out, int out_size, void* d_ws, size_t ws_size, hipStream_t stream) {
    static int grid = 0;
    if (grid == 0) {
        int dev = 0, cus = 0, per_cu = 0; hipGetDevice(&dev); hipDeviceGetAttribute(&cus, hipDeviceAttributeMultiprocessorCount, dev);
        if (hipFuncSetAttribute((const void*)mk_fwd, hipFuncAttributeMaxDynamicSharedMemorySize, LDS_BYTES) != hipSuccess) fprintf(stderr, "hipFuncSetAttribute failed\n");
        if (hipOccupancyMaxActiveBlocksPerMultiprocessor(&per_cu, (const void*)mk_fwd, NTHR, LDS_BYTES) != hipSuccess || per_cu < 1) { fprintf(stderr, "occupancy query: %d\n", per_cu); per_cu = 1; }
        (void)hipGetLastError();
        grid = cus * 1;
    }
    Bump bp{(char*)d_ws, 0, ws_size};
    MKP p{};
    p.x = (const float*)d_in[0]; p.meta = (const float*)d_in[1]; p.ln_in_g = (const float*)d_in[2]; p.ln_in_b = (const float*)d_in[3]; p.w_in = (const float*)d_in[4];
    p.diff_lambda = (const float*)d_in[5]; p.diff_subln_g = (const float*)d_in[6]; p.fox_forget_b = (const float*)d_in[7]; p.gdn_conv_w = (const float*)d_in[8]; p.gdn_a_log = (const float*)d_in[9];
    p.gdn_dt_bias = (const float*)d_in[10]; p.gdn_norm_g = (const float*)d_in[11]; p.w_out = (const float*)d_in[12]; p.ln1_g = (const float*)d_in[13]; p.ln1_b = (const float*)d_in[14];
    p.router_w = (const float*)d_in[15]; p.router_b = (const float*)d_in[16]; p.w1 = (const float*)d_in[17]; p.b1 = (const float*)d_in[18]; p.w2 = (const float*)d_in[19]; p.b2 = (const float*)d_in[20];
    p.ln2_g = (const float*)d_in[21]; p.ln2_b = (const float*)d_in[22]; p.out = (float*)d_out;
    p.ctl = (unsigned*)bp.get(1 << 20); p.cnt = (int*)(p.ctl + 65536);
    p.Win_t = (bf16_t*)bp.get((size_t)2 * NPJ * DM * 2); p.Wout_t = (bf16_t*)bp.get((size_t)2 * DM * DM * 2);
    p.W1_t = (bf16_t*)bp.get((size_t)2 * NE * 2 * DE * DM * 2); p.W2_t = (bf16_t*)bp.get((size_t)2 * NE * DM * DE * 2);
    p.stream = (float*)bp.get((size_t)MP * DM * 4); p.actb = (bf16_t*)bp.get((size_t)MP * DM * 2); p.proj = (bf16_t*)bp.get((size_t)(MP + 256) * NPJ * 2);
    p.gates = (float*)bp.get((size_t)MP * 16 * 4); p.mixcat = (bf16_t*)bp.get((size_t)MP * DM * 2);
    p.act = (bf16_t*)bp.get((size_t)PMAX * 256 * DE * 2); p.ybuf = (bf16_t*)bp.get((size_t)PMAX * 256 * DM * 2);
    p.tmpO = (bf16_t*)bp.get((size_t)16 * MP * 64 * 2 + 65536); p.Gk = (unsigned long long*)bp.get((size_t)8 * GSTRIDE * 8);
    p.wgc = (float*)bp.get(12 * DM * 4); p.rwT = (float*)bp.get((size_t)2 * NE * (DM + 4) * 4);
    p.Gf = (float*)bp.get((size_t)8 * GSTRIDE * 4);
    p.fox_loc = (float*)bp.get((size_t)8 * 17 * 512 * 4); p.fox_tot = (float*)bp.get(8 * 32 * 4);
    p.gch = (unsigned char*)bp.get((size_t)GCH_UNITS * GCH_BYTES); p.gcd = (float*)bp.get((size_t)GCH_UNITS * 4);
    p.gq = (float*)bp.get((size_t)MP * 256 * 4); p.gk = (float*)bp.get((size_t)MP * 256 * 4); p.gv = (float*)bp.get((size_t)MP * 256 * 4); p.gsc = (float*)bp.get((size_t)MP * 16 * 4); p.gdn_o = (float*)bp.get((size_t)MP * 256 * 4);
    p.etok = (int*)bp.get((size_t)NE * MP * 4); p.tok_e = (int*)bp.get((size_t)MP * 4 * 4); p.tok_pos = (int*)bp.get((size_t)MP * 4 * 4); p.tok_gate = (float*)bp.get((size_t)MP * 4 * 4);
    if (bp.off > ws_size) { fprintf(stderr, "kernel_launch: workspace too small: need %zu have %zu\n", bp.off, ws_size); return; }
    (void)hipMemsetAsync(p.ctl, 0, 1 << 20, stream);
    launch_mk(p, 0, N_PHASES, grid, stream);
#ifdef GDN_DEBUG
    { NaiveBufs nb{}; nb.proj = (float*)bp.get((size_t)MP * NPROJ * 4); nb.mixcat = (float*)bp.get((size_t)MP * DM * 4);
      nb.gq = (float*)bp.get((size_t)MP * 256 * 4); nb.gk = (float*)bp.get((size_t)MP * 256 * 4); nb.gv = (float*)bp.get((size_t)MP * 256 * 4); nb.gbeta = (float*)bp.get((size_t)MP * 4 * 4); nb.gg = (float*)bp.get((size_t)MP * 4 * 4);
      float* stats = (float*)bp.get(256); (void)hipMemsetAsync(stats, 0, 256, stream); const int layer = 1;
      k_proj_to_naive<<<MP, 256, 0, stream>>>(p.proj, p.gates, nb.proj);
      k_gdn_prep<<<MP, 256, 0, stream>>>(nb.proj, (const float*)d_in[8] + layer * 4 * 768, (const float*)d_in[9] + layer * 4, (const float*)d_in[10] + layer * 4, nb.gq, nb.gk, nb.gv, nb.gbeta, nb.gg);
      k_gdn_seq<<<NB * 4, 64, 0, stream>>>(nb.gq, nb.gk, nb.gv, nb.gbeta, nb.gg, nb.proj, (const float*)d_in[11] + layer * 64, nb.mixcat);
      k_gdn_gate<<<MP, 256, 0, stream>>>(nb.proj, nb.mixcat);
      k_dbg_cmp<<<MP, 256, 0, stream>>>(nb.mixcat, p.mixcat, stats);
      k_dbg_scale<<<256, 256, 0, stream>>>(stats, (float*)d_out, out_size); }
#endif
}
```
